# Optimizing an MI355X kernel written in HIP

```python
import jax, jax.numpy as jnp
from jax import lax
import numpy as np

D_MODEL = 1024
BATCH = 8
SEQ = 2048
DEPTH = 2
DEC_BATCH = 128
DEC_SEQ = 8
PAST_LEN = 16384
PAGE_SIZE = 128

RNN_WIDTH = D_MODEL
RNN_HEADS = 16
RNN_HEAD_DIM = RNN_WIDTH // RNN_HEADS
RNN_CONV = 4
RG_C = 8.0
S5_WIDTH = D_MODEL // 2
S5_GROUP = 16
S5_GROUPS = S5_WIDTH // S5_GROUP
S5_STATE = 64
D_FF = 3 * D_MODEL
FFN_CONV = 3
IN_WIDTH = 2 * RNN_WIDTH + S5_WIDTH + 2 * D_MODEL
SPLITS = [RNN_WIDTH, 2 * RNN_WIDTH, 2 * RNN_WIDTH + S5_WIDTH, 2 * RNN_WIDTH + S5_WIDTH + D_MODEL]
EPS = 1e-6
F32 = jnp.float32

kernel_name = "hawk_s5_gated_hybrid_step"


def rmsnorm(x, g):
    xf = x.astype(F32)
    y = xf * lax.rsqrt(jnp.mean(xf * xf, axis=-1, keepdims=True) + EPS)
    return (y * g.astype(F32)).astype(x.dtype)


def modulate(x, g, shift, scale):
    return rmsnorm(x, g) * (1 + scale[:, None]) + shift[:, None]


def causal_dwconv(buf, x, w, b):
    k = w.shape[0]
    t = x.shape[1]
    xp = jnp.concatenate([buf.astype(x.dtype), x], axis=1)
    y = b
    for j in range(k):
        y = y + xp[:, j:j + t] * w[j]
    return y, xp[:, xp.shape[1] - (k - 1):]


def _lin_combine(e1, e2):
    a1, b1 = e1
    a2, b2 = e2
    return a1 * a2, a2 * b1 + b2


def _cplx_combine(e1, e2):
    ar1, ai1, br1, bi1 = e1
    ar2, ai2, br2, bi2 = e2
    return (ar1 * ar2 - ai1 * ai2, ar1 * ai2 + ai1 * ar2,
            ar2 * br1 - ai2 * bi1 + br2, ar2 * bi1 + ai2 * br1 + bi2)


def rglru_branch(rx, ry, conv_buf, h0, conv_w, conv_b, wa, ba, wx, bx, lam):
    n, t, _ = rx.shape
    xc, new_buf = causal_dwconv(conv_buf, rx, conv_w, conv_b)
    xh = xc.reshape(n, t, RNN_HEADS, RNN_HEAD_DIM)
    r = jax.nn.sigmoid((jnp.einsum('nthi,hij->nthj', xh, wa).reshape(n, t, RNN_WIDTH) + ba).astype(F32))
    i = jax.nn.sigmoid((jnp.einsum('nthi,hij->nthj', xh, wx).reshape(n, t, RNN_WIDTH) + bx).astype(F32))
    log_a = RG_C * r * jax.nn.log_sigmoid(lam.astype(F32))
    a = jnp.exp(log_a)
    b = jnp.sqrt(-jnp.expm1(2.0 * log_a)) * i * xc.astype(F32)
    b = b.at[:, 0].add(a[:, 0] * h0.astype(F32))
    _, h = lax.associative_scan(_lin_combine, (a, b), axis=1)
    out = h.astype(rx.dtype) * jax.nn.gelu(ry)
    return out, h[:, -1], new_buf


def s5_branch(sx, re0, im0, lam_re, lam_im, b_re, b_im, c_re, c_im, d, log_dt):
    n, t, _ = sx.shape
    dt = jnp.exp(log_dt.astype(F32))[:, None]
    lr = lam_re.astype(F32)
    li = lam_im.astype(F32)
    mag = jnp.exp(lr * dt)
    ar = mag * jnp.cos(li * dt)
    ai = mag * jnp.sin(li * dt)
    den = lr * lr + li * li
    zr = ((ar - 1.0) * lr + ai * li) / den
    zi = (ai * lr - (ar - 1.0) * li) / den
    br = b_re.astype(F32)
    bi = b_im.astype(F32)
    bbr = zr[..., None] * br - zi[..., None] * bi
    bbi = zr[..., None] * bi + zi[..., None] * br
    u = sx.astype(F32).reshape(n, t, S5_GROUPS, S5_GROUP)
    bur = jnp.einsum('ntgc,gpc->ntgp', u, bbr)
    bui = jnp.einsum('ntgc,gpc->ntgp', u, bbi)
    re0 = re0.astype(F32)
    im0 = im0.astype(F32)
    bur = bur.at[:, 0].add(ar * re0 - ai * im0)
    bui = bui.at[:, 0].add(ar * im0 + ai * re0)
    arf = jnp.broadcast_to(ar, bur.shape)
    aif = jnp.broadcast_to(ai, bur.shape)
    _, _, sr, si = lax.associative_scan(_cplx_combine, (arf, aif, bur, bui), axis=1)
    y = (jnp.einsum('ntgp,gcp->ntgc', sr, c_re.astype(F32))
         - jnp.einsum('ntgp,gcp->ntgc', si, c_im.astype(F32)))
    y = y.reshape(n, t, S5_WIDTH) + d.astype(F32) * sx.astype(F32)
    return jax.nn.gelu(y).astype(sx.dtype), sr[:, -1], si[:, -1]


def layer(x, c, rg_h, rg_conv, s5_re, s5_im, ffn_conv, p):
    mod = jax.nn.silu(c) @ p['w_ada'] + p['b_ada']
    sh1, sc1, gt1, sh2, sc2, gt2 = jnp.split(mod, 6, axis=-1)
    h = modulate(x, p['g_norm1'], sh1, sc1)
    u = h @ p['w_in'] + p['b_in']
    rx, ry, sx, ga, gb = jnp.split(u, SPLITS, axis=-1)
    ra, new_rg_h, new_rg_conv = rglru_branch(rx, ry, rg_conv, rg_h, p['rg_conv_w'], p['rg_conv_b'],
                                             p['rg_wa'], p['rg_ba'], p['rg_wx'], p['rg_bx'], p['rg_lambda'])
    sb, new_s5_re, new_s5_im = s5_branch(sx, s5_re, s5_im, p['s5_lam_re'], p['s5_lam_im'], p['s5_b_re'],
                                         p['s5_b_im'], p['s5_c_re'], p['s5_c_im'], p['s5_d'], p['s5_log_dt'])
    branch_a = ra @ p['w_rg_proj']
    glu_a, glu_b = jnp.split(sb @ p['w_glu'], 2, axis=-1)
    branch_b = glu_a * jax.nn.sigmoid(glu_b)
    merged = jax.nn.sigmoid(ga) * branch_a + jax.nn.sigmoid(gb) * branch_b
    x = x + gt1[:, None] * (merged @ p['w_out'])
    h = modulate(x, p['g_norm2'], sh2, sc2)
    up = h @ p['w_up']
    uc, new_ffn_conv = causal_dwconv(ffn_conv, up, p['ffn_conv_w'], p['ffn_conv_b'])
    ua, ub = jnp.split(uc, 2, axis=-1)
    x = x + gt2[:, None] * ((jax.nn.gelu(ua) * ub) @ p['w_down'])
    return x, (new_rg_h, new_rg_conv, new_s5_re, new_s5_im, new_ffn_conv)


def trunk(x, c, rg_h, rg_conv, s5_re, s5_im, ffn_conv, params, g_final):
    outs = [[], [], [], [], []]
    for l in range(DEPTH):
        p = {k: v[l] for k, v in params.items()}
        x, st = layer(x, c, rg_h[:, l], rg_conv[:, l], s5_re[:, l], s5_im[:, l], ffn_conv[:, l], p)
        for o, s in zip(outs, st):
            o.append(s)
    y = rmsnorm(x, g_final)
    return (y, jnp.stack(outs[0], axis=1), jnp.stack(outs[1], axis=1), jnp.stack(outs[2], axis=1),
            jnp.stack(outs[3], axis=1), jnp.stack(outs[4], axis=1))


def setup_inputs(seed: int = 0) -> dict:
    key = jax.random.key(seed)
    ks = iter(jax.random.split(key, 48))

    def nrm(shape, s):
        return s * jax.random.normal(next(ks), shape, F32)

    L, D = DEPTH, D_MODEL
    u = jax.random.uniform(next(ks), (L, RNN_WIDTH), F32, 0.9, 0.999)
    s = u ** (1.0 / RG_C)
    rg_lambda = jnp.log(s) - jnp.log1p(-s)
    lam_im = jnp.pi * jnp.broadcast_to(jnp.arange(S5_STATE, dtype=F32), (L, S5_GROUPS, S5_STATE))
    return {
        'x_prompt': nrm((BATCH, SEQ, D), 1.0),
        'x_sample': nrm((DEC_BATCH, DEC_SEQ, D), 1.0),
        'state_rg_h': nrm((DEC_BATCH, L, RNN_WIDTH), 0.5),
        'state_rg_conv': nrm((DEC_BATCH, L, RNN_CONV - 1, RNN_WIDTH), 1.0),
        'state_s5_re': nrm((DEC_BATCH, L, S5_GROUPS, S5_STATE), 0.5),
        'state_s5_im': nrm((DEC_BATCH, L, S5_GROUPS, S5_STATE), 0.5),
        'state_ffn_conv': nrm((DEC_BATCH, L, FFN_CONV - 1, 2 * D_FF), 1.0),
        'c_prompt': nrm((BATCH, D), 1.0),
        'c_sample': nrm((DEC_BATCH, D), 1.0),
        'w_ada': nrm((L, D, 6 * D), 0.5 * D ** -0.5),
        'b_ada': nrm((L, 6 * D), 0.02),
        'g_norm1': 1.0 + nrm((L, D), 0.02),
        'g_norm2': 1.0 + nrm((L, D), 0.02),
        'w_in': nrm((L, D, IN_WIDTH), D ** -0.5),
        'b_in': nrm((L, IN_WIDTH), 0.02),
        'rg_conv_w': nrm((L, RNN_CONV, RNN_WIDTH), RNN_CONV ** -0.5),
        'rg_conv_b': nrm((L, RNN_WIDTH), 0.02),
        'rg_wa': nrm((L, RNN_HEADS, RNN_HEAD_DIM, RNN_HEAD_DIM), RNN_HEAD_DIM ** -0.5),
        'rg_ba': nrm((L, RNN_WIDTH), 0.02),
        'rg_wx': nrm((L, RNN_HEADS, RNN_HEAD_DIM, RNN_HEAD_DIM), RNN_HEAD_DIM ** -0.5),
        'rg_bx': nrm((L, RNN_WIDTH), 0.02),
        'rg_lambda': rg_lambda,
        's5_lam_re': -0.5 + nrm((L, S5_GROUPS, S5_STATE), 0.01),
        's5_lam_im': lam_im + nrm((L, S5_GROUPS, S5_STATE), 0.01),
        's5_b_re': nrm((L, S5_GROUPS, S5_STATE, S5_GROUP), (2.0 * S5_GROUP) ** -0.5),
        's5_b_im': nrm((L, S5_GROUPS, S5_STATE, S5_GROUP), (2.0 * S5_GROUP) ** -0.5),
        's5_c_re': nrm((L, S5_GROUPS, S5_GROUP, S5_STATE), (2.0 * S5_STATE) ** -0.5),
        's5_c_im': nrm((L, S5_GROUPS, S5_GROUP, S5_STATE), (2.0 * S5_STATE) ** -0.5),
        's5_d': nrm((L, S5_WIDTH), 0.5),
        's5_log_dt': jax.random.uniform(next(ks), (L, S5_GROUPS), F32, float(np.log(0.001)), float(np.log(0.1))),
        'w_rg_proj': nrm((L, RNN_WIDTH, D), RNN_WIDTH ** -0.5),
        'w_glu': nrm((L, S5_WIDTH, 2 * D), S5_WIDTH ** -0.5),
        'w_out': nrm((L, D, D), D ** -0.5),
        'w_up': nrm((L, D, 2 * D_FF), D ** -0.5),
        'ffn_conv_w': nrm((L, FFN_CONV, 2 * D_FF), FFN_CONV ** -0.5),
        'ffn_conv_b': nrm((L, 2 * D_FF), 0.02),
        'w_down': nrm((L, D_FF, D), D_FF ** -0.5),
        'g_final': 1.0 + nrm((D,), 0.02),
    }


def reference(x_prompt, x_sample, state_rg_h, state_rg_conv, state_s5_re, state_s5_im, state_ffn_conv,
              c_prompt, c_sample, w_ada, b_ada, g_norm1, g_norm2, w_in, b_in, rg_conv_w, rg_conv_b,
              rg_wa, rg_ba, rg_wx, rg_bx, rg_lambda, s5_lam_re, s5_lam_im, s5_b_re, s5_b_im,
              s5_c_re, s5_c_im, s5_d, s5_log_dt, w_rg_proj, w_glu, w_out, w_up, ffn_conv_w,
              ffn_conv_b, w_down, g_final):
    params = dict(w_ada=w_ada, b_ada=b_ada, g_norm1=g_norm1, g_norm2=g_norm2, w_in=w_in, b_in=b_in,
                  rg_conv_w=rg_conv_w, rg_conv_b=rg_conv_b, rg_wa=rg_wa, rg_ba=rg_ba, rg_wx=rg_wx,
                  rg_bx=rg_bx, rg_lambda=rg_lambda, s5_lam_re=s5_lam_re, s5_lam_im=s5_lam_im,
                  s5_b_re=s5_b_re, s5_b_im=s5_b_im, s5_c_re=s5_c_re, s5_c_im=s5_c_im, s5_d=s5_d,
                  s5_log_dt=s5_log_dt, w_rg_proj=w_rg_proj, w_glu=w_glu, w_out=w_out, w_up=w_up,
                  ffn_conv_w=ffn_conv_w, ffn_conv_b=ffn_conv_b, w_down=w_down)
    nb = x_prompt.shape[0]
    z_rg_h = jnp.zeros((nb, DEPTH, RNN_WIDTH), F32)
    z_rg_conv = jnp.zeros((nb, DEPTH, RNN_CONV - 1, RNN_WIDTH), x_prompt.dtype)
    z_s5 = jnp.zeros((nb, DEPTH, S5_GROUPS, S5_STATE), F32)
    z_ffn_conv = jnp.zeros((nb, DEPTH, FFN_CONV - 1, 2 * D_FF), x_prompt.dtype)
    y_prompt, p_rg_h, p_rg_conv, p_s5_re, p_s5_im, p_ffn_conv = trunk(
        x_prompt, c_prompt, z_rg_h, z_rg_conv, z_s5, z_s5, z_ffn_conv, params, g_final)
    y_sample, s_rg_h, s_rg_conv, s_s5_re, s_s5_im, s_ffn_conv = trunk(
        x_sample, c_sample, state_rg_h, state_rg_conv, state_s5_re, state_s5_im, state_ffn_conv,
        params, g_final)
    return (y_prompt, y_sample, p_rg_h, p_rg_conv, p_s5_re, p_s5_im, p_ffn_conv,
            s_rg_h, s_rg_conv, s_s5_re, s_s5_im, s_ffn_conv)
```

```cpp
#include <hip/hip_runtime.h>
#include <cstdio>
#include <cstdint>
namespace pg8 {
#define PG8_LAS __attribute__((address_space(3)))
typedef unsigned short bf16_t;
typedef short bf16x8 __attribute__((ext_vector_type(8)));
typedef float f32x4 __attribute__((ext_vector_type(4)));
typedef unsigned u32x4 __attribute__((ext_vector_type(4)));
constexpr int BM = 256, BK = 64, HALF = 128, HTB = HALF * BK * 2  , STAGE_BYTES = 8 * HTB, NXCD = 8, WGM = 8;

__host__ __device__ __forceinline__ int lds_byte(int r, int c) { const int st = (r >> 4) * 2 + (c >> 5), rr = r & 15, cc = c & 31, ob = rr * 64 + cc * 2; return st * 1024 + (ob ^ (((ob >> 9) & 1) << 5)); }
__host__ __device__ __forceinline__ void stage_rc(int b, int& R, int& C) { const int st = b / 1024, sb = b % 1024, swz = sb ^ (((sb >> 9) & 1) << 5); R = (st >> 1) * 16 + swz / 64; C = (st & 1) * 32 + (swz % 64) / 2; }
__host__ __device__ __forceinline__ int perm32(int rho) { const int n = rho >> 4, i = rho & 15; return 8 * (i >> 2) + 4 * n + (i & 3); }

struct Unit { int pm, pn; };
struct Gemm { const bf16_t* A; const bf16_t* Bt; int M, N, K; };

struct StaticOrder {
    int nM, nN, nwg, G, c;
    __host__ __device__ void init(int M, int N, int G_, int c_) { nM = M / BM; nN = N / BM; nwg = nM * nN; G = G_; c = c_; }
    __host__ __device__ bool next(int i, Unit& u) const {
        const long L = (long)i * G + c; if (L >= nwg) return false;
        int wgid = (int)L; { const int q = nwg / NXCD, r = nwg % NXCD, xcd = wgid % NXCD, off = wgid / NXCD; wgid = (xcd < r ? xcd * (q + 1) : r * (q + 1) + (xcd - r) * q) + off; }
        const int nig = WGM * nN, gid = wgid / nig, fm = gid * WGM, gsz = (nM - fm) < WGM ? (nM - fm) : WGM;
        u.pm = fm + ((wgid % nig) % gsz); u.pn = (wgid % nig) / gsz; return true;
    }
    __device__ __forceinline__ void a_ready(const Unit&) const {}
    __device__ __forceinline__ void done(const Unit&) const {}
};

__device__ __forceinline__ unsigned cvt_pk_bf16(float lo, float hi) { unsigned r; asm volatile("v_cvt_pk_bf16_f32 %0, %1, %2" : "=v"(r) : "v"(lo), "v"(hi)); return r; }
typedef float f32x2 __attribute__((ext_vector_type(2)));
__device__ __forceinline__ f32x2 gelu_pk(f32x2 v) {
    const f32x2 av = __builtin_elementwise_abs(v), d = av * 0.2316418882f + 1.0f;
    f32x2 t; t.x = __builtin_amdgcn_rcpf(d.x); t.y = __builtin_amdgcn_rcpf(d.y);
    f32x2 q = t * 0.5307027145f + (-0.7265760135f); q = q * t + 0.7107068705f; q = q * t + (-0.142248368f); q = q * t + 0.127414796f; q = q * t;
    const f32x2 s = (v * v) * (-0.72134752044f);
    f32x2 e; e.x = __builtin_amdgcn_exp2f(s.x); e.y = __builtin_amdgcn_exp2f(s.y);
    const f32x2 m = v * (q * e), r = v - m;
    f32x2 o; o.x = v.x < 0.f ? m.x : r.x; o.y = v.y < 0.f ? m.y : r.y; return o;
}

template <int ACT  > struct EpiBf16 {
    static constexpr bool PERM = true, AFTER_DRAIN = false; static_assert(ACT == 0 || ACT == 1, "EpiBf16: ACT is 0 (none) or 1 (gelu_pk)");
    bf16_t* O; int ldc; const float* bias; int split_cols; size_t split_stride; float scale0;
    __device__ __forceinline__ void operator()(const f32x4 (&acc)[2][2][4][2], const Unit& u, int wr, int wc, int fr, int fq) const {
        const int row0 = u.pm * BM + wr * 64 + fr; int colt = u.pn * BM; bf16_t* base = O;
        float sc = 1.f; if (split_cols) { const int t = colt / split_cols; base += (size_t)t * split_stride; colt -= t * split_cols; if (t == 0) sc = scale0; }
        const int col0 = colt + wc * 32 + 8 * fq, bcol0 = u.pn * BM + wc * 32 + 8 * fq;
        f32x4 bv[2][2];
#pragma unroll
        for (int bj = 0; bj < 2; ++bj)
#pragma unroll
            for (int n = 0; n < 2; ++n) bv[bj][n] = bias ? *(const f32x4*)(bias + bcol0 + bj * HALF + 4 * n) : (f32x4){0.f, 0.f, 0.f, 0.f};
#pragma unroll
        for (int ai = 0; ai < 2; ++ai)
#pragma unroll
            for (int m = 0; m < 4; ++m) { bf16_t* rowp = base + (size_t)(row0 + ai * HALF + m * 16) * ldc + col0;
#pragma unroll
                for (int bj = 0; bj < 2; ++bj) { f32x4 v0 = acc[ai][bj][m][0] + bv[bj][0], v1 = acc[ai][bj][m][1] + bv[bj][1];
                    if (ACT == 1) { f32x2 a = gelu_pk((f32x2){v0[0], v0[1]}), b = gelu_pk((f32x2){v0[2], v0[3]}), c = gelu_pk((f32x2){v1[0], v1[1]}), d = gelu_pk((f32x2){v1[2], v1[3]});
                        v0 = (f32x4){a.x, a.y, b.x, b.y}; v1 = (f32x4){c.x, c.y, d.x, d.y}; }
                    v0 = v0 * sc; v1 = v1 * sc; u32x4 w; w.x = cvt_pk_bf16(v0[0], v0[1]); w.y = cvt_pk_bf16(v0[2], v0[3]); w.z = cvt_pk_bf16(v1[0], v1[1]); w.w = cvt_pk_bf16(v1[2], v1[3]);
                    *(u32x4*)(rowp + bj * HALF) = w; } }
    }
};

template <class Epi, class Sched, bool ALIGN_EPI, bool SP2>
__device__ __forceinline__ void gemm_phase(PG8_LAS unsigned char* lds, const Gemm g, const Sched& S, const Epi& E) {
    int tid_ = threadIdx.x; asm volatile("" : "+v"(tid_));
    const int tid = tid_, wid = __builtin_amdgcn_readfirstlane(tid >> 6), lane = tid & 63, wr = wid >> 2, wc = wid & 3, fr = lane & 15, fq = lane >> 4;
    const int K = g.K, nt = K / BK;
    unsigned voffA[2], voffB[2];
#pragma unroll
    for (int i = 0; i < 2; ++i) { int R, C; stage_rc(tid * 16 + i * 8192, R, C); const int Rb = E.perm ? ((R & ~31) + perm32(R & 31)) : R;
        voffA[i] = (unsigned)(R * K + C) * 2u; voffB[i] = (unsigned)(Rb * K + C) * 2u; }
    const size_t kstep = (size_t)(BK * 2);
    const size_t hstep = (size_t)HALF * K * 2;
    const size_t tstep = 2 * hstep;
    const unsigned ldsw = (unsigned)wid * 1024u;
    const int aoff = lds_byte(wr * 64 + fr, fq * 8), boff = lds_byte(wc * 32 + fr, fq * 8);
#define PG8_SA(b, h) (((b) * 2 + (h)) * HTB)
#define PG8_SB(b, h) ((4 + (b) * 2 + (h)) * HTB)
#define PG8_STAGE(bufoff, gbase, voff) do { _Pragma("unroll") for (int _i = 0; _i < 2; ++_i) \
        __builtin_amdgcn_global_load_lds((const unsigned*)((const char*)(gbase) + (voff)[_i]), (PG8_LAS unsigned*)(lds + (bufoff) + ldsw + _i * 8192), 16, 0, 0); } while (0)
#define PG8_LDA(dst, b, h) do { _Pragma("unroll") for (int m = 0; m < 4; ++m) _Pragma("unroll") for (int k = 0; k < 2; ++k) dst[m][k] = *(const PG8_LAS bf16x8*)(lds + PG8_SA(b, h) + aoff + m * 2048 + k * 1024); } while (0)
#define PG8_LDB(dst, b, h) do { _Pragma("unroll") for (int n = 0; n < 2; ++n) _Pragma("unroll") for (int k = 0; k < 2; ++k) dst[n][k] = *(const PG8_LAS bf16x8*)(lds + PG8_SB(b, h) + boff + n * 2048 + k * 1024); } while (0)
#define PG8_MMA(ai, bj, At, Bt) do { __builtin_amdgcn_s_setprio(1); _Pragma("unroll") for (int m = 0; m < 4; ++m) _Pragma("unroll") for (int n = 0; n < 2; ++n) _Pragma("unroll") for (int k = 0; k < 2; ++k) \
        acc[ai][bj][m][n] = __builtin_amdgcn_mfma_f32_16x16x32_bf16(Bt[n][k], At[m][k], acc[ai][bj][m][n], 0, 0, 0); __builtin_amdgcn_s_setprio(0); } while (0)
#define PG8_WAIT_V(n) asm volatile("s_waitcnt vmcnt(" #n ")" ::: "memory")
#define PG8_WAIT_L(n) asm volatile("s_waitcnt lgkmcnt(" #n ")" ::: "memory")
#define PG8_BAR __builtin_amdgcn_s_barrier()
#define PG8_SCHED __builtin_amdgcn_sched_barrier(0)
    Unit cur, nxt; int ui = 0;
    if (!S.next(0, cur)) return;
    f32x4 acc[2][2][4][2];
#pragma unroll
    for (int a = 0; a < 2; ++a)
#pragma unroll
        for (int b = 0; b < 2; ++b)
#pragma unroll
            for (int m = 0; m < 4; ++m)
#pragma unroll
                for (int n = 0; n < 2; ++n) acc[a][b][m][n] = (f32x4){0.f, 0.f, 0.f, 0.f};
    bf16x8 At[4][2], B0[2][2], B1[2][2];
    const char* cA = (const char*)g.A + (size_t)cur.pm * tstep; const char* cB = (const char*)g.Bt + (size_t)cur.pn * tstep;
    S.a_ready(cur);
    if constexpr (SP2) {
        PG8_STAGE(PG8_SB(0, 0), cB, voffB); PG8_STAGE(PG8_SB(0, 1), cB + hstep, voffB); PG8_STAGE(PG8_SA(0, 0), cA, voffA); PG8_STAGE(PG8_SA(0, 1), cA + hstep, voffA);
        if (wr == 1) PG8_BAR;
        PG8_WAIT_V(2); PG8_BAR;
        PG8_STAGE(PG8_SB(1, 0), cB + kstep, voffB); PG8_STAGE(PG8_SA(1, 0), cA + kstep, voffA); PG8_STAGE(PG8_SB(1, 1), cB + hstep + kstep, voffB);
        PG8_WAIT_V(6); PG8_BAR;
    } else {
        PG8_STAGE(PG8_SB(0, 0), cB, voffB); PG8_STAGE(PG8_SA(0, 0), cA, voffA); PG8_STAGE(PG8_SB(0, 1), cB + hstep, voffB); PG8_STAGE(PG8_SA(0, 1), cA + hstep, voffA);
        if (wr == 1) PG8_BAR;
        PG8_WAIT_V(4); PG8_BAR;
        PG8_STAGE(PG8_SB(1, 0), cB + kstep, voffB); PG8_STAGE(PG8_SA(1, 0), cA + kstep, voffA); PG8_STAGE(PG8_SB(1, 1), cB + hstep + kstep, voffB);
        PG8_WAIT_V(6); PG8_BAR;
    }
    for (;;) {
        const bool has_next = S.next(ui + 1, nxt);
        const char* nA = has_next ? (const char*)g.A + (size_t)nxt.pm * tstep : cA; const char* nB = has_next ? (const char*)g.Bt + (size_t)nxt.pn * tstep : cB;
        for (int t = 0; t < nt; t += 2) {
            const bool last = (t == nt - 2);
            const char* a1 = cA + (size_t)(t + 1) * kstep;
            const char* a2 = last ? nA : cA + (size_t)(t + 2) * kstep; const char* b2 = last ? nB : cB + (size_t)(t + 2) * kstep;
            const char* a3 = a2 + kstep; const char* b3 = b2 + kstep;
            if (last && has_next) S.a_ready(nxt);
            if constexpr (SP2) {
            PG8_LDB(B0, 0, 0); PG8_LDB(B1, 0, 1); PG8_SCHED; PG8_LDA(At, 0, 0); PG8_STAGE(PG8_SA(1, 1), a1 + hstep, voffA);
            PG8_WAIT_V(8); PG8_WAIT_L(0); PG8_BAR; PG8_MMA(0, 0, At, B0); PG8_MMA(0, 1, At, B1); PG8_BAR; PG8_SCHED;
            PG8_LDA(At, 0, 1); PG8_STAGE(PG8_SB(0, 0), b2, voffB); PG8_STAGE(PG8_SB(0, 1), b2 + hstep, voffB); PG8_STAGE(PG8_SA(0, 0), a2, voffA);
            PG8_WAIT_V(8); PG8_WAIT_L(0); PG8_BAR; PG8_MMA(1, 0, At, B0); PG8_MMA(1, 1, At, B1); PG8_BAR; PG8_SCHED;
            PG8_LDB(B0, 1, 0); PG8_LDB(B1, 1, 1); PG8_SCHED; PG8_LDA(At, 1, 0); PG8_STAGE(PG8_SA(0, 1), a2 + hstep, voffA);
            PG8_WAIT_V(8); PG8_WAIT_L(0); PG8_BAR; PG8_MMA(0, 0, At, B0); PG8_MMA(0, 1, At, B1); PG8_BAR; PG8_SCHED;
            PG8_LDA(At, 1, 1); PG8_STAGE(PG8_SB(1, 0), b3, voffB); PG8_STAGE(PG8_SB(1, 1), b3 + hstep, voffB); PG8_STAGE(PG8_SA(1, 0), a3, voffA);
            PG8_WAIT_V(8); PG8_WAIT_L(0); PG8_BAR; PG8_MMA(1, 0, At, B0); PG8_MMA(1, 1, At, B1); PG8_BAR; PG8_SCHED;
            } else {
            PG8_LDB(B0, 0, 0); PG8_SCHED; PG8_LDA(At, 0, 0); PG8_STAGE(PG8_SA(1, 1), a1 + hstep, voffA);
            PG8_WAIT_L(8); PG8_BAR; PG8_WAIT_L(0); PG8_MMA(0, 0, At, B0); PG8_BAR; PG8_SCHED;
            PG8_LDB(B1, 0, 1); PG8_STAGE(PG8_SB(0, 0), b2, voffB);
            PG8_BAR; PG8_WAIT_L(0); PG8_MMA(0, 1, At, B1); PG8_BAR;
            PG8_LDA(At, 0, 1); PG8_STAGE(PG8_SA(0, 0), a2, voffA);
            PG8_BAR; PG8_WAIT_L(0); PG8_MMA(1, 0, At, B0); PG8_BAR; PG8_SCHED;
            PG8_STAGE(PG8_SB(0, 1), b2 + hstep, voffB);
            PG8_WAIT_V(6); PG8_BAR; PG8_MMA(1, 1, At, B1); PG8_BAR;
            PG8_LDB(B0, 1, 0); PG8_SCHED; PG8_LDA(At, 1, 0); PG8_STAGE(PG8_SA(0, 1), a2 + hstep, voffA);
            PG8_WAIT_L(8); PG8_BAR; PG8_WAIT_L(0); PG8_MMA(0, 0, At, B0); PG8_BAR; PG8_SCHED;
            PG8_LDB(B1, 1, 1); PG8_STAGE(PG8_SB(1, 0), b3, voffB);
            PG8_BAR; PG8_WAIT_L(0); PG8_MMA(0, 1, At, B1); PG8_BAR;
            PG8_LDA(At, 1, 1); PG8_STAGE(PG8_SA(1, 0), a3, voffA);
            PG8_BAR; PG8_WAIT_L(0); PG8_MMA(1, 0, At, B0); PG8_BAR; PG8_SCHED;
            PG8_STAGE(PG8_SB(1, 1), b3 + hstep, voffB);
            PG8_WAIT_V(6); PG8_BAR; PG8_MMA(1, 1, At, B1); PG8_BAR;
            }
        }
        if constexpr (ALIGN_EPI) { if (wr == 0) PG8_BAR; }
        if constexpr (!Epi::AFTER_DRAIN) { E(acc, cur, wr, wc, fr, fq); S.done(cur); }
        if (!has_next) break;
#pragma unroll
        for (int a = 0; a < 2; ++a)
#pragma unroll
            for (int b = 0; b < 2; ++b)
#pragma unroll
                for (int m = 0; m < 4; ++m)
#pragma unroll
                    for (int n = 0; n < 2; ++n) acc[a][b][m][n] = (f32x4){0.f, 0.f, 0.f, 0.f};
        cur = nxt; cA = nA; cB = nB; ++ui;
        if constexpr (ALIGN_EPI) { if (wr == 1) PG8_BAR; }
    }
    PG8_WAIT_V(0);
    if constexpr (!ALIGN_EPI) { if (wr == 0) PG8_BAR; }
    PG8_BAR;
    if constexpr (Epi::AFTER_DRAIN) { E.fused(acc, cur, wr, wc, fr, fq, lds, wid, lane); S.done(cur); }
#undef PG8_SA
#undef PG8_SB
#undef PG8_STAGE
#undef PG8_LDA
#undef PG8_LDB
#undef PG8_MMA
#undef PG8_WAIT_V
#undef PG8_WAIT_L
#undef PG8_BAR
#undef PG8_SCHED
}
}
#define GAS __attribute__((address_space(1)))
#define LAS __attribute__((address_space(3)))
typedef unsigned short bf16;
typedef unsigned v4u __attribute__((ext_vector_type(4)));
typedef float f32x4 __attribute__((ext_vector_type(4)));
typedef short bf16x8 __attribute__((ext_vector_type(8)));
typedef GAS unsigned gu32;
typedef GAS unsigned long long gu64;
#define RLX_AGENT __ATOMIC_RELAXED, __HIP_MEMORY_SCOPE_AGENT
#define LDS_WAIT() asm volatile("s_waitcnt lgkmcnt(0)" ::: "memory")
#define VM_WAIT() asm volatile("s_waitcnt vmcnt(0)" ::: "memory")
__device__ __forceinline__ unsigned long long rt() { return __builtin_amdgcn_s_memrealtime(); }
__device__ __forceinline__ unsigned f2bf(float f) { unsigned u = __builtin_bit_cast(unsigned, f); return (u + 0x7fffu + ((u >> 16) & 1u)) >> 16; }
__device__ __forceinline__ unsigned pk2(float lo, float hi) { return f2bf(lo) | (f2bf(hi) << 16); }
#define XB_TMO      128
#define XB_XCNT(j)  (256  + 64 * (j))
#define XB_XSUB(j)  (1280 + 64 * (j))
#define XB_XGEN(j)  (2304 + 64 * (j))
#define XB_TOP      3328
#define XB_TOPGEN   3392
#define XCD_BAR_WORDS 3456
#define XB_SPIN_CAP (1u << 18)

__device__ __forceinline__ unsigned xb_ld(unsigned* p)              { return __hip_atomic_load(p, __ATOMIC_RELAXED, __HIP_MEMORY_SCOPE_AGENT); }
__device__ __forceinline__ unsigned xb_add(unsigned* p, unsigned v) { return __hip_atomic_fetch_add(p, v, __ATOMIC_RELAXED, __HIP_MEMORY_SCOPE_AGENT); }
__device__ __forceinline__ unsigned xb_xcc_id() { return (unsigned)__builtin_amdgcn_s_getreg((3 << 11) | 20) & 0xFu; }
#define XB_SPIN(cond, bar) do { unsigned _sp = 0; while (cond) { __builtin_amdgcn_s_sleep(1); \
    if ((++_sp & 255u) == 0u) { if (xb_ld(&(bar)[XB_TMO])) break; if (_sp > XB_SPIN_CAP) { atomicAdd(&(bar)[XB_TMO], 1u); break; } } } } while (0)

struct XcdBarrier {
    unsigned* bar; unsigned x;
    volatile LAS unsigned* st;
};

__device__ __forceinline__ XcdBarrier xcd_barrier_post(unsigned* bar, volatile LAS unsigned* st) {
    XcdBarrier b; b.bar = bar; b.x = xb_xcc_id(); b.st = st;
    if (threadIdx.x == 0) (void)xb_add(&bar[XB_XCNT(b.x)], 1u);
    return b;
}
__device__ __forceinline__ void xcd_barrier_complete(unsigned* bar, unsigned x, unsigned& nloc, unsigned& nx) {
    const unsigned G = gridDim.x * gridDim.y * gridDim.z;
    unsigned sum, cnt, mine, sp = 0u;
    for (;;) {
        sum = 0u; cnt = 0u; mine = 0u;
#pragma unroll
        for (unsigned j = 0; j < 16; ++j) { const unsigned c = xb_ld(&bar[XB_XCNT(j)]); sum += c; cnt += (c > 0u) ? 1u : 0u; mine = (j == x) ? c : mine; }
        if (sum == G) break;
        __builtin_amdgcn_s_sleep(1);
        if ((++sp & 255u) == 0u) { if (xb_ld(&bar[XB_TMO])) break; if (sp > XB_SPIN_CAP) { atomicAdd(&bar[XB_TMO], 1u); break; } }
    }
    nloc = mine > 0u ? mine : 1u; nx = cnt > 0u ? cnt : 1u;
}

__device__ __forceinline__ void xcd_barrier(const XcdBarrier& b) {
    asm volatile("s_waitcnt vmcnt(0)" ::: "memory");
    __syncthreads();
    if (threadIdx.x == 0) {
        unsigned* bar = b.bar;
        __builtin_amdgcn_s_waitcnt(0);
        unsigned nloc = b.st[0], nx = b.st[1];
        if (nloc == 0u) { xcd_barrier_complete(bar, b.x, nloc, nx); b.st[0] = nloc; b.st[1] = nx; }
        const unsigned old = xb_add(&bar[XB_XSUB(b.x)], 1u);
        const unsigned gen = old / nloc;
        if (old + 1u == (gen + 1u) * nloc) {
            __builtin_amdgcn_fence(__ATOMIC_RELEASE, "agent");
            asm volatile("s_waitcnt vmcnt(0)" ::: "memory");
            const unsigned og = xb_add(&bar[XB_TOP], 1u);
            const unsigned tg = og / nx;
            if (og + 1u == (tg + 1u) * nx) xb_add(&bar[XB_TOPGEN], 1u);
            else XB_SPIN(xb_ld(&bar[XB_TOPGEN]) == tg, bar);
            __builtin_amdgcn_fence(__ATOMIC_ACQUIRE, "agent");
            xb_add(&bar[XB_XGEN(b.x)], 1u);
            asm volatile("s_waitcnt vmcnt(0)" ::: "memory");
        } else {
            XB_SPIN(xb_ld(&bar[XB_XGEN(b.x)]) == gen, bar);
            __builtin_amdgcn_fence(__ATOMIC_ACQUIRE, "agent");
            asm volatile("s_waitcnt vmcnt(0)" ::: "memory");
        }
    }
    __syncthreads();
}

constexpr int NWAVES = 8;
#ifndef NST_MAX
#define NST_MAX 31
#endif
constexpr int DM = 1024, MROWS = 17408, MP = 16384, TP = 2048, NSP = 8, NSS = 128, TS = 8;
constexpr int INW = 4608, FF = 3072, FF2 = 6144, NCI = 136, MODW = 12288;
constexpr float EPSN = 1e-6f;
constexpr int TC = 128, NCH = TP / TC;

constexpr size_t MiB = 1u << 20;
constexpr size_t WS_CTL = 0, CTL_ZERO_BYTES = 1 * MiB;
constexpr size_t WS_MOD = 1 * MiB;
constexpr size_t WS_WIN = 8 * MiB, WS_WRG = 17 * MiB, WS_WGLU = 19 * MiB, WS_WOUT = 21 * MiB, WS_WUP = 23 * MiB, WS_WDOWN = 35 * MiB;
constexpr size_t WS_SMALL = 41 * MiB;
constexpr size_t SM_WG = 0, SM_BBAR = 256 * 1024, SM_CMAT = 384 * 1024, SM_ABAR = 512 * 1024, SM_ABARTC = 528 * 1024;
constexpr size_t WS_XN = 42 * MiB;
constexpr size_t WS_RX = 76 * MiB, WS_RY = 110 * MiB, WS_SX = 144 * MiB, WS_GA = 161 * MiB, WS_GB = 195 * MiB;
constexpr size_t WS_UPH = 76 * MiB, WS_HFFH = 184 * MiB;
constexpr size_t WS_WADA = 76 * MiB, WS_SILUC = 100 * MiB;
constexpr size_t WS_AGGRG = 240 * MiB, WS_AGGS5 = 241 * MiB;
constexpr size_t WS_END = 243 * MiB;
constexpr int CW_BAR = 4096, CW_Q = 8192;

constexpr size_t O_Y = 0, O_PRGH = 17825792, O_PRGC = 17842176, O_PS5R = 17891328, O_PS5I = 17924096, O_PFFN = 17956864,
                 O_SRGH = 18153472, O_SRGC = 18415616, O_SS5R = 19202048, O_SS5I = 19726336, O_SFFN = 20250624;

constexpr int RING_BYTES = 131072, LDSCTL_OFF = RING_BYTES, MISC_OFF = LDSCTL_OFF + 320, LDS_BYTES = 147456;

typedef float f32x2 __attribute__((ext_vector_type(2)));
typedef unsigned u32x2 __attribute__((ext_vector_type(2)));

struct Args { const float* in[38]; float* out; unsigned char* ws; };

struct Frame { LAS unsigned char* lds; volatile LAS unsigned* MISC; gu32* ctl; int tid, lane, wave, vcu, G; };
__device__ __forceinline__ Frame refresh(const Frame& F0) {
    Frame F = F0; int t = threadIdx.x; asm volatile("" : "+v"(t)); int bx = blockIdx.x; asm volatile("" : "+s"(bx));
    F.tid = t; F.lane = t & 63; F.wave = __builtin_amdgcn_readfirstlane(t >> 6); F.G = gridDim.x; F.vcu = (F.G % 8 == 0) ? (bx % 8) * (F.G / 8) + bx / 8 : bx; return F;
}

__device__ __forceinline__ float bf2f(unsigned short b) { return __builtin_bit_cast(float, (unsigned)b << 16); }
__device__ __forceinline__ float bflo(unsigned w) { return __builtin_bit_cast(float, w << 16); }
__device__ __forceinline__ float bfhi(unsigned w) { return __builtin_bit_cast(float, w & 0xffff0000u); }
__device__ __forceinline__ float fsig(float x) { return __builtin_amdgcn_rcpf(1.f + __builtin_amdgcn_exp2f(-1.44269504f * x)); }
__device__ __forceinline__ float fgelu(float x) { const float u = x * (1.f + 0.044715f * x * x); return x * __builtin_amdgcn_rcpf(1.f + __builtin_amdgcn_exp2f(-2.302208198f * u)); }
__device__ __forceinline__ float wave_sum(float v) {
#pragma unroll
    for (int o = 1; o < 64; o <<= 1) v += __shfl_xor(v, o);
    return v;
}
__device__ __forceinline__ int row_ci(int row) { return row < MP ? (row >> 11) : 8 + ((row - MP) >> 3); }

namespace pg8 {
enum { EM_ADA = 0, EM_IN = 1, EM_GLU = 2, EM_RGP = 3, EM_RES = 4, EM_PLAIN = 5 };
struct EpiAny {
    static constexpr bool AFTER_DRAIN = false;
    int mode; bool perm; unsigned char* ws; const float* p0; const float* p1; const float* p2; float* out; int row_off;
    __device__ __forceinline__ void operator()(const f32x4 (&acc)[2][2][4][2], const Unit& u, int wr, int wc, int fr, int fq) const {
        asm volatile("" : "+v"(fr), "+v"(fq), "+s"(wr), "+s"(wc));
        if (mode == EM_IN || mode == EM_PLAIN) {
            const int pn = u.pn; int ldc = 1024, ct = pn; size_t wo = WS_UPH;
            if (mode == EM_IN) { if (pn < 4) { wo = WS_RX; ct = pn; } else if (pn < 8) { wo = WS_RY; ct = pn - 4; } else if (pn < 10) { wo = WS_SX; ct = pn - 8; ldc = 512; } else if (pn < 14) { wo = WS_GA; ct = pn - 10; } else { wo = WS_GB; ct = pn - 14; } }
            else ldc = FF2;
            bf16_t* base = (bf16_t*)(ws + wo);
            const int row0 = u.pm * BM + wr * 64 + fr, col0 = ct * BM + wc * 32 + 8 * fq, bcol0 = pn * BM + wc * 32 + 8 * fq;
#pragma unroll
            for (int bj = 0; bj < 2; ++bj) {
                f32x4 b0 = {0.f, 0.f, 0.f, 0.f}, b1 = {0.f, 0.f, 0.f, 0.f};
                if (mode == EM_IN) { b0 = *(const f32x4*)(p0 + bcol0 + bj * HALF); b1 = *(const f32x4*)(p0 + bcol0 + bj * HALF + 4); }
#pragma unroll
                for (int ai = 0; ai < 2; ++ai)
#pragma unroll
                    for (int m = 0; m < 4; ++m) { bf16_t* rowp = base + (size_t)(row0 + ai * HALF + m * 16) * ldc + col0;
                        const f32x4 v0 = acc[ai][bj][m][0] + b0, v1 = acc[ai][bj][m][1] + b1;
                        u32x4 w; w.x = cvt_pk_bf16(v0[0], v0[1]); w.y = cvt_pk_bf16(v0[2], v0[3]); w.z = cvt_pk_bf16(v1[0], v1[1]); w.w = cvt_pk_bf16(v1[2], v1[3]);
                        *(u32x4*)(rowp + bj * HALF) = w; } }
        } else if (mode == EM_GLU) {
            bf16_t* GB = (bf16_t*)(ws + WS_GB);
            const int row0 = u.pm * BM + wr * 64 + fr, col0 = u.pn * HALF + wc * 32 + 8 * fq;
#pragma unroll
            for (int ai = 0; ai < 2; ++ai)
#pragma unroll
                for (int m = 0; m < 4; ++m) { bf16_t* p = GB + (size_t)(row0 + ai * HALF + m * 16) * 1024 + col0;
                    const u32x4 g = *(const u32x4*)p; float gv[8] = {bflo(g.x), bfhi(g.x), bflo(g.y), bfhi(g.y), bflo(g.z), bfhi(g.z), bflo(g.w), bfhi(g.w)}; float o[8];
#pragma unroll
                    for (int n = 0; n < 2; ++n)
#pragma unroll
                        for (int j = 0; j < 4; ++j) o[4 * n + j] = fsig(gv[4 * n + j]) * acc[ai][0][m][n][j] * fsig(acc[ai][1][m][n][j]);
                    u32x4 w; w.x = cvt_pk_bf16(o[0], o[1]); w.y = cvt_pk_bf16(o[2], o[3]); w.z = cvt_pk_bf16(o[4], o[5]); w.w = cvt_pk_bf16(o[6], o[7]);
                    *(u32x4*)p = w; }
        } else if (mode == EM_RGP) {
            bf16_t* GA = (bf16_t*)(ws + WS_GA); const bf16_t* GB = (const bf16_t*)(ws + WS_GB);
            const int row0 = u.pm * BM + wr * 64 + fr, col0 = u.pn * BM + wc * 32 + 8 * fq;
#pragma unroll
            for (int ai = 0; ai < 2; ++ai)
#pragma unroll
                for (int m = 0; m < 4; ++m)
#pragma unroll
                    for (int bj = 0; bj < 2; ++bj) { const size_t off = (size_t)(row0 + ai * HALF + m * 16) * 1024 + col0 + bj * HALF;
                        const u32x4 g = *(const u32x4*)(GA + off), b = *(const u32x4*)(GB + off);
                        float gv[8] = {bflo(g.x), bfhi(g.x), bflo(g.y), bfhi(g.y), bflo(g.z), bfhi(g.z), bflo(g.w), bfhi(g.w)};
                        float bv[8] = {bflo(b.x), bfhi(b.x), bflo(b.y), bfhi(b.y), bflo(b.z), bfhi(b.z), bflo(b.w), bfhi(b.w)}; float o[8];
#pragma unroll
                        for (int n = 0; n < 2; ++n)
#pragma unroll
                            for (int j = 0; j < 4; ++j) o[4 * n + j] = fsig(gv[4 * n + j]) * acc[ai][bj][m][n][j] + bv[4 * n + j];
                        u32x4 w; w.x = cvt_pk_bf16(o[0], o[1]); w.y = cvt_pk_bf16(o[2], o[3]); w.z = cvt_pk_bf16(o[4], o[5]); w.w = cvt_pk_bf16(o[6], o[7]);
                        *(u32x4*)(GA + off) = w; }
        } else if (mode == EM_RES) {
            const int col0 = u.pn * BM + wc * 32 + 4 * fq;
#pragma unroll
            for (int ai = 0; ai < 2; ++ai)
#pragma unroll
                for (int m = 0; m < 4; ++m) { const int r = row_off + u.pm * BM + ai * HALF + wr * 64 + m * 16 + fr; const float* src = (r < MP) ? p0 : p1; const float* gt = p2 + (size_t)row_ci(r) * MODW;
#pragma unroll
                    for (int bj = 0; bj < 2; ++bj)
#pragma unroll
                        for (int n = 0; n < 2; ++n) { const int c = col0 + bj * HALF + n * 16; const size_t off = (size_t)r * DM + c;
                            *(f32x4*)(out + off) = *(const f32x4*)(src + off) + *(const f32x4*)(gt + c) * acc[ai][bj][m][n]; } }
        } else {
            const int col0 = u.pn * BM + wc * 32 + 4 * fq;
#pragma unroll
            for (int ai = 0; ai < 2; ++ai)
#pragma unroll
                for (int m = 0; m < 4; ++m) { const int r = ai * HALF + wr * 64 + m * 16 + fr;
                    if (r < NCI) {
#pragma unroll
                        for (int bj = 0; bj < 2; ++bj)
#pragma unroll
                            for (int n = 0; n < 2; ++n) { const int c = col0 + bj * HALF + n * 16; *(f32x4*)(out + (size_t)r * MODW + c) = acc[ai][bj][m][n] + *(const f32x4*)(p0 + c); } } }
        }
    }
};
}

template <int MAP> __device__ __forceinline__ int wt_row(int n) {
    if (MAP == 1) { return n < 1024 ? ((n >> 7) << 8) + (n & 127) : (((n - 1024) >> 7) << 8) + 128 + (n & 127); }
    return n;
}
template <int MAP> __device__ __forceinline__ void p0_transpose_item(const float* W, int K, int N, bf16* WT, int row_off, LAS float* scr, int item, int lane) {
    const int nblk = N / 32, kb = item / nblk, nb = item % nblk, k0 = 64 * kb, n0 = 32 * nb;
#pragma unroll 8
    for (int i = 0; i < 32; ++i) { const int kk = 2 * i + (lane >> 5); scr[kk * 33 + (lane & 31)] = W[(size_t)(k0 + kk) * N + n0 + (lane & 31)]; }
    LDS_WAIT(); asm volatile("" ::: "memory");
    const int c = lane & 7;
#pragma unroll
    for (int j = 0; j < 4; ++j) { const int n = (lane >> 3) + 8 * j; const LAS float* s = scr + (8 * c) * 33 + n;
        v4u o; o.x = pk2(s[0 * 33], s[1 * 33]); o.y = pk2(s[2 * 33], s[3 * 33]); o.z = pk2(s[4 * 33], s[5 * 33]); o.w = pk2(s[6 * 33], s[7 * 33]);
        *(GAS v4u*)(WT + (size_t)(row_off + wt_row<MAP>(n0 + n)) * K + k0 + 8 * c) = o; }
    LDS_WAIT(); asm volatile("" ::: "memory");
}

__device__ __forceinline__ void p0_weights(const Frame& F0, const Args& A, int l, bool first) {
    const Frame F = refresh(F0);
    unsigned char* ws = A.ws;
    LAS float* scr = (LAS float*)(F.lds + F.wave * 16384);
    const int gw = F.vcu * NWAVES + F.wave, NGW = F.G * NWAVES;
    constexpr int I_IN = (DM / 64) * (INW / 32), I_SQ = (DM / 64) * (DM / 32), I_GLU = (512 / 64) * (2048 / 32), I_UP = (DM / 64) * (FF2 / 32), I_DN = (FF / 64) * (DM / 32), I_ADA = (DM / 64) * (FF2 / 32);
    const int nitems = I_IN + 2 * I_SQ + I_GLU + I_UP + I_DN + (first ? 2 * I_ADA : 0);
    for (int it = gw; it < nitems; it += NGW) {
        int r = it;
        if (r < I_IN) { p0_transpose_item<0>(A.in[13] + (size_t)l * DM * INW, DM, INW, (bf16*)(ws + WS_WIN), 0, scr, r, F.lane); continue; } r -= I_IN;
        if (r < I_SQ) { p0_transpose_item<0>(A.in[30] + (size_t)l * DM * DM, DM, DM, (bf16*)(ws + WS_WRG), 0, scr, r, F.lane); continue; } r -= I_SQ;
        if (r < I_SQ) { p0_transpose_item<0>(A.in[32] + (size_t)l * DM * DM, DM, DM, (bf16*)(ws + WS_WOUT), 0, scr, r, F.lane); continue; } r -= I_SQ;
        if (r < I_GLU) { p0_transpose_item<1>(A.in[31] + (size_t)l * 512 * 2048, 512, 2048, (bf16*)(ws + WS_WGLU), 0, scr, r, F.lane); continue; } r -= I_GLU;
        if (r < I_UP) { p0_transpose_item<0>(A.in[33] + (size_t)l * DM * FF2, DM, FF2, (bf16*)(ws + WS_WUP), 0, scr, r, F.lane); continue; } r -= I_UP;
        if (r < I_DN) { p0_transpose_item<0>(A.in[36] + (size_t)l * FF * DM, FF, DM, (bf16*)(ws + WS_WDOWN), 0, scr, r, F.lane); continue; } r -= I_DN;
        if (r < I_ADA) { p0_transpose_item<0>(A.in[9], DM, FF2, (bf16*)(ws + WS_WADA), 0, scr, r, F.lane); continue; } r -= I_ADA;
        p0_transpose_item<0>(A.in[9] + (size_t)DM * FF2, DM, FF2, (bf16*)(ws + WS_WADA), FF2, scr, r, F.lane);
    }
    const int gt = F.vcu * (NWAVES * 64) + F.tid, NGT = F.G * NWAVES * 64;
    bf16* WG = (bf16*)(ws + WS_SMALL + SM_WG);
    for (int e = gt; e < 2 * 16 * 4096; e += NGT) { const int gate = e >> 16, rem = e & 65535, h = rem >> 12, j = (rem >> 6) & 63, i = rem & 63;
        const float* src = (gate ? A.in[19] : A.in[17]) + (size_t)l * 65536 + h * 4096 + i * 64 + j;
        WG[((h * 2 + gate) * 64 + j) * 64 + i] = (bf16)f2bf(*src); }
    for (int e = gt; e < 2048; e += NGT) { const int g = e >> 6, p = e & 63;
        const float dt = expf(A.in[29][l * 32 + g]);
        const float lr = A.in[22][l * 2048 + e], li = A.in[23][l * 2048 + e];
        const float mag = expf(lr * dt); float sn, cs; sincosf(li * dt, &sn, &cs);
        const float ar = mag * cs, ai = mag * sn, den = lr * lr + li * li;
        const float zr = ((ar - 1.f) * lr + ai * li) / den, zi = (ai * lr - (ar - 1.f) * li) / den;
        float* AB = (float*)(ws + WS_SMALL + SM_ABAR); AB[e * 2] = ar; AB[e * 2 + 1] = ai;
        float pr = ar, pi = ai;
#pragma unroll 1
        for (int s = 0; s < 7; ++s) { const float nr = pr * pr - pi * pi, ni = 2.f * pr * pi; pr = nr; pi = ni; }
        float* ABT = (float*)(ws + WS_SMALL + SM_ABARTC); ABT[e * 2] = pr; ABT[e * 2 + 1] = pi;
        bf16* BB = (bf16*)(ws + WS_SMALL + SM_BBAR) + (size_t)g * 128 * 16;
        const float* bre = A.in[24] + ((size_t)l * 2048 + e) * 16; const float* bim = A.in[25] + ((size_t)l * 2048 + e) * 16;
#pragma unroll 4
        for (int c = 0; c < 16; ++c) { const float br = bre[c], bi = bim[c]; BB[p * 16 + c] = (bf16)f2bf(zr * br - zi * bi); BB[(64 + p) * 16 + c] = (bf16)f2bf(zr * bi + zi * br); }
        bf16* CM = (bf16*)(ws + WS_SMALL + SM_CMAT) + (size_t)g * 16 * 128;
        const float* cre = A.in[26] + ((size_t)l * 32 + g) * 1024; const float* cim = A.in[27] + ((size_t)l * 32 + g) * 1024;
#pragma unroll 4
        for (int c = 0; c < 16; ++c) { CM[c * 128 + p] = (bf16)f2bf(cre[c * 64 + p]); CM[c * 128 + 64 + p] = (bf16)f2bf(-cim[c * 64 + p]); }
    }
    if (first) {
        bf16* SC = (bf16*)(ws + WS_SILUC);
        for (int e = gt; e < 256 * DM; e += NGT) { const int r = e >> 10, c = e & 1023; float v = 0.f;
            if (r < NSP) v = A.in[7][r * DM + c]; else if (r < NCI) v = A.in[8][(r - NSP) * DM + c];
            SC[e] = (bf16)f2bf(v * fsig(v)); }
    }
}

__device__ __forceinline__ void norm_rows(const Frame& F0, const float* xp, const float* xs_adj, const float* g, const float* mod_sh, const float* mod_sc, bf16* XN) {
    const Frame F = refresh(F0);
    const int gw = F.vcu * NWAVES + F.wave, NGW = F.G * NWAVES;
    for (int m = gw; m < MROWS; m += NGW) {
        const float* xrow = (m < MP ? xp : xs_adj) + (size_t)m * DM; const int ci = row_ci(m);
        const GAS f32x4* xr = (const GAS f32x4*)xrow + F.lane;
        f32x4 v[4]; float s = 0.f;
#pragma unroll
        for (int j = 0; j < 4; ++j) { v[j] = xr[64 * j]; s += (v[j].x * v[j].x + v[j].y * v[j].y) + (v[j].z * v[j].z + v[j].w * v[j].w); }
        const float rstd = 1.f / sqrtf(wave_sum(s) * (1.f / DM) + EPSN);
        GAS unsigned long long* o8 = (GAS unsigned long long*)(XN + (size_t)m * DM) + F.lane;
#pragma unroll
        for (int j = 0; j < 4; ++j) { const int c = 256 * j + 4 * F.lane;
            const f32x4 gg = *(const f32x4*)(g + c), sh = *(const f32x4*)(mod_sh + (size_t)ci * MODW + c), sc = *(const f32x4*)(mod_sc + (size_t)ci * MODW + c);
            const f32x4 y = v[j] * rstd * gg * (sc + 1.f) + sh;
            o8[64 * j] = (unsigned long long)pk2(y.x, y.y) | ((unsigned long long)pk2(y.z, y.w) << 32); }
    }
}
__device__ __forceinline__ void final_norm(const Frame& F0, float* x, const float* g) {
    const Frame F = refresh(F0);
    const int gw = F.vcu * NWAVES + F.wave, NGW = F.G * NWAVES;
    for (int m = gw; m < MROWS; m += NGW) {
        GAS f32x4* xr = (GAS f32x4*)(x + (size_t)m * DM) + F.lane;
        f32x4 v[4]; float s = 0.f;
#pragma unroll
        for (int j = 0; j < 4; ++j) { v[j] = xr[64 * j]; s += (v[j].x * v[j].x + v[j].y * v[j].y) + (v[j].z * v[j].z + v[j].w * v[j].w); }
        const float rstd = 1.f / sqrtf(wave_sum(s) * (1.f / DM) + EPSN);
#pragma unroll
        for (int j = 0; j < 4; ++j) { const f32x4 gg = *(const f32x4*)(g + 256 * j + 4 * F.lane); xr[64 * j] = v[j] * rstd * gg; }
    }
}

__device__ __forceinline__ void cvt8(const v4u w, float (&o)[8]) { o[0] = bflo(w.x); o[1] = bfhi(w.x); o[2] = bflo(w.y); o[3] = bfhi(w.y); o[4] = bflo(w.z); o[5] = bfhi(w.z); o[6] = bflo(w.w); o[7] = bfhi(w.w); }

template <int MODE> __device__ __forceinline__ void rg_unit(const Frame& F, const Args& A, int l, bool sample, int s, int c, int h) {
    unsigned char* ws = A.ws;
    LAS float* TAB = (LAS float*)(F.lds + F.wave * 15360);
    LAS float* XC = TAB + 512;
    LAS float* AA = XC + 16 * 68;
    LAS float* BB = AA + 16 * 68;
    const int lane = F.lane, fr = lane & 15, fq = lane >> 4, ch0 = 64 * h;
    const bf16* RX = (const bf16*)(ws + WS_RX); bf16* RY = (bf16*)(ws + WS_RY);
    {
        const int chg = l * DM + ch0 + lane;
#pragma unroll
        for (int j = 0; j < 4; ++j) TAB[j * 64 + lane] = A.in[15][(size_t)(l * 4 + j) * DM + ch0 + lane];
        TAB[4 * 64 + lane] = A.in[16][chg]; TAB[5 * 64 + lane] = A.in[18][chg]; TAB[6 * 64 + lane] = A.in[20][chg];
        const float lam = A.in[21][chg]; TAB[7 * 64 + lane] = -8.f * 1.44269504f * log1pf(expf(-lam));
    }
    bf16x8 Wf[2][4][2];
    { const bf16* WG = (const bf16*)(ws + WS_SMALL + SM_WG);
#pragma unroll
      for (int g = 0; g < 2; ++g)
#pragma unroll
        for (int n = 0; n < 4; ++n)
#pragma unroll
            for (int k = 0; k < 2; ++k) Wf[g][n][k] = *(const bf16x8*)(WG + ((h * 2 + g) * 64 + 16 * n + fr) * 64 + 32 * k + 8 * fq); }
    LDS_WAIT(); asm volatile("" ::: "memory");
    const int rbase = sample ? MP + s * 128 : s * TP + c * TC;
    float hst = 0.f, aprod = 1.f;
    if (MODE == 1 && !sample) {
        const float* AG = (const float*)(ws + WS_AGGRG) + ((size_t)(s * NCH) * DM + ch0 + lane) * 2;
        for (int cc = 0; cc < c; ++cc) { const float a = AG[(size_t)cc * DM * 2], b = AG[(size_t)cc * DM * 2 + 1]; hst = a * hst + b; }
    }
#pragma unroll 1
    for (int tile = 0; tile < 8; ++tile) {
        const int row = rbase + 16 * tile + fr;
        const int t = sample ? (fr & 7) : c * TC + 16 * tile + fr;
        const int sq = sample ? s * 16 + tile * 2 + (fr >> 3) : s;
        bf16x8 X[2];
#pragma unroll
        for (int k = 0; k < 2; ++k) {
            const int cl = 32 * k + 8 * fq; float xc[8];
            { const f32x4 b0 = *(const LAS f32x4*)(TAB + 4 * 64 + cl), b1 = *(const LAS f32x4*)(TAB + 4 * 64 + cl + 4); xc[0] = b0.x; xc[1] = b0.y; xc[2] = b0.z; xc[3] = b0.w; xc[4] = b1.x; xc[5] = b1.y; xc[6] = b1.z; xc[7] = b1.w; }
#pragma unroll
            for (int d = 0; d < 4; ++d) {
                float v[8];
                if (t - d >= 0) { cvt8(*(const v4u*)(RX + (size_t)(row - d) * DM + ch0 + cl), v); }
                else if (sample) { const float* st = A.in[3] + ((size_t)(sq * 2 + l) * 3 + (3 + t - d)) * DM + ch0 + cl; const f32x4 a0 = *(const f32x4*)st, a1 = *(const f32x4*)(st + 4);
                    v[0] = a0.x; v[1] = a0.y; v[2] = a0.z; v[3] = a0.w; v[4] = a1.x; v[5] = a1.y; v[6] = a1.z; v[7] = a1.w; }
                else {
#pragma unroll
                    for (int q = 0; q < 8; ++q) v[q] = 0.f; }
                const f32x4 w0 = *(const LAS f32x4*)(TAB + (3 - d) * 64 + cl), w1 = *(const LAS f32x4*)(TAB + (3 - d) * 64 + cl + 4);
                xc[0] += w0.x * v[0]; xc[1] += w0.y * v[1]; xc[2] += w0.z * v[2]; xc[3] += w0.w * v[3]; xc[4] += w1.x * v[4]; xc[5] += w1.y * v[5]; xc[6] += w1.z * v[6]; xc[7] += w1.w * v[7];
            }
            *(LAS f32x4*)(XC + fr * 68 + cl) = (f32x4){xc[0], xc[1], xc[2], xc[3]}; *(LAS f32x4*)(XC + fr * 68 + cl + 4) = (f32x4){xc[4], xc[5], xc[6], xc[7]};
            v4u pk; pk.x = pk2(xc[0], xc[1]); pk.y = pk2(xc[2], xc[3]); pk.z = pk2(xc[4], xc[5]); pk.w = pk2(xc[6], xc[7]);
            X[k] = __builtin_bit_cast(bf16x8, pk);
        }
        f32x4 acc[2][4];
#pragma unroll
        for (int g = 0; g < 2; ++g)
#pragma unroll
            for (int n = 0; n < 4; ++n) { acc[g][n] = (f32x4){0.f, 0.f, 0.f, 0.f};
#pragma unroll
                for (int k = 0; k < 2; ++k) acc[g][n] = __builtin_amdgcn_mfma_f32_16x16x32_bf16(Wf[g][n][k], X[k], acc[g][n], 0, 0, 0); }
        LDS_WAIT(); asm volatile("" ::: "memory");
#pragma unroll
        for (int n = 0; n < 4; ++n) { const int cl = 16 * n + 4 * fq;
            const f32x4 xv = *(const LAS f32x4*)(XC + fr * 68 + cl), ba = *(const LAS f32x4*)(TAB + 5 * 64 + cl), bx = *(const LAS f32x4*)(TAB + 6 * 64 + cl), c8 = *(const LAS f32x4*)(TAB + 7 * 64 + cl);
            f32x4 av, bv;
#pragma unroll
            for (int j = 0; j < 4; ++j) { const float r = fsig(acc[0][n][j] + ba[j]), ig = fsig(acc[1][n][j] + bx[j]); const float a = __builtin_amdgcn_exp2f(r * c8[j]);
                av[j] = a; bv[j] = sqrtf(fmaxf(1.f - a * a, 0.f)) * ig * xv[j]; }
            *(LAS f32x4*)(AA + fr * 68 + cl) = av; *(LAS f32x4*)(BB + fr * 68 + cl) = bv; }
        LDS_WAIT(); asm volatile("" ::: "memory");
#pragma unroll
        for (int tt = 0; tt < 16; ++tt) {
            if (sample && (tt & 7) == 0) hst = A.in[2][(size_t)((s * 16 + tile * 2 + (tt >> 3)) * 2 + l) * DM + ch0 + lane];
            const float a = AA[tt * 68 + lane], b = BB[tt * 68 + lane];
            hst = a * hst + b; if (MODE == 0) aprod *= a;
            if (MODE == 1) BB[tt * 68 + lane] = hst;
            if (MODE == 1 && sample && (tt & 7) == 7) A.out[O_SRGH + (size_t)((s * 16 + tile * 2 + (tt >> 3)) * 2 + l) * DM + ch0 + lane] = hst;
        }
        if (MODE == 1) {
            LDS_WAIT(); asm volatile("" ::: "memory");
#pragma unroll
            for (int n = 0; n < 4; ++n) { const int cl = 16 * n + 4 * fq; const f32x4 hv = *(const LAS f32x4*)(BB + fr * 68 + cl);
                bf16* p = RY + (size_t)row * DM + ch0 + cl; const u32x2 ry = *(const u32x2*)p;
                u32x2 o; o.x = pk2(hv.x * fgelu(bflo(ry.x)), hv.y * fgelu(bfhi(ry.x))); o.y = pk2(hv.z * fgelu(bflo(ry.y)), hv.w * fgelu(bfhi(ry.y)));
                *(u32x2*)p = o; }
            LDS_WAIT(); asm volatile("" ::: "memory");
        }
    }
    if (MODE == 0) { float* AG = (float*)(ws + WS_AGGRG) + ((size_t)(s * NCH + c) * DM + ch0 + lane) * 2; AG[0] = aprod; AG[1] = hst; }
    if (MODE == 1) {
        if (!sample && c == NCH - 1) {
            A.out[O_PRGH + (size_t)(s * 2 + l) * DM + ch0 + lane] = hst;
#pragma unroll
            for (int k = 0; k < 3; ++k) A.out[O_PRGC + (size_t)((s * 2 + l) * 3 + k) * DM + ch0 + lane] = bf2f(RX[(size_t)(s * TP + TP - 3 + k) * DM + ch0 + lane]);
        }
        if (sample) {
#pragma unroll 1
            for (int q = 0; q < 16; ++q) { const int n = s * 16 + q;
#pragma unroll
                for (int k = 0; k < 3; ++k) A.out[O_SRGC + (size_t)((n * 2 + l) * 3 + k) * DM + ch0 + lane] = bf2f(RX[(size_t)(MP + n * TS + 5 + k) * DM + ch0 + lane]); }
        }
    }
}

template <int MODE> __device__ __forceinline__ void s5_unit(const Frame& F, const Args& A, int l, bool sample, int s, int c, int g) {
    unsigned char* ws = A.ws;
    LAS float* BU = (LAS float*)(F.lds + F.wave * 15360);
    LAS bf16* XS = (LAS bf16*)(F.lds + F.wave * 15360 + 16 * 132 * 4);
    const int lane = F.lane, fr = lane & 15, fq = lane >> 4;
    bf16* SX = (bf16*)(ws + WS_SX);
    bf16x8 Bf[8], Cf[4];
    { const bf16* BBm = (const bf16*)(ws + WS_SMALL + SM_BBAR) + (size_t)g * 128 * 16;
#pragma unroll
      for (int n = 0; n < 8; ++n) { v4u z = {0u, 0u, 0u, 0u}; if (fq < 2) z = *(const v4u*)(BBm + (16 * n + fr) * 16 + 8 * fq); Bf[n] = __builtin_bit_cast(bf16x8, z); }
      const bf16* CM = (const bf16*)(ws + WS_SMALL + SM_CMAT) + (size_t)g * 16 * 128;
#pragma unroll
      for (int kk = 0; kk < 4; ++kk) Cf[kk] = *(const bf16x8*)(CM + fr * 128 + 32 * kk + 8 * fq); }
    const float ar = ((const float*)(ws + WS_SMALL + SM_ABAR))[(g * 64 + lane) * 2], ai = ((const float*)(ws + WS_SMALL + SM_ABAR))[(g * 64 + lane) * 2 + 1];
    const f32x4 dv = *(const f32x4*)(A.in[28] + l * 512 + 16 * g + 4 * fq);
    const int rbase = sample ? MP + s * 128 : s * TP + c * TC;
    float xr = 0.f, xi = 0.f;
    if (MODE == 1 && !sample) {
        const float tr = ((const float*)(ws + WS_SMALL + SM_ABARTC))[(g * 64 + lane) * 2], ti = ((const float*)(ws + WS_SMALL + SM_ABARTC))[(g * 64 + lane) * 2 + 1];
        const float* AG = (const float*)(ws + WS_AGGS5) + ((size_t)(s * NCH) * 2048 + g * 64 + lane) * 2;
        for (int cc = 0; cc < c; ++cc) { const float er = AG[(size_t)cc * 4096], ei = AG[(size_t)cc * 4096 + 1]; const float nr = tr * xr - ti * xi + er, ni = tr * xi + ti * xr + ei; xr = nr; xi = ni; }
    }
#pragma unroll 1
    for (int tile = 0; tile < 8; ++tile) {
        const int row = rbase + 16 * tile + fr;
        v4u uz = {0u, 0u, 0u, 0u}; if (fq < 2) uz = *(const v4u*)(SX + (size_t)row * 512 + 16 * g + 8 * fq);
        const bf16x8 U = __builtin_bit_cast(bf16x8, uz);
#pragma unroll
        for (int n = 0; n < 8; ++n) { f32x4 a = __builtin_amdgcn_mfma_f32_16x16x32_bf16(Bf[n], U, (f32x4){0.f, 0.f, 0.f, 0.f}, 0, 0, 0);
            *(LAS f32x4*)(BU + fr * 132 + 16 * n + 4 * fq) = a; }
        LDS_WAIT(); asm volatile("" ::: "memory");
#pragma unroll
        for (int tt = 0; tt < 16; ++tt) {
            if (sample && (tt & 7) == 0) { const size_t si = ((size_t)((s * 16 + tile * 2 + (tt >> 3)) * 2 + l) * 32 + g) * 64 + lane; xr = A.in[4][si]; xi = A.in[5][si]; }
            const float br = BU[tt * 132 + lane], bi = BU[tt * 132 + 64 + lane];
            const float nr = ar * xr - ai * xi + br, ni = ar * xi + ai * xr + bi; xr = nr; xi = ni;
            if (MODE == 1) { XS[tt * 136 + lane] = (bf16)f2bf(xr); XS[tt * 136 + 64 + lane] = (bf16)f2bf(xi); }
            if (MODE == 1 && sample && (tt & 7) == 7) { const size_t si = ((size_t)((s * 16 + tile * 2 + (tt >> 3)) * 2 + l) * 32 + g) * 64 + lane; A.out[O_SS5R + si] = xr; A.out[O_SS5I + si] = xi; }
        }
        if (MODE == 1) {
            LDS_WAIT(); asm volatile("" ::: "memory");
            f32x4 y = {0.f, 0.f, 0.f, 0.f};
#pragma unroll
            for (int kk = 0; kk < 4; ++kk) { const bf16x8 xb = *(const LAS bf16x8*)(XS + fr * 136 + 32 * kk + 8 * fq); y = __builtin_amdgcn_mfma_f32_16x16x32_bf16(Cf[kk], xb, y, 0, 0, 0); }
            bf16* p = SX + (size_t)row * 512 + 16 * g + 4 * fq; const u32x2 sx = *(const u32x2*)p;
            u32x2 o; o.x = pk2(fgelu(y.x + dv.x * bflo(sx.x)), fgelu(y.y + dv.y * bfhi(sx.x))); o.y = pk2(fgelu(y.z + dv.z * bflo(sx.y)), fgelu(y.w + dv.w * bfhi(sx.y)));
            *(u32x2*)p = o;
        }
        LDS_WAIT(); asm volatile("" ::: "memory");
    }
    if (MODE == 0) { float* AG = (float*)(ws + WS_AGGS5) + ((size_t)(s * NCH + c) * 2048 + g * 64 + lane) * 2; AG[0] = xr; AG[1] = xi; }
    if (MODE == 1 && !sample && c == NCH - 1) { const size_t si = ((size_t)(s * 2 + l) * 32 + g) * 64 + lane; A.out[O_PS5R + si] = xr; A.out[O_PS5I + si] = xi; }
}

template <int MODE> __device__ __forceinline__ void mixer_phase(const Frame& F0, const Args& A, int l) {
    const Frame F = refresh(F0);
    gu32* q = F.ctl + CW_Q + 64 * (l * 2 + MODE);
    constexpr int NC = MODE == 0 ? NCH - 1 : NCH;
    constexpr int N_RGP = NSP * NC * 16, N_RGS = MODE == 0 ? 0 : 8 * 16, N_S5P = NSP * NC * 32, N_S5S = MODE == 0 ? 0 : 8 * 32;
    constexpr int NTOT = N_RGP + N_RGS + N_S5P + N_S5S;
    for (;;) {
        int u = 0; if (F.lane == 0) u = (int)__hip_atomic_fetch_add(q, 1u, __ATOMIC_RELAXED, __HIP_MEMORY_SCOPE_AGENT);
        u = __builtin_amdgcn_readfirstlane(u);
        if (u >= NTOT) break;
        if (u < N_RGP) { const int h = u & 15, r = u >> 4, c = r % NC, s = r / NC; rg_unit<MODE>(F, A, l, false, s, c, h); continue; } u -= N_RGP;
        if (u < N_RGS) { rg_unit<MODE>(F, A, l, true, u >> 4, 0, u & 15); continue; } u -= N_RGS;
        if (u < N_S5P) { const int g = u & 31, r = u >> 5, c = r % NC, s = r / NC; s5_unit<MODE>(F, A, l, false, s, c, g); continue; } u -= N_S5P;
        s5_unit<MODE>(F, A, l, true, u >> 5, 0, u & 31);
    }
}

__device__ __forceinline__ void ffn_conv_phase(const Frame& F0, const Args& A, int l, int row_lo, int nrows) {
    const Frame F = refresh(F0);
    const bf16* UP = (const bf16*)(A.ws + WS_UPH); bf16* HF = (bf16*)(A.ws + WS_HFFH);
    const int gt = F.vcu * (NWAVES * 64) + F.tid, NGT = F.G * NWAVES * 64;
    const int nstrip = nrows / 32, nitem = nstrip * 384;
    const float* cw = A.in[34] + (size_t)l * 3 * FF2; const float* cb = A.in[35] + (size_t)l * FF2;
    for (int it = gt; it < nitem; it += NGT) {
        const int co = it % 384, strip = it / 384, c0 = 8 * co;
        float w[2][3][8], bb[2][8];
#pragma unroll
        for (int hh = 0; hh < 2; ++hh) {
#pragma unroll
            for (int j = 0; j < 3; ++j) { const f32x4 a = *(const f32x4*)(cw + j * FF2 + hh * FF + c0), b = *(const f32x4*)(cw + j * FF2 + hh * FF + c0 + 4);
                w[hh][j][0] = a.x; w[hh][j][1] = a.y; w[hh][j][2] = a.z; w[hh][j][3] = a.w; w[hh][j][4] = b.x; w[hh][j][5] = b.y; w[hh][j][6] = b.z; w[hh][j][7] = b.w; }
            const f32x4 a = *(const f32x4*)(cb + hh * FF + c0), b = *(const f32x4*)(cb + hh * FF + c0 + 4);
            bb[hh][0] = a.x; bb[hh][1] = a.y; bb[hh][2] = a.z; bb[hh][3] = a.w; bb[hh][4] = b.x; bb[hh][5] = b.y; bb[hh][6] = b.z; bb[hh][7] = b.w;
        }
        float p1[2][8], p2[2][8];
        const int lr0 = strip * 32;
#pragma unroll 1
        for (int i = 0; i < 32; ++i) {
            const int lr = lr0 + i, row = row_lo + lr;
            const bool smp = row >= MP; const int t = smp ? ((row - MP) & 7) : (row & (TP - 1)); const int T = smp ? TS : TP;
            const int sq = smp ? ((row - MP) >> 3) : (row >> 11);
            if (t == 0) {
#pragma unroll
                for (int hh = 0; hh < 2; ++hh)
#pragma unroll
                    for (int q = 0; q < 8; ++q) { if (smp) { const float* st = A.in[6] + ((size_t)(sq * 2 + l) * 2) * FF2 + hh * FF + c0 + q; p2[hh][q] = st[0]; p1[hh][q] = st[FF2]; } else { p1[hh][q] = 0.f; p2[hh][q] = 0.f; } }
            } else if (i == 0) {
#pragma unroll
                for (int hh = 0; hh < 2; ++hh) { cvt8(*(const v4u*)(UP + (size_t)(lr - 1) * FF2 + hh * FF + c0), p1[hh]);
                    if (t >= 2) cvt8(*(const v4u*)(UP + (size_t)(lr - 2) * FF2 + hh * FF + c0), p2[hh]);
                    else {
#pragma unroll
                        for (int q = 0; q < 8; ++q) p2[hh][q] = smp ? A.in[6][((size_t)(sq * 2 + l) * 2 + 1) * FF2 + hh * FF + c0 + q] : 0.f; } }
            }
            float cur[2][8], uc[2][8];
#pragma unroll
            for (int hh = 0; hh < 2; ++hh) { cvt8(*(const v4u*)(UP + (size_t)lr * FF2 + hh * FF + c0), cur[hh]);
#pragma unroll
                for (int q = 0; q < 8; ++q) uc[hh][q] = bb[hh][q] + w[hh][0][q] * p2[hh][q] + w[hh][1][q] * p1[hh][q] + w[hh][2][q] * cur[hh][q]; }
            v4u o; o.x = pk2(fgelu(uc[0][0]) * uc[1][0], fgelu(uc[0][1]) * uc[1][1]); o.y = pk2(fgelu(uc[0][2]) * uc[1][2], fgelu(uc[0][3]) * uc[1][3]);
            o.z = pk2(fgelu(uc[0][4]) * uc[1][4], fgelu(uc[0][5]) * uc[1][5]); o.w = pk2(fgelu(uc[0][6]) * uc[1][6], fgelu(uc[0][7]) * uc[1][7]);
            *(v4u*)(HF + (size_t)lr * FF + c0) = o;
            if (t == T - 1) {
                float* so = A.out + (smp ? O_SFFN : O_PFFN) + ((size_t)(sq * 2 + l) * 2) * FF2;
#pragma unroll
                for (int hh = 0; hh < 2; ++hh)
#pragma unroll
                    for (int q = 0; q < 8; ++q) { so[hh * FF + c0 + q] = p1[hh][q]; so[FF2 + hh * FF + c0 + q] = cur[hh][q]; }
            }
#pragma unroll
            for (int hh = 0; hh < 2; ++hh)
#pragma unroll
                for (int q = 0; q < 8; ++q) { p2[hh][q] = p1[hh][q]; p1[hh][q] = cur[hh][q]; }
        }
    }
}

__global__ void __launch_bounds__(NWAVES * 64, 2) hawk_fwd(Args args) {
    extern __shared__ __attribute__((aligned(16))) unsigned char lds[];
    Frame F;
    F.lds = (LAS unsigned char*)lds;
    F.MISC = (volatile LAS unsigned*)(F.lds + MISC_OFF);
    F.tid = threadIdx.x; F.lane = F.tid & 63; F.wave = __builtin_amdgcn_readfirstlane(F.tid >> 6);
    F.G = gridDim.x; { const int bx = blockIdx.x; F.vcu = (F.G % 8 == 0) ? (bx % 8) * (F.G / 8) + bx / 8 : bx; }
    unsigned char* ws = args.ws;
    F.ctl = (gu32*)(ws + WS_CTL);
    for (int u = F.tid; u < (LDS_BYTES - LDSCTL_OFF) / 4; u += NWAVES * 64) ((LAS unsigned*)(F.lds + LDSCTL_OFF))[u] = 0u;
    __syncthreads();
    XcdBarrier bar = xcd_barrier_post((unsigned*)(F.ctl + CW_BAR), F.MISC + 8);
#define GRID_BAR() xcd_barrier(bar)

#pragma unroll 1
    for (int st = 0; st < NST_MAX; ++st) {
        unsigned char* ws = args.ws; float* outp = args.out; asm volatile("" : "+s"(ws), "+s"(outp));
        float* XR = outp + O_Y; float* MOD = (float*)(ws + WS_MOD); bf16* XN = (bf16*)(ws + WS_XN); int bid = (int)blockIdx.x; asm volatile("" : "+s"(bid));
        const int l = st < 2 ? 0 : (st - 2) / 14, sub = st < 2 ? st - 2 : (st == 30 ? 99 : (st - 2) % 14);
        const int ll = st == 30 ? 1 : l;
        const float* xin_p = ll == 0 ? args.in[0] : XR; const float* xin_s = ll == 0 ? args.in[1] - (size_t)MP * DM : XR;
        const float* modl = MOD + ll * 6144;
        const int hf = (sub >= 11) ? 1 : 0, rlo = hf ? 8192 : 0, nr = hf ? MROWS - 8192 : 8192;
        if (st == 0 || (sub == 0 && l == 1)) p0_weights(F, args, l, st == 0);
        bool is_gemm = false; pg8::Gemm g{nullptr, nullptr, 0, 0, 0}; pg8::EpiAny E{0, false, ws, nullptr, nullptr, nullptr, nullptr, 0};
        switch (sub) {
            case -1: is_gemm = true; g = pg8::Gemm{(const pg8::bf16_t*)(ws + WS_SILUC), (const pg8::bf16_t*)(ws + WS_WADA), 256, MODW, DM}; E.mode = pg8::EM_ADA; E.perm = false; E.p0 = args.in[10]; E.out = MOD; break;
            case 1: is_gemm = true; g = pg8::Gemm{(const pg8::bf16_t*)XN, (const pg8::bf16_t*)(ws + WS_WIN), MROWS, INW, DM}; E.mode = pg8::EM_IN; E.perm = true; E.p0 = args.in[14] + l * INW; break;
            case 4: is_gemm = true; g = pg8::Gemm{(const pg8::bf16_t*)(ws + WS_SX), (const pg8::bf16_t*)(ws + WS_WGLU), MROWS, 2048, 512}; E.mode = pg8::EM_GLU; E.perm = true; break;
            case 5: is_gemm = true; g = pg8::Gemm{(const pg8::bf16_t*)(ws + WS_RY), (const pg8::bf16_t*)(ws + WS_WRG), MROWS, DM, DM}; E.mode = pg8::EM_RGP; E.perm = true; break;
            case 6: is_gemm = true; g = pg8::Gemm{(const pg8::bf16_t*)(ws + WS_GA), (const pg8::bf16_t*)(ws + WS_WOUT), MROWS, DM, DM}; E.mode = pg8::EM_RES; E.perm = false; E.p0 = xin_p; E.p1 = xin_s; E.p2 = modl + 2048; E.out = XR; break;
            case 8: case 11: is_gemm = true; g = pg8::Gemm{(const pg8::bf16_t*)XN + (size_t)rlo * DM, (const pg8::bf16_t*)(ws + WS_WUP), nr, FF2, DM}; E.mode = pg8::EM_PLAIN; E.perm = true; break;
            case 10: case 13: is_gemm = true; g = pg8::Gemm{(const pg8::bf16_t*)(ws + WS_HFFH), (const pg8::bf16_t*)(ws + WS_WDOWN), nr, DM, FF}; E.mode = pg8::EM_RES; E.perm = false; E.p0 = XR; E.p1 = XR; E.p2 = modl + 5120; E.out = XR; E.row_off = rlo; break;
            default: break;
        }
        if (sub == 0 || sub == 7) norm_rows(F, sub == 0 ? xin_p : XR, sub == 0 ? xin_s : XR, (sub == 0 ? args.in[11] : args.in[12]) + l * DM, modl + (sub == 0 ? 0 : 3072), modl + (sub == 0 ? 1024 : 4096), XN);
        if (sub == 2) mixer_phase<0>(F, args, l);
        if (sub == 3) mixer_phase<1>(F, args, l);
        if (sub == 9 || sub == 12) ffn_conv_phase(F, args, l, rlo, nr);
        if (is_gemm) { pg8::StaticOrder S; S.init(g.M, g.N, F.G, bid); pg8::gemm_phase<pg8::EpiAny, pg8::StaticOrder, true, true>(F.lds, g, S, E); }
        if (sub == 99) final_norm(F, XR, args.in[37]); else GRID_BAR();
    }
}

extern "C" void kernel_launch(void* const* d_in, const int* in_sizes, int n_in, void* d_out, int out_size, void* d_ws, size_t ws_size, hipStream_t stream) {
    static int grid = 0;
    if (grid == 0) {
        if (n_in != 38 || out_size != 23396352 || ws_size < WS_END) { fprintf(stderr, "kernel_launch: unexpected shapes (n_in %d out %d ws %zu)\n", n_in, out_size, ws_size); grid = -1; return; }
        int dev = 0, cus = 0, per_cu = 0;
        if (hipGetDevice(&dev) != hipSuccess || hipDeviceGetAttribute(&cus, hipDeviceAttributeMultiprocessorCount, dev) != hipSuccess) { grid = -1; return; }
        if (hipFuncSetAttribute((const void*)hawk_fwd, hipFuncAttributeMaxDynamicSharedMemorySize, LDS_BYTES) != hipSuccess) { fprintf(stderr, "kernel_launch: hipFuncSetAttribute failed\n"); grid = -1; return; }
        if (hipOccupancyMaxActiveBlocksPerMultiprocessor(&per_cu, (const void*)hawk_fwd, NWAVES * 64, LDS_BYTES) != hipSuccess || per_cu < 1) { fprintf(stderr, "kernel_launch: occupancy query says %d\n", per_cu); per_cu = 1; }
        (void)hipGetLastError();
        grid = cus;
    }
    if (grid < 0) return;
    if (hipMemsetAsync((char*)d_ws + WS_CTL, 0, CTL_ZERO_BYTES, stream) != hipSuccess) { fprintf(stderr, "kernel_launch: memset failed\n"); return; }
    Args a{};
    for (int i = 0; i < 38; ++i) a.in[i] = (const float*)d_in[i];
    a.out = (float*)d_out; a.ws = (unsigned char*)d_ws;
    hipLaunchKernelGGL(hawk_fwd, dim3(grid), dim3(NWAVES * 64), LDS_BYTES, stream, a);
}
```

```cpp
#include <hip/hip_runtime.h>
#include <cstdio>
#include <cstdint>
namespace pg8 {
#define PG8_LAS __attribute__((address_space(3)))
typedef unsigned short bf16_t;
typedef short bf16x8 __attribute__((ext_vector_type(8)));
typedef float f32x4 __attribute__((ext_vector_type(4)));
typedef unsigned u32x4 __attribute__((ext_vector_type(4)));
constexpr int BM = 256, BK = 64, HALF = 128, HTB = HALF * BK * 2  , STAGE_BYTES = 8 * HTB, NXCD = 8, WGM = 8;

__host__ __device__ __forceinline__ int lds_byte(int r, int c) { const int st = (r >> 4) * 2 + (c >> 5), rr = r & 15, cc = c & 31, ob = rr * 64 + cc * 2; return st * 1024 + (ob ^ (((ob >> 9) & 1) << 5)); }
__host__ __device__ __forceinline__ void stage_rc(int b, int& R, int& C) { const int st = b / 1024, sb = b % 1024, swz = sb ^ (((sb >> 9) & 1) << 5); R = (st >> 1) * 16 + swz / 64; C = (st & 1) * 32 + (swz % 64) / 2; }
__host__ __device__ __forceinline__ int perm32(int rho) { const int n = rho >> 4, i = rho & 15; return 8 * (i >> 2) + 4 * n + (i & 3); }

struct Unit { int pm, pn, koff, nt, mini, ksl; };
struct Gemm { const bf16_t* A; const bf16_t* Bt; int M, N, K, lda, ldb; };

struct StaticOrder {
    int nM, nN, nwg, G, c, ntK;
    __host__ __device__ void init(int M, int N, int G_, int c_, int K_ = 128) { nM = M / BM; nN = N / BM; nwg = nM * nN; G = G_; c = c_; ntK = K_ / BK; }
    __host__ __device__ bool next(int i, Unit& u) const {
        const long L = (long)i * G + c; if (L >= nwg) return false;
        int wgid = (int)L; { const int q = nwg / NXCD, r = nwg % NXCD, xcd = wgid % NXCD, off = wgid / NXCD; wgid = (xcd < r ? xcd * (q + 1) : r * (q + 1) + (xcd - r) * q) + off; }
        const int nig = WGM * nN, gid = wgid / nig, fm = gid * WGM, gsz = (nM - fm) < WGM ? (nM - fm) : WGM;
        u.pm = fm + ((wgid % nig) % gsz); u.pn = (wgid % nig) / gsz; u.koff = 0; u.nt = ntK; u.mini = 0; u.ksl = 256; return true;
    }
    __device__ __forceinline__ void a_ready(const Unit&) const {}
    __device__ __forceinline__ void done(const Unit&) const {}
};
struct SplitOrder {
    StaticOrder so; int nslice, nmini, rounds, smode, ksl;
    __device__ void init(int M, int N, int K, int G_, int c_, int smode_, int ksl_) { smode = smode_; ksl = ksl_; so.init(smode_ == 0 ? M : 16384, N, G_, c_, K); nslice = K / ksl_; nmini = smode_ == 1 ? 4 * (N / BM) * nslice : 0; rounds = (so.nwg + G_ - 1) / G_; }
    __device__ bool next(int i, Unit& u) const {
        const long L = (long)i * so.G + so.c;
        if (smode == 3) { if (L >= 4 * so.nN) return false; u.pm = 64 + (int)L / so.nN; u.pn = (int)L % so.nN; u.koff = 0; u.nt = so.ntK; u.mini = 0; u.ksl = 256; return true; }
        if (L < so.nwg) return so.next(i, u);
        const int mm = (int)(L - so.nwg);
        if (mm >= nmini) return false;
        const int kc = mm % nslice, t16 = mm / nslice; u.pm = 64 + t16 / so.nN; u.pn = t16 % so.nN; u.koff = kc * ksl; u.nt = ksl / BK; u.mini = 1; u.ksl = ksl; return true;
    }
    __device__ __forceinline__ void a_ready(const Unit&) const {}
    __device__ __forceinline__ void done(const Unit&) const {}
};


__device__ __forceinline__ unsigned cvt_pk_bf16(float lo, float hi) { unsigned r; asm volatile("v_cvt_pk_bf16_f32 %0, %1, %2" : "=v"(r) : "v"(lo), "v"(hi)); return r; }
typedef float f32x2 __attribute__((ext_vector_type(2)));
__device__ __forceinline__ f32x2 gelu_pk(f32x2 v) {
    const f32x2 av = __builtin_elementwise_abs(v), d = av * 0.2316418882f + 1.0f;
    f32x2 t; t.x = __builtin_amdgcn_rcpf(d.x); t.y = __builtin_amdgcn_rcpf(d.y);
    f32x2 q = t * 0.5307027145f + (-0.7265760135f); q = q * t + 0.7107068705f; q = q * t + (-0.142248368f); q = q * t + 0.127414796f; q = q * t;
    const f32x2 s = (v * v) * (-0.72134752044f);
    f32x2 e; e.x = __builtin_amdgcn_exp2f(s.x); e.y = __builtin_amdgcn_exp2f(s.y);
    const f32x2 m = v * (q * e), r = v - m;
    f32x2 o; o.x = v.x < 0.f ? m.x : r.x; o.y = v.y < 0.f ? m.y : r.y; return o;
}

template <int ACT  > struct EpiBf16 {
    static constexpr bool PERM = true, AFTER_DRAIN = false; static_assert(ACT == 0 || ACT == 1, "EpiBf16: ACT is 0 (none) or 1 (gelu_pk)");
    bf16_t* O; int ldc; const float* bias; int split_cols; size_t split_stride; float scale0;
    __device__ __forceinline__ void operator()(const f32x4 (&acc)[2][2][4][2], const Unit& u, int wr, int wc, int fr, int fq) const {
        const int row0 = u.pm * BM + wr * 64 + fr; int colt = u.pn * BM; bf16_t* base = O;
        float sc = 1.f; if (split_cols) { const int t = colt / split_cols; base += (size_t)t * split_stride; colt -= t * split_cols; if (t == 0) sc = scale0; }
        const int col0 = colt + wc * 32 + 8 * fq, bcol0 = u.pn * BM + wc * 32 + 8 * fq;
        f32x4 bv[2][2];
#pragma unroll
        for (int bj = 0; bj < 2; ++bj)
#pragma unroll
            for (int n = 0; n < 2; ++n) bv[bj][n] = bias ? *(const f32x4*)(bias + bcol0 + bj * HALF + 4 * n) : (f32x4){0.f, 0.f, 0.f, 0.f};
#pragma unroll
        for (int ai = 0; ai < 2; ++ai)
#pragma unroll
            for (int m = 0; m < 4; ++m) { bf16_t* rowp = base + (size_t)(row0 + ai * HALF + m * 16) * ldc + col0;
#pragma unroll
                for (int bj = 0; bj < 2; ++bj) { f32x4 v0 = acc[ai][bj][m][0] + bv[bj][0], v1 = acc[ai][bj][m][1] + bv[bj][1];
                    if (ACT == 1) { f32x2 a = gelu_pk((f32x2){v0[0], v0[1]}), b = gelu_pk((f32x2){v0[2], v0[3]}), c = gelu_pk((f32x2){v1[0], v1[1]}), d = gelu_pk((f32x2){v1[2], v1[3]});
                        v0 = (f32x4){a.x, a.y, b.x, b.y}; v1 = (f32x4){c.x, c.y, d.x, d.y}; }
                    v0 = v0 * sc; v1 = v1 * sc; u32x4 w; w.x = cvt_pk_bf16(v0[0], v0[1]); w.y = cvt_pk_bf16(v0[2], v0[3]); w.z = cvt_pk_bf16(v1[0], v1[1]); w.w = cvt_pk_bf16(v1[2], v1[3]);
                    *(u32x4*)(rowp + bj * HALF) = w; } }
    }
};

template <class Epi, class Sched, bool ALIGN_EPI, bool SP2>
__device__ __forceinline__ void gemm_phase(PG8_LAS unsigned char* lds, const Gemm g, const Sched& S, const Epi& E) {
    int tid_ = threadIdx.x; asm volatile("" : "+v"(tid_));
    const int tid = tid_, wid = __builtin_amdgcn_readfirstlane(tid >> 6), lane = tid & 63, wr = wid >> 2, wc = wid & 3, fr = lane & 15, fq = lane >> 4;
    const int lda = g.lda, ldb = g.ldb;
    unsigned voffA[2], voffB[2];
#pragma unroll
    for (int i = 0; i < 2; ++i) { int R, C; stage_rc(tid * 16 + i * 8192, R, C); const int Rb = E.perm ? ((R & ~31) + perm32(R & 31)) : R;
        voffA[i] = (unsigned)(R * lda + C) * 2u; voffB[i] = (unsigned)(Rb * ldb + C) * 2u; }
    const size_t kstep = (size_t)(BK * 2);
    const size_t hstepA = (size_t)HALF * lda * 2, hstepB = (size_t)HALF * ldb * 2;
    const size_t tstepA = 2 * hstepA, tstepB = 2 * hstepB;
    const unsigned ldsw = (unsigned)wid * 1024u;
    const int aoff = lds_byte(wr * 64 + fr, fq * 8), boff = lds_byte(wc * 32 + fr, fq * 8);
#define PG8_SA(b, h) (((b) * 2 + (h)) * HTB)
#define PG8_SB(b, h) ((4 + (b) * 2 + (h)) * HTB)
#define PG8_STAGE(bufoff, gbase, voff) do { _Pragma("unroll") for (int _i = 0; _i < 2; ++_i) \
        __builtin_amdgcn_global_load_lds((const unsigned*)((const char*)(gbase) + (voff)[_i]), (PG8_LAS unsigned*)(lds + (bufoff) + ldsw + _i * 8192), 16, 0, 0); } while (0)
#define PG8_LDA(dst, b, h) do { _Pragma("unroll") for (int m = 0; m < 4; ++m) _Pragma("unroll") for (int k = 0; k < 2; ++k) dst[m][k] = *(const PG8_LAS bf16x8*)(lds + PG8_SA(b, h) + aoff + m * 2048 + k * 1024); } while (0)
#define PG8_LDB(dst, b, h) do { _Pragma("unroll") for (int n = 0; n < 2; ++n) _Pragma("unroll") for (int k = 0; k < 2; ++k) dst[n][k] = *(const PG8_LAS bf16x8*)(lds + PG8_SB(b, h) + boff + n * 2048 + k * 1024); } while (0)
#define PG8_MMA(ai, bj, At, Bt) do { __builtin_amdgcn_s_setprio(1); _Pragma("unroll") for (int m = 0; m < 4; ++m) _Pragma("unroll") for (int n = 0; n < 2; ++n) _Pragma("unroll") for (int k = 0; k < 2; ++k) \
        acc[ai][bj][m][n] = __builtin_amdgcn_mfma_f32_16x16x32_bf16(Bt[n][k], At[m][k], acc[ai][bj][m][n], 0, 0, 0); __builtin_amdgcn_s_setprio(0); } while (0)
#define PG8_WAIT_V(n) asm volatile("s_waitcnt vmcnt(" #n ")" ::: "memory")
#define PG8_WAIT_L(n) asm volatile("s_waitcnt lgkmcnt(" #n ")" ::: "memory")
#define PG8_BAR __builtin_amdgcn_s_barrier()
#define PG8_SCHED __builtin_amdgcn_sched_barrier(0)
    Unit cur, nxt; int ui = 0;
    if (!S.next(0, cur)) return;
    f32x4 acc[2][2][4][2];
#pragma unroll
    for (int a = 0; a < 2; ++a)
#pragma unroll
        for (int b = 0; b < 2; ++b)
#pragma unroll
            for (int m = 0; m < 4; ++m)
#pragma unroll
                for (int n = 0; n < 2; ++n) acc[a][b][m][n] = (f32x4){0.f, 0.f, 0.f, 0.f};
    bf16x8 At[4][2], B0[2][2], B1[2][2];
    const char* cA = (const char*)g.A + (size_t)cur.pm * tstepA + (size_t)cur.koff * 2; const char* cB = (const char*)g.Bt + (size_t)cur.pn * tstepB + (size_t)cur.koff * 2;
    S.a_ready(cur);
    if constexpr (SP2) {
        PG8_STAGE(PG8_SB(0, 0), cB, voffB); PG8_STAGE(PG8_SB(0, 1), cB + hstepB, voffB); PG8_STAGE(PG8_SA(0, 0), cA, voffA); PG8_STAGE(PG8_SA(0, 1), cA + hstepA, voffA);
        if (wr == 1) PG8_BAR;
        PG8_WAIT_V(2); PG8_BAR;
        PG8_STAGE(PG8_SB(1, 0), cB + kstep, voffB); PG8_STAGE(PG8_SA(1, 0), cA + kstep, voffA); PG8_STAGE(PG8_SB(1, 1), cB + hstepB + kstep, voffB);
        PG8_WAIT_V(6); PG8_BAR;
    } else {
        PG8_STAGE(PG8_SB(0, 0), cB, voffB); PG8_STAGE(PG8_SA(0, 0), cA, voffA); PG8_STAGE(PG8_SB(0, 1), cB + hstepB, voffB); PG8_STAGE(PG8_SA(0, 1), cA + hstepA, voffA);
        if (wr == 1) PG8_BAR;
        PG8_WAIT_V(4); PG8_BAR;
        PG8_STAGE(PG8_SB(1, 0), cB + kstep, voffB); PG8_STAGE(PG8_SA(1, 0), cA + kstep, voffA); PG8_STAGE(PG8_SB(1, 1), cB + hstepB + kstep, voffB);
        PG8_WAIT_V(6); PG8_BAR;
    }
    for (;;) {
        const bool has_next = S.next(ui + 1, nxt);
        const char* nA = has_next ? (const char*)g.A + (size_t)nxt.pm * tstepA + (size_t)nxt.koff * 2 : cA; const char* nB = has_next ? (const char*)g.Bt + (size_t)nxt.pn * tstepB + (size_t)nxt.koff * 2 : cB;
        const int nt = cur.nt;
        for (int t = 0; t < nt; t += 2) {
            const bool last = (t == nt - 2);
            const char* a1 = cA + (size_t)(t + 1) * kstep;
            const char* a2 = last ? nA : cA + (size_t)(t + 2) * kstep; const char* b2 = last ? nB : cB + (size_t)(t + 2) * kstep;
            const char* a3 = a2 + kstep; const char* b3 = b2 + kstep;
            if (last && has_next) S.a_ready(nxt);
            if constexpr (SP2) {
            PG8_LDB(B0, 0, 0); PG8_LDB(B1, 0, 1); PG8_SCHED; PG8_LDA(At, 0, 0); PG8_STAGE(PG8_SA(1, 1), a1 + hstepA, voffA);
            PG8_WAIT_V(8); PG8_WAIT_L(0); PG8_BAR; PG8_MMA(0, 0, At, B0); PG8_MMA(0, 1, At, B1); PG8_BAR; PG8_SCHED;
            PG8_LDA(At, 0, 1); PG8_STAGE(PG8_SB(0, 0), b2, voffB); PG8_STAGE(PG8_SB(0, 1), b2 + hstepB, voffB); PG8_STAGE(PG8_SA(0, 0), a2, voffA);
            PG8_WAIT_V(8); PG8_WAIT_L(0); PG8_BAR; PG8_MMA(1, 0, At, B0); PG8_MMA(1, 1, At, B1); PG8_BAR; PG8_SCHED;
            PG8_LDB(B0, 1, 0); PG8_LDB(B1, 1, 1); PG8_SCHED; PG8_LDA(At, 1, 0); PG8_STAGE(PG8_SA(0, 1), a2 + hstepA, voffA);
            PG8_WAIT_V(8); PG8_WAIT_L(0); PG8_BAR; PG8_MMA(0, 0, At, B0); PG8_MMA(0, 1, At, B1); PG8_BAR; PG8_SCHED;
            PG8_LDA(At, 1, 1); PG8_STAGE(PG8_SB(1, 0), b3, voffB); PG8_STAGE(PG8_SB(1, 1), b3 + hstepB, voffB); PG8_STAGE(PG8_SA(1, 0), a3, voffA);
            PG8_WAIT_V(8); PG8_WAIT_L(0); PG8_BAR; PG8_MMA(1, 0, At, B0); PG8_MMA(1, 1, At, B1); PG8_BAR; PG8_SCHED;
            } else {
            PG8_LDB(B0, 0, 0); PG8_SCHED; PG8_LDA(At, 0, 0); PG8_STAGE(PG8_SA(1, 1), a1 + hstepA, voffA);
            PG8_WAIT_L(8); PG8_BAR; PG8_WAIT_L(0); PG8_MMA(0, 0, At, B0); PG8_BAR; PG8_SCHED;
            PG8_LDB(B1, 0, 1); PG8_STAGE(PG8_SB(0, 0), b2, voffB);
            PG8_BAR; PG8_WAIT_L(0); PG8_MMA(0, 1, At, B1); PG8_BAR;
            PG8_LDA(At, 0, 1); PG8_STAGE(PG8_SA(0, 0), a2, voffA);
            PG8_BAR; PG8_WAIT_L(0); PG8_MMA(1, 0, At, B0); PG8_BAR; PG8_SCHED;
            PG8_STAGE(PG8_SB(0, 1), b2 + hstepB, voffB);
            PG8_WAIT_V(6); PG8_BAR; PG8_MMA(1, 1, At, B1); PG8_BAR;
            PG8_LDB(B0, 1, 0); PG8_SCHED; PG8_LDA(At, 1, 0); PG8_STAGE(PG8_SA(0, 1), a2 + hstepA, voffA);
            PG8_WAIT_L(8); PG8_BAR; PG8_WAIT_L(0); PG8_MMA(0, 0, At, B0); PG8_BAR; PG8_SCHED;
            PG8_LDB(B1, 1, 1); PG8_STAGE(PG8_SB(1, 0), b3, voffB);
            PG8_BAR; PG8_WAIT_L(0); PG8_MMA(0, 1, At, B1); PG8_BAR;
            PG8_LDA(At, 1, 1); PG8_STAGE(PG8_SA(1, 0), a3, voffA);
            PG8_BAR; PG8_WAIT_L(0); PG8_MMA(1, 0, At, B0); PG8_BAR; PG8_SCHED;
            PG8_STAGE(PG8_SB(1, 1), b3 + hstepB, voffB);
            PG8_WAIT_V(6); PG8_BAR; PG8_MMA(1, 1, At, B1); PG8_BAR;
            }
        }
        if constexpr (ALIGN_EPI) { if (wr == 0) PG8_BAR; }
        if constexpr (!Epi::AFTER_DRAIN) { E(acc, cur, wr, wc, fr, fq); S.done(cur); }
        if (!has_next) break;
#pragma unroll
        for (int a = 0; a < 2; ++a)
#pragma unroll
            for (int b = 0; b < 2; ++b)
#pragma unroll
                for (int m = 0; m < 4; ++m)
#pragma unroll
                    for (int n = 0; n < 2; ++n) acc[a][b][m][n] = (f32x4){0.f, 0.f, 0.f, 0.f};
        cur = nxt; cA = nA; cB = nB; ++ui;
        if constexpr (ALIGN_EPI) { if (wr == 1) PG8_BAR; }
    }
    PG8_WAIT_V(0);
    if constexpr (!ALIGN_EPI) { if (wr == 0) PG8_BAR; }
    PG8_BAR;
    if constexpr (Epi::AFTER_DRAIN) { E.fused(acc, cur, wr, wc, fr, fq, lds, wid, lane); S.done(cur); }
#undef PG8_SA
#undef PG8_SB
#undef PG8_STAGE
#undef PG8_LDA
#undef PG8_LDB
#undef PG8_MMA
#undef PG8_WAIT_V
#undef PG8_WAIT_L
#undef PG8_BAR
#undef PG8_SCHED
}
}
#define GAS __attribute__((address_space(1)))
#define LAS __attribute__((address_space(3)))
typedef unsigned short bf16;
typedef unsigned v4u __attribute__((ext_vector_type(4)));
typedef float f32x4 __attribute__((ext_vector_type(4)));
typedef short bf16x8 __attribute__((ext_vector_type(8)));
typedef GAS unsigned gu32;
typedef GAS unsigned long long gu64;
#define RLX_AGENT __ATOMIC_RELAXED, __HIP_MEMORY_SCOPE_AGENT
#define LDS_WAIT() asm volatile("s_waitcnt lgkmcnt(0)" ::: "memory")
#define VM_WAIT() asm volatile("s_waitcnt vmcnt(0)" ::: "memory")
__device__ __forceinline__ unsigned long long rt() { return __builtin_amdgcn_s_memrealtime(); }
__device__ __forceinline__ unsigned pk2(float lo, float hi) { unsigned r; asm("v_cvt_pk_bf16_f32 %0, %1, %2" : "=v"(r) : "v"(lo), "v"(hi)); return r; }
__device__ __forceinline__ unsigned f2bf(float f) { return pk2(f, 0.f) & 0xffffu; }
#define XB_TMO      128
#define XB_XCNT(j)  (256  + 64 * (j))
#define XB_XSUB(j)  (1280 + 64 * (j))
#define XB_XGEN(j)  (2304 + 64 * (j))
#define XB_TOP      3328
#define XB_TOPGEN   3392
#define XCD_BAR_WORDS 3456
#define XB_SPIN_CAP (1u << 18)

__device__ __forceinline__ unsigned xb_ld(unsigned* p)              { return __hip_atomic_load(p, __ATOMIC_RELAXED, __HIP_MEMORY_SCOPE_AGENT); }
__device__ __forceinline__ unsigned xb_add(unsigned* p, unsigned v) { return __hip_atomic_fetch_add(p, v, __ATOMIC_RELAXED, __HIP_MEMORY_SCOPE_AGENT); }
__device__ __forceinline__ unsigned xb_xcc_id() { return (unsigned)__builtin_amdgcn_s_getreg((3 << 11) | 20) & 0xFu; }
#define XB_SPIN(cond, bar) do { unsigned _sp = 0; while (cond) { __builtin_amdgcn_s_sleep(1); \
    if ((++_sp & 255u) == 0u) { if (xb_ld(&(bar)[XB_TMO])) break; if (_sp > XB_SPIN_CAP) { atomicAdd(&(bar)[XB_TMO], 1u); break; } } } } while (0)

struct XcdBarrier {
    unsigned* bar; unsigned x;
    volatile LAS unsigned* st;
};

__device__ __forceinline__ XcdBarrier xcd_barrier_post(unsigned* bar, volatile LAS unsigned* st) {
    XcdBarrier b; b.bar = bar; b.x = xb_xcc_id(); b.st = st;
    if (threadIdx.x == 0) (void)xb_add(&bar[XB_XCNT(b.x)], 1u);
    return b;
}
__device__ __forceinline__ void xcd_barrier_complete(unsigned* bar, unsigned x, unsigned& nloc, unsigned& nx) {
    const unsigned G = gridDim.x * gridDim.y * gridDim.z;
    unsigned sum, cnt, mine, sp = 0u;
    for (;;) {
        sum = 0u; cnt = 0u; mine = 0u;
#pragma unroll
        for (unsigned j = 0; j < 16; ++j) { const unsigned c = xb_ld(&bar[XB_XCNT(j)]); sum += c; cnt += (c > 0u) ? 1u : 0u; mine = (j == x) ? c : mine; }
        if (sum == G) break;
        __builtin_amdgcn_s_sleep(1);
        if ((++sp & 255u) == 0u) { if (xb_ld(&bar[XB_TMO])) break; if (sp > XB_SPIN_CAP) { atomicAdd(&bar[XB_TMO], 1u); break; } }
    }
    nloc = mine > 0u ? mine : 1u; nx = cnt > 0u ? cnt : 1u;
}

__device__ __forceinline__ void xcd_barrier(const XcdBarrier& b) {
    asm volatile("s_waitcnt vmcnt(0)" ::: "memory");
    __syncthreads();
    if (threadIdx.x == 0) {
        unsigned* bar = b.bar;
        __builtin_amdgcn_s_waitcnt(0);
        unsigned nloc = b.st[0], nx = b.st[1];
        if (nloc == 0u) { xcd_barrier_complete(bar, b.x, nloc, nx); b.st[0] = nloc; b.st[1] = nx; }
        const unsigned old = xb_add(&bar[XB_XSUB(b.x)], 1u);
        const unsigned gen = old / nloc;
        if (old + 1u == (gen + 1u) * nloc) {
            __builtin_amdgcn_fence(__ATOMIC_RELEASE, "agent");
            asm volatile("s_waitcnt vmcnt(0)" ::: "memory");
            const unsigned og = xb_add(&bar[XB_TOP], 1u);
            const unsigned tg = og / nx;
            if (og + 1u == (tg + 1u) * nx) xb_add(&bar[XB_TOPGEN], 1u);
            else XB_SPIN(xb_ld(&bar[XB_TOPGEN]) == tg, bar);
            __builtin_amdgcn_fence(__ATOMIC_ACQUIRE, "agent");
            xb_add(&bar[XB_XGEN(b.x)], 1u);
            asm volatile("s_waitcnt vmcnt(0)" ::: "memory");
        } else {
            XB_SPIN(xb_ld(&bar[XB_XGEN(b.x)]) == gen, bar);
            __builtin_amdgcn_fence(__ATOMIC_ACQUIRE, "agent");
            asm volatile("s_waitcnt vmcnt(0)" ::: "memory");
        }
    }
    __syncthreads();
}

constexpr int NWAVES = 8;
#ifndef NST_MAX
#define NST_MAX 23
#endif
constexpr int DM = 1024, MROWS = 17408, MP = 16384, TP = 2048, NSP = 8, NSS = 128, TS = 8;
constexpr int INW = 4608, FF = 3072, FF2 = 6144, NCI = 136, MODW = 12288;
constexpr float EPSN = 1e-6f;
constexpr int TC = 128, NCH = TP / TC;

constexpr size_t MiB = 1u << 20;
constexpr size_t WS_CTL = 0, CTL_ZERO_BYTES = 1 * MiB;
constexpr size_t WS_MOD = 1 * MiB;
constexpr size_t WS_WIN = 8 * MiB, WS_WRG = 17 * MiB, WS_WGLU = 19 * MiB, WS_WOUT = 21 * MiB, WS_WUP = 23 * MiB, WS_WDOWN = 35 * MiB;
constexpr size_t WS_SMALL = 41 * MiB;
constexpr size_t SM_WG = 0, SM_BBAR = 256 * 1024, SM_CMAT = 384 * 1024, SM_ABAR = 512 * 1024, SM_ABARTC = 528 * 1024;
constexpr size_t WS_XN = 42 * MiB;
constexpr size_t WS_XRB = 76 * MiB;
constexpr size_t WS_RX = 110 * MiB, WS_RY = 144 * MiB, WS_SX = 178 * MiB, WS_GA = 195 * MiB, WS_GB = 229 * MiB;
constexpr size_t WS_UPH = 110 * MiB, WS_HFFH = 212 * MiB;
constexpr size_t WS_HFF = 110 * MiB, WS_HALO = 212 * MiB;
constexpr size_t WS_WADA = 110 * MiB, WS_SILUC = 135 * MiB;
constexpr size_t WS_AGGRG = 263 * MiB, WS_AGGS5 = 263 * MiB;
constexpr size_t WS_PART_OUT = 229 * MiB, WS_PART_DOWN = 219 * MiB;
constexpr size_t WS_AGT = 267 * MiB;
constexpr size_t WS_END = 269 * MiB;
constexpr int CW_BAR = 4096, CW_Q = 8192;

constexpr size_t O_Y = 0, O_PRGH = 17825792, O_PRGC = 17842176, O_PS5R = 17891328, O_PS5I = 17924096, O_PFFN = 17956864,
                 O_SRGH = 18153472, O_SRGC = 18415616, O_SS5R = 19202048, O_SS5I = 19726336, O_SFFN = 20250624;

constexpr int RING_BYTES = 131072, LDSCTL_OFF = RING_BYTES, MISC_OFF = LDSCTL_OFF + 320, LDS_BYTES = 147456;
constexpr int XCH_OFF = RING_BYTES + 1024;

typedef float f32x2 __attribute__((ext_vector_type(2)));
typedef unsigned u32x2 __attribute__((ext_vector_type(2)));

struct Args { const float* in[38]; float* out; unsigned char* ws; };

struct Frame { LAS unsigned char* lds; volatile LAS unsigned* MISC; gu32* ctl; int tid, lane, wave, vcu, G; };
__device__ __forceinline__ Frame refresh(const Frame& F0) {
    Frame F = F0; int t = threadIdx.x; asm volatile("" : "+v"(t)); int bx = blockIdx.x; asm volatile("" : "+s"(bx));
    F.tid = t; F.lane = t & 63; F.wave = __builtin_amdgcn_readfirstlane(t >> 6); F.G = gridDim.x; F.vcu = (F.G % 8 == 0) ? (bx % 8) * (F.G / 8) + bx / 8 : bx; return F;
}

__device__ __forceinline__ float bf2f(unsigned short b) { return __builtin_bit_cast(float, (unsigned)b << 16); }
__device__ __forceinline__ float bflo(unsigned w) { return __builtin_bit_cast(float, w << 16); }
__device__ __forceinline__ float bfhi(unsigned w) { return __builtin_bit_cast(float, w & 0xffff0000u); }
__device__ __forceinline__ float fsig(float x) { return __builtin_amdgcn_rcpf(1.f + __builtin_amdgcn_exp2f(-1.44269504f * x)); }
__device__ __forceinline__ float fgelu(float x) { const float u = x * (1.f + 0.044715f * x * x); return x * __builtin_amdgcn_rcpf(1.f + __builtin_amdgcn_exp2f(-2.302208198f * u)); }
__device__ __forceinline__ float wave_sum(float v) {
#pragma unroll
    for (int o = 1; o < 64; o <<= 1) v += __shfl_xor(v, o);
    return v;
}
__device__ __forceinline__ int row_ci(int row) { return row < MP ? (row >> 11) : 8 + ((row - MP) >> 3); }

namespace pg8 {
enum { EM_ADA = 0, EM_IN = 1, EM_GLU = 2, EM_RGP = 3, EM_RES = 4, EM_PLAIN = 5, EM_UPF = 6 };
struct EpiAny {
    static constexpr bool AFTER_DRAIN = false;
    int mode; bool perm; unsigned char* ws; const float* p0; const float* p1; const float* p2; float* out; int row_off; int lay; PG8_LAS float* xch;
    __device__ __forceinline__ void operator()(const f32x4 (&acc)[2][2][4][2], const Unit& u, int wr, int wc, int fr, int fq) const {
        asm volatile("" : "+v"(fr), "+v"(fq), "+s"(wr), "+s"(wc));
        if (mode == EM_IN || mode == EM_PLAIN) {
            const int pn = u.pn; int ldc = 1024, ct = pn; size_t wo = WS_UPH;
            if (mode == EM_IN) { if (pn < 4) { wo = WS_RX; ct = pn; } else if (pn < 8) { wo = WS_RY; ct = pn - 4; } else if (pn < 10) { wo = WS_SX; ct = pn - 8; ldc = 512; } else if (pn < 14) { wo = WS_GA; ct = pn - 10; } else { wo = WS_GB; ct = pn - 14; } }
            else ldc = FF2;
            bf16_t* base = (bf16_t*)(ws + wo);
            const int row0 = u.pm * BM + wr * 64 + fr, col0 = ct * BM + wc * 32 + 8 * fq, bcol0 = pn * BM + wc * 32 + 8 * fq;
#pragma unroll
            for (int bj = 0; bj < 2; ++bj) {
                f32x4 b0 = {0.f, 0.f, 0.f, 0.f}, b1 = {0.f, 0.f, 0.f, 0.f};
                if (mode == EM_IN) { b0 = *(const f32x4*)(p0 + bcol0 + bj * HALF); b1 = *(const f32x4*)(p0 + bcol0 + bj * HALF + 4); }
#pragma unroll
                for (int ai = 0; ai < 2; ++ai)
#pragma unroll
                    for (int m = 0; m < 4; ++m) { bf16_t* rowp = base + (size_t)(row0 + ai * HALF + m * 16) * ldc + col0;
                        const f32x4 v0 = acc[ai][bj][m][0] + b0, v1 = acc[ai][bj][m][1] + b1;
                        u32x4 w; w.x = cvt_pk_bf16(v0[0], v0[1]); w.y = cvt_pk_bf16(v0[2], v0[3]); w.z = cvt_pk_bf16(v1[0], v1[1]); w.w = cvt_pk_bf16(v1[2], v1[3]);
                        *(u32x4*)(rowp + bj * HALF) = w; } }
        } else if (mode == EM_UPF) {
            const int pm = u.pm, pn = u.pn; const bool smp = pm >= 64; const int lane = fq * 16 + fr;
            bf16_t* HF = (bf16_t*)(ws + WS_HFF); float* HALO = (float*)(ws + WS_HALO);
            const int cb = pn * HALF + wc * 32 + 8 * fq;
            if (fr >= 14) {
#pragma unroll
                for (int ai = 0; ai < 2; ++ai)
#pragma unroll
                    for (int bj = 0; bj < 2; ++bj)
#pragma unroll
                        for (int n = 0; n < 2; ++n) *(PG8_LAS f32x4*)(xch + ((((ai * 2 + wr) * 2 + (fr - 14)) * 4 + wc) * 4 + fq) * 16 + bj * 8 + n * 4) = acc[ai][bj][3][n];
            }
            if (!smp) {
                if (wr == 1 && fr >= 14) {
#pragma unroll
                    for (int bj = 0; bj < 2; ++bj)
#pragma unroll
                        for (int n = 0; n < 2; ++n) { *(f32x4*)(HALO + ((size_t)(pm * 4 + (fr - 14)) * 2 + bj) * FF + cb + 4 * n) = acc[1][bj][3][n];
                            if ((pm & 7) == 7) *(f32x4*)(out + O_PFFN + ((size_t)((pm >> 3) * 2 + lay) * 2 + (fr - 14)) * FF2 + bj * FF + cb + 4 * n) = acc[1][bj][3][n]; }
                }
                if (wr == 0 && fr < 2) {
#pragma unroll
                    for (int bj = 0; bj < 2; ++bj)
#pragma unroll
                        for (int n = 0; n < 2; ++n) *(f32x4*)(HALO + ((size_t)(pm * 4 + 2 + fr) * 2 + bj) * FF + cb + 4 * n) = acc[0][bj][0][n];
                }
            } else if ((fr & 7) >= 6) {
#pragma unroll
                for (int ai = 0; ai < 2; ++ai)
#pragma unroll
                    for (int m = 0; m < 4; ++m) { const int sq = ((pm - 64) * BM + ai * HALF + wr * 64 + m * 16 + fr) >> 3;
#pragma unroll
                        for (int bj = 0; bj < 2; ++bj)
#pragma unroll
                            for (int n = 0; n < 2; ++n) *(f32x4*)(out + O_SFFN + ((size_t)(sq * 2 + lay) * 2 + ((fr & 7) - 6)) * FF2 + bj * FF + cb + 4 * n) = acc[ai][bj][m][n]; }
            }
            asm volatile("s_waitcnt lgkmcnt(0)" ::: "memory"); __builtin_amdgcn_s_barrier(); asm volatile("" ::: "memory");
#pragma unroll
            for (int n = 0; n < 2; ++n) {
                const int c4 = cb + 4 * n;
                f32x4 w[2][3], bb[2];
#pragma unroll
                for (int bj = 0; bj < 2; ++bj) { bb[bj] = *(const f32x4*)(p1 + bj * FF + c4);
#pragma unroll
                    for (int k = 0; k < 3; ++k) w[bj][k] = *(const f32x4*)(p0 + k * FF2 + bj * FF + c4); }
#pragma unroll
                for (int ai = 0; ai < 2; ++ai) {
                    f32x4 pg[2] = {{0.f, 0.f, 0.f, 0.f}, {0.f, 0.f, 0.f, 0.f}};
                    const int blk = ai * 2 + wr;
                    if (!smp && blk > 0 && fr >= 14) {
#pragma unroll
                        for (int bj = 0; bj < 2; ++bj) pg[bj] = *(const PG8_LAS f32x4*)(xch + (((((blk - 1) * 2 + (fr - 14)) * 4 + wc) * 4 + fq) * 16 + bj * 8 + n * 4));
                    }
#pragma unroll
                    for (int m = 0; m < 4; ++m) {
                        const int trow = ai * HALF + wr * 64 + m * 16 + fr;
                        f32x4 uc[2];
#pragma unroll
                        for (int bj = 0; bj < 2; ++bj) {
                            const f32x4 cur = acc[ai][bj][m][n]; f32x4 p1v, p2v;
#pragma unroll
                            for (int j = 0; j < 4; ++j) { const float x1 = (fr == 15) ? pg[bj][j] : cur[j], x2 = (fr >= 14) ? pg[bj][j] : cur[j];
                                p1v[j] = __builtin_bit_cast(float, __builtin_amdgcn_update_dpp(0, __builtin_bit_cast(int, x1), 0x121, 0xF, 0xF, false));
                                p2v[j] = __builtin_bit_cast(float, __builtin_amdgcn_update_dpp(0, __builtin_bit_cast(int, x2), 0x122, 0xF, 0xF, false)); }
                            if (smp) { const int t = fr & 7;
                                if (t < 2) { const int sq = ((pm - 64) * BM + trow) >> 3; const float* st = p2 + ((size_t)(sq * 2 + lay) * 2) * FF2 + bj * FF + c4;
                                    const f32x4 s1 = *(const f32x4*)(st + FF2); p2v = s1; if (t == 0) { p1v = s1; p2v = *(const f32x4*)st; } } }
                            uc[bj] = bb[bj] + w[bj][0] * p2v + w[bj][1] * p1v + w[bj][2] * cur;
                            pg[bj] = cur;
                        }
                        u32x2 o; o.x = cvt_pk_bf16(fgelu(uc[0][0]) * uc[1][0], fgelu(uc[0][1]) * uc[1][1]); o.y = cvt_pk_bf16(fgelu(uc[0][2]) * uc[1][2], fgelu(uc[0][3]) * uc[1][3]);
                        *(u32x2*)(HF + (size_t)(pm * BM + trow) * FF + c4) = o;
                    }
                }
            }
        } else if (mode == EM_GLU) {
            bf16_t* GA = (bf16_t*)(ws + WS_GA); const bf16_t* GB = (const bf16_t*)(ws + WS_GB);
            const int row0 = u.pm * BM + wr * 64 + fr, col0 = u.pn * HALF + wc * 32 + 8 * fq;
#pragma unroll
            for (int ai = 0; ai < 2; ++ai) {
                u32x4 gq[4], aq[4];
#pragma unroll
                for (int m = 0; m < 4; ++m) { const size_t off = (size_t)(row0 + ai * HALF + m * 16) * 1024 + col0; gq[m] = *(const u32x4*)(GB + off); aq[m] = *(const u32x4*)(GA + off); }
#pragma unroll
                for (int m = 0; m < 4; ++m) { const size_t off = (size_t)(row0 + ai * HALF + m * 16) * 1024 + col0;
                    const u32x4 g = gq[m], a = aq[m];
                    float gv[8] = {bflo(g.x), bfhi(g.x), bflo(g.y), bfhi(g.y), bflo(g.z), bfhi(g.z), bflo(g.w), bfhi(g.w)};
                    float av[8] = {bflo(a.x), bfhi(a.x), bflo(a.y), bfhi(a.y), bflo(a.z), bfhi(a.z), bflo(a.w), bfhi(a.w)}; float o[8];
#pragma unroll
                    for (int n = 0; n < 2; ++n)
#pragma unroll
                        for (int j = 0; j < 4; ++j) o[4 * n + j] = av[4 * n + j] + fsig(gv[4 * n + j]) * acc[ai][0][m][n][j] * fsig(acc[ai][1][m][n][j]);
                    u32x4 w; w.x = cvt_pk_bf16(o[0], o[1]); w.y = cvt_pk_bf16(o[2], o[3]); w.z = cvt_pk_bf16(o[4], o[5]); w.w = cvt_pk_bf16(o[6], o[7]);
                    *(u32x4*)(GA + off) = w; } }
        } else if (mode == EM_RGP) {
            bf16_t* GA = (bf16_t*)(ws + WS_GA);
            const int row0 = u.pm * BM + wr * 64 + fr, col0 = u.pn * BM + wc * 32 + 8 * fq;
#pragma unroll
            for (int ai = 0; ai < 2; ++ai) {
                u32x4 gq[4][2];
#pragma unroll
                for (int m = 0; m < 4; ++m)
#pragma unroll
                    for (int bj = 0; bj < 2; ++bj) gq[m][bj] = *(const u32x4*)(GA + (size_t)(row0 + ai * HALF + m * 16) * 1024 + col0 + bj * HALF);
#pragma unroll
                for (int m = 0; m < 4; ++m)
#pragma unroll
                    for (int bj = 0; bj < 2; ++bj) { const size_t off = (size_t)(row0 + ai * HALF + m * 16) * 1024 + col0 + bj * HALF;
                        const u32x4 g = gq[m][bj];
                        float gv[8] = {bflo(g.x), bfhi(g.x), bflo(g.y), bfhi(g.y), bflo(g.z), bfhi(g.z), bflo(g.w), bfhi(g.w)}; float o[8];
#pragma unroll
                        for (int n = 0; n < 2; ++n)
#pragma unroll
                            for (int j = 0; j < 4; ++j) o[4 * n + j] = fsig(gv[4 * n + j]) * acc[ai][bj][m][n][j];
                        u32x4 w; w.x = cvt_pk_bf16(o[0], o[1]); w.y = cvt_pk_bf16(o[2], o[3]); w.z = cvt_pk_bf16(o[4], o[5]); w.w = cvt_pk_bf16(o[6], o[7]);
                        *(u32x4*)(GA + off) = w; } }
        } else if (mode == EM_RES) {
            bf16_t* XB = (bf16_t*)(ws + WS_XRB);
            const int col0 = u.pn * BM + wc * 32 + 8 * fq;
            if (u.mini) {
#pragma unroll
                for (int ai = 0; ai < 2; ++ai)
#pragma unroll
                    for (int m = 0; m < 4; ++m) { const int r = u.pm * BM + ai * HALF + wr * 64 + m * 16 + fr;
#pragma unroll
                        for (int bj = 0; bj < 2; ++bj) { float* P = (float*)(ws + (row_off ? WS_PART_DOWN : WS_PART_OUT)) + ((size_t)(u.koff / u.ksl) * (MROWS - MP) + (r - MP)) * DM + col0 + bj * HALF;
                            *(f32x4*)P = acc[ai][bj][m][0]; *(f32x4*)(P + 4) = acc[ai][bj][m][1]; } }
            } else {
                const float* gt = p2 + (size_t)(u.pm >> 3) * MODW;
                f32x4 gq[2][2];
#pragma unroll
                for (int bj = 0; bj < 2; ++bj) { gq[bj][0] = *(const f32x4*)(gt + col0 + bj * HALF); gq[bj][1] = *(const f32x4*)(gt + col0 + bj * HALF + 4); }
#pragma unroll
                for (int ai = 0; ai < 2; ++ai) {
                    f32x4 sq[4][2][2];
#pragma unroll
                    for (int m = 0; m < 4; ++m)
#pragma unroll
                        for (int bj = 0; bj < 2; ++bj) { const size_t off = (size_t)(u.pm * BM + ai * HALF + wr * 64 + m * 16 + fr) * DM + col0 + bj * HALF;
                            if (p0) { sq[m][bj][0] = *(const f32x4*)(p0 + off); sq[m][bj][1] = *(const f32x4*)(p0 + off + 4); }
                            else { const u32x4 b = *(const u32x4*)(XB + off); sq[m][bj][0] = (f32x4){bflo(b.x), bfhi(b.x), bflo(b.y), bfhi(b.y)}; sq[m][bj][1] = (f32x4){bflo(b.z), bfhi(b.z), bflo(b.w), bfhi(b.w)}; } }
#pragma unroll
                    for (int m = 0; m < 4; ++m)
#pragma unroll
                        for (int bj = 0; bj < 2; ++bj) { const size_t off = (size_t)(u.pm * BM + ai * HALF + wr * 64 + m * 16 + fr) * DM + col0 + bj * HALF;
                            const f32x4 o0 = sq[m][bj][0] + gq[bj][0] * acc[ai][bj][m][0], o1 = sq[m][bj][1] + gq[bj][1] * acc[ai][bj][m][1];
                            u32x4 w; w.x = cvt_pk_bf16(o0[0], o0[1]); w.y = cvt_pk_bf16(o0[2], o0[3]); w.z = cvt_pk_bf16(o1[0], o1[1]); w.w = cvt_pk_bf16(o1[2], o1[3]);
                            *(u32x4*)(XB + off) = w; } }
            }
        } else {
            const int col0 = u.pn * BM + wc * 32 + 4 * fq;
#pragma unroll
            for (int ai = 0; ai < 2; ++ai)
#pragma unroll
                for (int m = 0; m < 4; ++m) { const int r = ai * HALF + wr * 64 + m * 16 + fr;
                    if (r < NCI) {
#pragma unroll
                        for (int bj = 0; bj < 2; ++bj)
#pragma unroll
                            for (int n = 0; n < 2; ++n) { const int c = col0 + bj * HALF + n * 16; *(f32x4*)(out + (size_t)r * MODW + c) = acc[ai][bj][m][n] + *(const f32x4*)(p0 + c); } } }
        }
    }
};
}

template <int MAP> __device__ __forceinline__ int wt_row(int n) {
    if (MAP == 1) { return n < 1024 ? ((n >> 7) << 8) + (n & 127) : (((n - 1024) >> 7) << 8) + 128 + (n & 127); }
    if (MAP == 2) { return n < 3072 ? ((n >> 7) << 8) + (n & 127) : (((n - 3072) >> 7) << 8) + 128 + (n & 127); }
    return n;
}
template <int MAP> __device__ __forceinline__ void p0_transpose_item(const float* W, int K, int N, bf16* WT, int row_off, LAS float* scr, int item, int lane) {
    const int nblk = N / 32, kb = item / nblk, nb = item % nblk, k0 = 64 * kb, n0 = 32 * nb;
    { f32x4 v[8];
#pragma unroll
      for (int i = 0; i < 8; ++i) v[i] = *(const f32x4*)(W + (size_t)(k0 + 8 * i + (lane >> 3)) * N + n0 + 4 * (lane & 7));
#pragma unroll
      for (int i = 0; i < 8; ++i) { LAS float* d = scr + (8 * i + (lane >> 3)) * 33 + 4 * (lane & 7); d[0] = v[i].x; d[1] = v[i].y; d[2] = v[i].z; d[3] = v[i].w; } }
    LDS_WAIT(); asm volatile("" ::: "memory");
    const int c = lane & 7;
#pragma unroll
    for (int j = 0; j < 4; ++j) { const int n = (lane >> 3) + 8 * j; const LAS float* s = scr + (8 * c) * 33 + n;
        v4u o; o.x = pk2(s[0 * 33], s[1 * 33]); o.y = pk2(s[2 * 33], s[3 * 33]); o.z = pk2(s[4 * 33], s[5 * 33]); o.w = pk2(s[6 * 33], s[7 * 33]);
        *(GAS v4u*)(WT + (size_t)(row_off + wt_row<MAP>(n0 + n)) * K + k0 + 8 * c) = o; }
    LDS_WAIT(); asm volatile("" ::: "memory");
}

__device__ __forceinline__ void p0_weights(const Frame& F0, const Args& A, int l, int part, int b0, int nb) {
    const Frame F = refresh(F0);
    unsigned char* ws = A.ws;
    LAS float* scr = (LAS float*)(F.lds + F.wave * 16384);
    int bx = blockIdx.x; asm volatile("" : "+s"(bx));
    if (bx < b0) return;
    const bool first = part == 0;
    const int gw = (bx - b0) * NWAVES + F.wave, NGW = nb * NWAVES;
    constexpr int I_IN = (DM / 64) * (INW / 32), I_SQ = (DM / 64) * (DM / 32), I_GLU = (512 / 64) * (2048 / 32), I_UP = (DM / 64) * (FF2 / 32), I_DN = (FF / 64) * (DM / 32), I_ADA = (DM / 64) * (FF2 / 32);
    constexpr int NLAYER = I_IN + 2 * I_SQ + I_GLU + I_UP + I_DN;
    const int nitems = first ? 2 * I_ADA : NLAYER;
    const int per_ = (nitems + NGW - 1) / NGW, it_hi = (gw + 1) * per_ < nitems ? (gw + 1) * per_ : nitems;
    for (int it = gw * per_; it < it_hi; ++it) {
        int r = first ? it + NLAYER : it;
        if (r < I_IN) { p0_transpose_item<0>(A.in[13] + (size_t)l * DM * INW, DM, INW, (bf16*)(ws + WS_WIN), 0, scr, r, F.lane); continue; } r -= I_IN;
        if (r < I_SQ) { p0_transpose_item<0>(A.in[30] + (size_t)l * DM * DM, DM, DM, (bf16*)(ws + WS_WRG), 0, scr, r, F.lane); continue; } r -= I_SQ;
        if (r < I_SQ) { p0_transpose_item<0>(A.in[32] + (size_t)l * DM * DM, DM, DM, (bf16*)(ws + WS_WOUT), 0, scr, r, F.lane); continue; } r -= I_SQ;
        if (r < I_GLU) { p0_transpose_item<1>(A.in[31] + (size_t)l * 512 * 2048, 512, 2048, (bf16*)(ws + WS_WGLU), 0, scr, r, F.lane); continue; } r -= I_GLU;
        if (r < I_UP) { p0_transpose_item<2>(A.in[33] + (size_t)l * DM * FF2, DM, FF2, (bf16*)(ws + WS_WUP), 0, scr, r, F.lane); continue; } r -= I_UP;
        if (r < I_DN) { p0_transpose_item<0>(A.in[36] + (size_t)l * FF * DM, FF, DM, (bf16*)(ws + WS_WDOWN), 0, scr, r, F.lane); continue; } r -= I_DN;
        if (r < I_ADA) { p0_transpose_item<0>(A.in[9], DM, FF2, (bf16*)(ws + WS_WADA), 0, scr, r, F.lane); continue; } r -= I_ADA;
        p0_transpose_item<0>(A.in[9] + (size_t)DM * FF2, DM, FF2, (bf16*)(ws + WS_WADA), FF2, scr, r, F.lane);
    }
    const int gt = (bx - b0) * (NWAVES * 64) + F.tid, NGT = nb * NWAVES * 64;
    if (!first) {
    bf16* WG = (bf16*)(ws + WS_SMALL + SM_WG);
    for (int e = gt; e < 2 * 16 * 4096; e += NGT) { const int gate = e >> 16, rem = e & 65535, h = rem >> 12, j = (rem >> 6) & 63, i = rem & 63;
        const float* src = (gate ? A.in[19] : A.in[17]) + (size_t)l * 65536 + h * 4096 + i * 64 + j;
        WG[((h * 2 + gate) * 64 + j) * 64 + i] = (bf16)f2bf(*src); }
    for (int e = gt; e < 2048; e += NGT) { const int g = e >> 6, p = e & 63;
        const float dt = expf(A.in[29][l * 32 + g]);
        const float lr = A.in[22][l * 2048 + e], li = A.in[23][l * 2048 + e];
        const float mag = expf(lr * dt); float sn, cs; sincosf(li * dt, &sn, &cs);
        const float ar = mag * cs, ai = mag * sn, den = lr * lr + li * li;
        const float zr = ((ar - 1.f) * lr + ai * li) / den, zi = (ai * lr - (ar - 1.f) * li) / den;
        float* AB = (float*)(ws + WS_SMALL + SM_ABAR); AB[e * 2] = ar; AB[e * 2 + 1] = ai;
        float pr = ar, pi = ai;
#pragma unroll 1
        for (int s = 0; s < 7; ++s) { const float nr = pr * pr - pi * pi, ni = 2.f * pr * pi; pr = nr; pi = ni; }
        float* ABT = (float*)(ws + WS_SMALL + SM_ABARTC); ABT[e * 2] = pr; ABT[e * 2 + 1] = pi;
        bf16* BB = (bf16*)(ws + WS_SMALL + SM_BBAR) + (size_t)g * 128 * 16;
        const float* bre = A.in[24] + ((size_t)l * 2048 + e) * 16; const float* bim = A.in[25] + ((size_t)l * 2048 + e) * 16;
#pragma unroll 4
        for (int c = 0; c < 16; ++c) { const float br = bre[c], bi = bim[c]; BB[p * 16 + c] = (bf16)f2bf(zr * br - zi * bi); BB[(64 + p) * 16 + c] = (bf16)f2bf(zr * bi + zi * br); }
        bf16* CM = (bf16*)(ws + WS_SMALL + SM_CMAT) + (size_t)g * 16 * 128;
        const float* cre = A.in[26] + ((size_t)l * 32 + g) * 1024; const float* cim = A.in[27] + ((size_t)l * 32 + g) * 1024;
#pragma unroll 4
        for (int c = 0; c < 16; ++c) { CM[c * 128 + p] = (bf16)f2bf(cre[c * 64 + p]); CM[c * 128 + 64 + p] = (bf16)f2bf(-cim[c * 64 + p]); }
    }
    }
    if (first) {
        bf16* XRs = (bf16*)(ws + WS_XRB) + (size_t)MP * DM;
        for (int e = gt; e < (MROWS - MP) * DM / 4; e += NGT) { const f32x4 v = ((const f32x4*)A.in[1])[e]; ((unsigned long long*)XRs)[e] = (unsigned long long)pk2(v.x, v.y) | ((unsigned long long)pk2(v.z, v.w) << 32); }
    }
    if (first) {
        bf16* SC = (bf16*)(ws + WS_SILUC);
        for (int e = gt; e < 256 * DM; e += NGT) { const int r = e >> 10, c = e & 1023; float v = 0.f;
            if (r < NSP) v = A.in[7][r * DM + c]; else if (r < NCI) v = A.in[8][(r - NSP) * DM + c];
            SC[e] = (bf16)f2bf(v * fsig(v)); }
    }
}

__device__ __forceinline__ void cvt8(const v4u w, float (&o)[8]) { o[0] = bflo(w.x); o[1] = bfhi(w.x); o[2] = bflo(w.y); o[3] = bfhi(w.y); o[4] = bflo(w.z); o[5] = bfhi(w.z); o[6] = bflo(w.w); o[7] = bfhi(w.w); }
__device__ __forceinline__ f32x4 ld_row4(const float* xf, const bf16* xb, size_t row, int idx) {
    if (xf) return ((const GAS f32x4*)(xf + row * DM))[idx];
    const u32x2 b = ((const GAS u32x2*)(xb + row * DM))[idx]; return (f32x4){bflo(b.x), bfhi(b.x), bflo(b.y), bfhi(b.y)};
}
__device__ __forceinline__ void norm_rows(const Frame& F0, const float* xp, const float* xs_adj, bf16* XRB, const float* g, const float* mod_sh, const float* mod_sc, bf16* XN, int npart, const float* pgate, const float* PART) {
    const Frame F = refresh(F0);
    const int gw = F.vcu * NWAVES + F.wave, NGW = F.G * NWAVES;
    if (!xp) {
        for (int m0 = 8 * gw; m0 < MP; m0 += 8 * NGW) {
            const int ci = m0 >> 11;
            v4u w[8][2]; float sr[8];
#pragma unroll
            for (int r = 0; r < 8; ++r)
#pragma unroll
                for (int j = 0; j < 2; ++j) w[r][j] = ((const GAS v4u*)(XRB + (size_t)(m0 + r) * DM))[64 * j + F.lane];
#pragma unroll
            for (int r = 0; r < 8; ++r) { float q = 0.f;
#pragma unroll
                for (int j = 0; j < 2; ++j) { float v[8]; cvt8(w[r][j], v);
#pragma unroll
                    for (int e = 0; e < 8; ++e) q += v[e] * v[e]; }
                sr[r] = __builtin_amdgcn_rsqf(wave_sum(q) * (1.f / DM) + EPSN); }
#pragma unroll
            for (int j = 0; j < 2; ++j) { const int c = 512 * j + 8 * F.lane; float gs[8], sh[8];
#pragma unroll
                for (int h2 = 0; h2 < 2; ++h2) { const f32x4 gg = *(const f32x4*)(g + c + 4 * h2), s4 = *(const f32x4*)(mod_sh + (size_t)ci * MODW + c + 4 * h2), c4 = *(const f32x4*)(mod_sc + (size_t)ci * MODW + c + 4 * h2);
#pragma unroll
                    for (int e = 0; e < 4; ++e) { gs[4 * h2 + e] = gg[e] * (c4[e] + 1.f); sh[4 * h2 + e] = s4[e]; } }
#pragma unroll
                for (int r = 0; r < 8; ++r) { float v[8]; cvt8(w[r][j], v); v4u o;
                    o.x = pk2(v[0] * sr[r] * gs[0] + sh[0], v[1] * sr[r] * gs[1] + sh[1]); o.y = pk2(v[2] * sr[r] * gs[2] + sh[2], v[3] * sr[r] * gs[3] + sh[3]);
                    o.z = pk2(v[4] * sr[r] * gs[4] + sh[4], v[5] * sr[r] * gs[5] + sh[5]); o.w = pk2(v[6] * sr[r] * gs[6] + sh[6], v[7] * sr[r] * gs[7] + sh[7]);
                    ((GAS v4u*)(XN + (size_t)(m0 + r) * DM))[64 * j + F.lane] = o; } }
        }
    } else
    for (int m0 = 4 * gw; m0 < MP; m0 += 4 * NGW) {
        const int ci = m0 >> 11;
        f32x4 v[4][4]; float s[4];
#pragma unroll
        for (int r = 0; r < 4; ++r)
#pragma unroll
            for (int j = 0; j < 4; ++j) v[r][j] = ld_row4(xp, XRB, (size_t)(m0 + r), 64 * j + F.lane);
#pragma unroll
        for (int r = 0; r < 4; ++r) { float q = 0.f;
#pragma unroll
            for (int j = 0; j < 4; ++j) q += (v[r][j].x * v[r][j].x + v[r][j].y * v[r][j].y) + (v[r][j].z * v[r][j].z + v[r][j].w * v[r][j].w);
            s[r] = 1.f / sqrtf(wave_sum(q) * (1.f / DM) + EPSN); }
#pragma unroll
        for (int j = 0; j < 4; ++j) { const int c = 256 * j + 4 * F.lane;
            const f32x4 gg = *(const f32x4*)(g + c), sh = *(const f32x4*)(mod_sh + (size_t)ci * MODW + c), sc = *(const f32x4*)(mod_sc + (size_t)ci * MODW + c);
            const f32x4 gs = gg * (sc + 1.f);
#pragma unroll
            for (int r = 0; r < 4; ++r) { const f32x4 y = v[r][j] * s[r] * gs + sh;
                ((GAS unsigned long long*)(XN + (size_t)(m0 + r) * DM))[64 * j + F.lane] = (unsigned long long)pk2(y.x, y.y) | ((unsigned long long)pk2(y.z, y.w) << 32); } }
    }
    for (int m = MP + gw; m < MROWS; m += NGW) {
        const int ci = row_ci(m);
        f32x4 v[4]; float q = 0.f;
#pragma unroll
        for (int j = 0; j < 4; ++j) { v[j] = ld_row4(xs_adj, XRB, (size_t)m, 64 * j + F.lane);
            if (npart > 0) {
                f32x4 ps = {0.f, 0.f, 0.f, 0.f};
#pragma unroll
                for (int k = 0; k < 12; ++k) if (k < npart) ps += *(const f32x4*)(PART + ((size_t)k * (MROWS - MP) + (m - MP)) * DM + 256 * j + 4 * F.lane);
                v[j] += *(const f32x4*)(pgate + (size_t)ci * MODW + 256 * j + 4 * F.lane) * ps;
                ((GAS unsigned long long*)(XRB + (size_t)m * DM))[64 * j + F.lane] = (unsigned long long)pk2(v[j].x, v[j].y) | ((unsigned long long)pk2(v[j].z, v[j].w) << 32);
            }
            q += (v[j].x * v[j].x + v[j].y * v[j].y) + (v[j].z * v[j].z + v[j].w * v[j].w); }
        const float rstd = 1.f / sqrtf(wave_sum(q) * (1.f / DM) + EPSN);
#pragma unroll
        for (int j = 0; j < 4; ++j) { const int c = 256 * j + 4 * F.lane;
            const f32x4 gg = *(const f32x4*)(g + c), sh = *(const f32x4*)(mod_sh + (size_t)ci * MODW + c), sc = *(const f32x4*)(mod_sc + (size_t)ci * MODW + c);
            const f32x4 y = v[j] * rstd * gg * (sc + 1.f) + sh;
            ((GAS unsigned long long*)(XN + (size_t)m * DM))[64 * j + F.lane] = (unsigned long long)pk2(y.x, y.y) | ((unsigned long long)pk2(y.z, y.w) << 32); }
    }
}
__device__ __forceinline__ void final_norm(const Frame& F0, const bf16* XRB, float* y, const float* g, int npart, const float* pgate, const float* PART) {
    const Frame F = refresh(F0);
    const int gw = F.vcu * NWAVES + F.wave, NGW = F.G * NWAVES;
    for (int m0 = 8 * gw; m0 < MP; m0 += 8 * NGW) {
        v4u w[8][2]; float sr[8];
#pragma unroll
        for (int r = 0; r < 8; ++r)
#pragma unroll
            for (int j = 0; j < 2; ++j) w[r][j] = ((const GAS v4u*)(XRB + (size_t)(m0 + r) * DM))[64 * j + F.lane];
#pragma unroll
        for (int r = 0; r < 8; ++r) { float q = 0.f;
#pragma unroll
            for (int j = 0; j < 2; ++j) { float v[8]; cvt8(w[r][j], v);
#pragma unroll
                for (int e = 0; e < 8; ++e) q += v[e] * v[e]; }
            sr[r] = __builtin_amdgcn_rsqf(wave_sum(q) * (1.f / DM) + EPSN); }
#pragma unroll
        for (int j = 0; j < 2; ++j) { const int c = 512 * j + 8 * F.lane; const f32x4 g0 = *(const f32x4*)(g + c), g1 = *(const f32x4*)(g + c + 4);
#pragma unroll
            for (int r = 0; r < 8; ++r) { float v[8]; cvt8(w[r][j], v); float* yp = y + (size_t)(m0 + r) * DM + c;
                *(f32x4*)yp = (f32x4){v[0], v[1], v[2], v[3]} * sr[r] * g0; *(f32x4*)(yp + 4) = (f32x4){v[4], v[5], v[6], v[7]} * sr[r] * g1; } }
    }
    for (int m = MP + gw; m < MROWS; m += NGW) {
        const int ci = row_ci(m);
        f32x4 v[4]; float q = 0.f;
#pragma unroll
        for (int j = 0; j < 4; ++j) { v[j] = ld_row4(nullptr, XRB, (size_t)m, 64 * j + F.lane);
            f32x4 ps = {0.f, 0.f, 0.f, 0.f};
#pragma unroll
            for (int k = 0; k < 12; ++k) if (k < npart) ps += *(const f32x4*)(PART + ((size_t)k * (MROWS - MP) + (m - MP)) * DM + 256 * j + 4 * F.lane);
            v[j] += *(const f32x4*)(pgate + (size_t)ci * MODW + 256 * j + 4 * F.lane) * ps;
            q += (v[j].x * v[j].x + v[j].y * v[j].y) + (v[j].z * v[j].z + v[j].w * v[j].w); }
        const float rstd = 1.f / sqrtf(wave_sum(q) * (1.f / DM) + EPSN);
#pragma unroll
        for (int j = 0; j < 4; ++j) { const f32x4 gg = *(const f32x4*)(g + 256 * j + 4 * F.lane); ((GAS f32x4*)(y + (size_t)m * DM))[64 * j + F.lane] = v[j] * rstd * gg; }
    }
}


template <int MODE> __device__ __forceinline__ void rg_unit(const Frame& F, const Args& A, int l, bool sample, int s, int c, int h) {
    unsigned char* ws = A.ws;
    LAS float* TAB = (LAS float*)(F.lds + F.wave * 15360);
    LAS float* XC = TAB + 512;
    LAS float* AA = XC + 16 * 68;
    LAS float* BB = AA + 16 * 68;
    const int lane = F.lane, fr = lane & 15, fq = lane >> 4, ch0 = 64 * h;
    const bf16* RX = (const bf16*)(ws + WS_RX); bf16* RY = (bf16*)(ws + WS_RY);
    {
        const int chg = l * DM + ch0 + lane;
#pragma unroll
        for (int j = 0; j < 4; ++j) TAB[j * 64 + lane] = A.in[15][(size_t)(l * 4 + j) * DM + ch0 + lane];
        TAB[4 * 64 + lane] = A.in[16][chg]; TAB[5 * 64 + lane] = A.in[18][chg]; TAB[6 * 64 + lane] = A.in[20][chg];
        const float lam = A.in[21][chg]; TAB[7 * 64 + lane] = -8.f * 1.44269504f * log1pf(expf(-lam));
    }
    bf16x8 Wf[2][4][2];
    { const bf16* WG = (const bf16*)(ws + WS_SMALL + SM_WG);
#pragma unroll
      for (int g = 0; g < 2; ++g)
#pragma unroll
        for (int n = 0; n < 4; ++n)
#pragma unroll
            for (int k = 0; k < 2; ++k) Wf[g][n][k] = *(const bf16x8*)(WG + ((h * 2 + g) * 64 + 16 * n + fr) * 64 + 32 * k + 8 * fq); }
    LDS_WAIT(); asm volatile("" ::: "memory");
    const int rbase = sample ? MP + s * 32 : s * TP + c * TC;
    float hst = 0.f, aprod = 1.f;
    if (MODE == 1 && !sample) {
        const float* AG = (const float*)(ws + WS_AGGRG) + ((size_t)(s * NCH) * DM + ch0 + lane) * 2;
        for (int cc = 0; cc < c; ++cc) { const float a = AG[(size_t)cc * DM * 2], b = AG[(size_t)cc * DM * 2 + 1]; hst = a * hst + b; }
    }
    const int ntile = sample ? 2 : 8;
#pragma unroll 1
    for (int tile = 0; tile < ntile; ++tile) {
        const int row = rbase + 16 * tile + fr;
        const int t = sample ? (fr & 7) : c * TC + 16 * tile + fr;
        const int sq = sample ? s * 4 + tile * 2 + (fr >> 3) : s;
        bf16x8 X[2];
#pragma unroll
        for (int k = 0; k < 2; ++k) {
            const int cl = 32 * k + 8 * fq; float xc[8];
            { const f32x4 b0 = *(const LAS f32x4*)(TAB + 4 * 64 + cl), b1 = *(const LAS f32x4*)(TAB + 4 * 64 + cl + 4); xc[0] = b0.x; xc[1] = b0.y; xc[2] = b0.z; xc[3] = b0.w; xc[4] = b1.x; xc[5] = b1.y; xc[6] = b1.z; xc[7] = b1.w; }
#pragma unroll
            for (int d = 0; d < 4; ++d) {
                float v[8];
                if (t - d >= 0) { cvt8(*(const v4u*)(RX + (size_t)(row - d) * DM + ch0 + cl), v); }
                else if (sample) { const float* st = A.in[3] + ((size_t)(sq * 2 + l) * 3 + (3 + t - d)) * DM + ch0 + cl; const f32x4 a0 = *(const f32x4*)st, a1 = *(const f32x4*)(st + 4);
                    v[0] = a0.x; v[1] = a0.y; v[2] = a0.z; v[3] = a0.w; v[4] = a1.x; v[5] = a1.y; v[6] = a1.z; v[7] = a1.w; }
                else {
#pragma unroll
                    for (int q = 0; q < 8; ++q) v[q] = 0.f; }
                const f32x4 w0 = *(const LAS f32x4*)(TAB + (3 - d) * 64 + cl), w1 = *(const LAS f32x4*)(TAB + (3 - d) * 64 + cl + 4);
                xc[0] += w0.x * v[0]; xc[1] += w0.y * v[1]; xc[2] += w0.z * v[2]; xc[3] += w0.w * v[3]; xc[4] += w1.x * v[4]; xc[5] += w1.y * v[5]; xc[6] += w1.z * v[6]; xc[7] += w1.w * v[7];
            }
            *(LAS f32x4*)(XC + fr * 68 + cl) = (f32x4){xc[0], xc[1], xc[2], xc[3]}; *(LAS f32x4*)(XC + fr * 68 + cl + 4) = (f32x4){xc[4], xc[5], xc[6], xc[7]};
            v4u pk; pk.x = pk2(xc[0], xc[1]); pk.y = pk2(xc[2], xc[3]); pk.z = pk2(xc[4], xc[5]); pk.w = pk2(xc[6], xc[7]);
            X[k] = __builtin_bit_cast(bf16x8, pk);
        }
        f32x4 acc[2][4];
#pragma unroll
        for (int g = 0; g < 2; ++g)
#pragma unroll
            for (int n = 0; n < 4; ++n) { acc[g][n] = (f32x4){0.f, 0.f, 0.f, 0.f};
#pragma unroll
                for (int k = 0; k < 2; ++k) acc[g][n] = __builtin_amdgcn_mfma_f32_16x16x32_bf16(Wf[g][n][k], X[k], acc[g][n], 0, 0, 0); }
        LDS_WAIT(); asm volatile("" ::: "memory");
#pragma unroll
        for (int n = 0; n < 4; ++n) { const int cl = 16 * n + 4 * fq;
            const f32x4 xv = *(const LAS f32x4*)(XC + fr * 68 + cl), ba = *(const LAS f32x4*)(TAB + 5 * 64 + cl), bx = *(const LAS f32x4*)(TAB + 6 * 64 + cl), c8 = *(const LAS f32x4*)(TAB + 7 * 64 + cl);
            f32x4 av, bv;
#pragma unroll
            for (int j = 0; j < 4; ++j) { const float r = fsig(acc[0][n][j] + ba[j]), ig = fsig(acc[1][n][j] + bx[j]); const float a = __builtin_amdgcn_exp2f(r * c8[j]);
                av[j] = a; bv[j] = __builtin_amdgcn_sqrtf(fmaxf(1.f - a * a, 0.f)) * ig * xv[j]; }
            *(LAS f32x4*)(AA + fr * 68 + cl) = av; *(LAS f32x4*)(BB + fr * 68 + cl) = bv; }
        LDS_WAIT(); asm volatile("" ::: "memory");
#pragma unroll
        for (int tt = 0; tt < 16; ++tt) {
            if (sample && (tt & 7) == 0) hst = A.in[2][(size_t)((s * 4 + tile * 2 + (tt >> 3)) * 2 + l) * DM + ch0 + lane];
            const float a = AA[tt * 68 + lane], b = BB[tt * 68 + lane];
            hst = a * hst + b; if (MODE == 0) aprod *= a;
            if (MODE == 1) BB[tt * 68 + lane] = hst;
            if (MODE == 1 && sample && (tt & 7) == 7) A.out[O_SRGH + (size_t)((s * 4 + tile * 2 + (tt >> 3)) * 2 + l) * DM + ch0 + lane] = hst;
        }
        if (MODE == 1) {
            LDS_WAIT(); asm volatile("" ::: "memory");
#pragma unroll
            for (int n = 0; n < 4; ++n) { const int cl = 16 * n + 4 * fq; const f32x4 hv = *(const LAS f32x4*)(BB + fr * 68 + cl);
                bf16* p = RY + (size_t)row * DM + ch0 + cl; const u32x2 ry = *(const u32x2*)p;
                u32x2 o; o.x = pk2(hv.x * fgelu(bflo(ry.x)), hv.y * fgelu(bfhi(ry.x))); o.y = pk2(hv.z * fgelu(bflo(ry.y)), hv.w * fgelu(bfhi(ry.y)));
                *(u32x2*)p = o; }
            LDS_WAIT(); asm volatile("" ::: "memory");
        }
    }
    if (MODE == 0) { float* AG = (float*)(ws + WS_AGGRG) + ((size_t)(s * NCH + c) * DM + ch0 + lane) * 2; AG[0] = aprod; AG[1] = hst; }
    if (MODE == 1) {
        if (!sample && c == NCH - 1) {
            A.out[O_PRGH + (size_t)(s * 2 + l) * DM + ch0 + lane] = hst;
#pragma unroll
            for (int k = 0; k < 3; ++k) A.out[O_PRGC + (size_t)((s * 2 + l) * 3 + k) * DM + ch0 + lane] = bf2f(RX[(size_t)(s * TP + TP - 3 + k) * DM + ch0 + lane]);
        }
        if (sample) {
#pragma unroll 1
            for (int q = 0; q < 4; ++q) { const int n = s * 4 + q;
#pragma unroll
                for (int k = 0; k < 3; ++k) A.out[O_SRGC + (size_t)((n * 2 + l) * 3 + k) * DM + ch0 + lane] = bf2f(RX[(size_t)(MP + n * TS + 5 + k) * DM + ch0 + lane]); }
        }
    }
}

__device__ __forceinline__ void rg_unit_sp(const Frame& F, const Args& A, int l, int s, int c, int h) {
    constexpr int MODE = 0; constexpr bool sample = false;
    unsigned char* ws = A.ws;
    LAS float* TAB = (LAS float*)(F.lds + F.wave * 15360);
    LAS float* XC = TAB + 512;
    LAS float* AA = XC + 16 * 68;
    LAS float* BB = AA + 16 * 68;
    const int lane = F.lane, fr = lane & 15, fq = lane >> 4, ch0 = 64 * h;
    const bf16* RX = (const bf16*)(ws + WS_RX); bf16* RY = (bf16*)(ws + WS_RY);
    {
        const int chg = l * DM + ch0 + lane;
#pragma unroll
        for (int j = 0; j < 4; ++j) TAB[j * 64 + lane] = A.in[15][(size_t)(l * 4 + j) * DM + ch0 + lane];
        TAB[4 * 64 + lane] = A.in[16][chg]; TAB[5 * 64 + lane] = A.in[18][chg]; TAB[6 * 64 + lane] = A.in[20][chg];
        const float lam = A.in[21][chg]; TAB[7 * 64 + lane] = -8.f * 1.44269504f * log1pf(expf(-lam));
    }
    bf16x8 Wf[2][4][2];
    { const bf16* WG = (const bf16*)(ws + WS_SMALL + SM_WG);
#pragma unroll
      for (int g = 0; g < 2; ++g)
#pragma unroll
        for (int n = 0; n < 4; ++n)
#pragma unroll
            for (int k = 0; k < 2; ++k) Wf[g][n][k] = *(const bf16x8*)(WG + ((h * 2 + g) * 64 + 16 * n + fr) * 64 + 32 * k + 8 * fq); }
    LDS_WAIT(); asm volatile("" ::: "memory");
    const int rbase = s * TP + c * TC;
    bf16* XQ = (bf16*)(ws + WS_XN);
    float hst = 0.f, aprod = 1.f;
    if (MODE == 1 && !sample) {
        const float* AG = (const float*)(ws + WS_AGGRG) + ((size_t)(s * NCH) * DM + ch0 + lane) * 2;
        for (int cc = 0; cc < c; ++cc) { const float a = AG[(size_t)cc * DM * 2], b = AG[(size_t)cc * DM * 2 + 1]; hst = a * hst + b; }
    }
    v4u nx[2][4]; unsigned short nry[16];
#define RG_LOAD_RX(tl) do { const int row_ = rbase + 16 * (tl) + fr, t_ = c * TC + 16 * (tl) + fr; \
        _Pragma("unroll") for (int k = 0; k < 2; ++k) _Pragma("unroll") for (int d = 0; d < 4; ++d) nx[k][d] = *(const v4u*)(RX + (size_t)(t_ - d >= 0 ? row_ - d : row_) * DM + ch0 + 32 * k + 8 * fq); } while (0)
#define RG_LOAD_RY(tl) do { _Pragma("unroll") for (int tt = 0; tt < 16; ++tt) nry[tt] = RY[(size_t)(rbase + 16 * (tl) + tt) * DM + ch0 + lane]; } while (0)
    RG_LOAD_RX(0); RG_LOAD_RY(0);
    bf16x8 X[2]; f32x4 acc[2][4];
#define RG_FRONT(tl) do { const int t_f = c * TC + 16 * (tl) + fr; \
        _Pragma("unroll") for (int k = 0; k < 2; ++k) { const int cl = 32 * k + 8 * fq; float xc[8]; \
            { const f32x4 b0 = *(const LAS f32x4*)(TAB + 4 * 64 + cl), b1 = *(const LAS f32x4*)(TAB + 4 * 64 + cl + 4); xc[0] = b0.x; xc[1] = b0.y; xc[2] = b0.z; xc[3] = b0.w; xc[4] = b1.x; xc[5] = b1.y; xc[6] = b1.z; xc[7] = b1.w; } \
            _Pragma("unroll") for (int d = 0; d < 4; ++d) { float v[8]; { v4u w_ = nx[k][d]; if (t_f - d < 0) w_ = (v4u){0u, 0u, 0u, 0u}; cvt8(w_, v); } \
                const f32x4 w0 = *(const LAS f32x4*)(TAB + (3 - d) * 64 + cl), w1 = *(const LAS f32x4*)(TAB + (3 - d) * 64 + cl + 4); \
                xc[0] += w0.x * v[0]; xc[1] += w0.y * v[1]; xc[2] += w0.z * v[2]; xc[3] += w0.w * v[3]; xc[4] += w1.x * v[4]; xc[5] += w1.y * v[5]; xc[6] += w1.z * v[6]; xc[7] += w1.w * v[7]; } \
            *(LAS f32x4*)(XC + fr * 68 + cl) = (f32x4){xc[0], xc[1], xc[2], xc[3]}; *(LAS f32x4*)(XC + fr * 68 + cl + 4) = (f32x4){xc[4], xc[5], xc[6], xc[7]}; \
            v4u pk; pk.x = pk2(xc[0], xc[1]); pk.y = pk2(xc[2], xc[3]); pk.z = pk2(xc[4], xc[5]); pk.w = pk2(xc[6], xc[7]); X[k] = __builtin_bit_cast(bf16x8, pk); } \
        if ((tl) < 7) RG_LOAD_RX((tl) + 1); \
        _Pragma("unroll") for (int g = 0; g < 2; ++g) _Pragma("unroll") for (int n = 0; n < 4; ++n) { acc[g][n] = (f32x4){0.f, 0.f, 0.f, 0.f}; \
            _Pragma("unroll") for (int k = 0; k < 2; ++k) acc[g][n] = __builtin_amdgcn_mfma_f32_16x16x32_bf16(Wf[g][n][k], X[k], acc[g][n], 0, 0, 0); } } while (0)
#define RG_GATES() do { LDS_WAIT(); asm volatile("" ::: "memory"); \
        _Pragma("unroll") for (int n = 0; n < 4; ++n) { const int cl = 16 * n + 4 * fq; \
            const f32x4 xv = *(const LAS f32x4*)(XC + fr * 68 + cl), ba = *(const LAS f32x4*)(TAB + 5 * 64 + cl), bx = *(const LAS f32x4*)(TAB + 6 * 64 + cl), c8 = *(const LAS f32x4*)(TAB + 7 * 64 + cl); \
            f32x4 av, bv; \
            _Pragma("unroll") for (int j = 0; j < 4; ++j) { const float r = fsig(acc[0][n][j] + ba[j]), ig = fsig(acc[1][n][j] + bx[j]); const float a = __builtin_amdgcn_exp2f(r * c8[j]); \
                av[j] = a; bv[j] = __builtin_amdgcn_sqrtf(fmaxf(1.f - a * a, 0.f)) * ig * xv[j]; } \
            *(LAS f32x4*)(AA + fr * 68 + cl) = av; *(LAS f32x4*)(BB + fr * 68 + cl) = bv; } } while (0)
    RG_FRONT(0); RG_GATES();
#pragma unroll 1
    for (int tile = 0; tile < 8; ++tile) {
        LDS_WAIT(); asm volatile("" ::: "memory");
        if (tile < 7) RG_FRONT(tile + 1);
#pragma unroll
        for (int tt = 0; tt < 16; ++tt) {
            const float sa_ = AA[tt * 68 + lane], sb_ = BB[tt * 68 + lane];
            hst = sa_ * hst + sb_; aprod *= sa_;
            const float g = fgelu(bf2f(nry[tt]));
            const size_t o = (size_t)(rbase + 16 * tile + tt) * DM + ch0 + lane; const unsigned pq = pk2(hst * g, aprod * g); RY[o] = (bf16)(pq & 0xffffu); XQ[o] = (bf16)(pq >> 16);
        }
        if (tile < 7) { RG_LOAD_RY(tile + 1); RG_GATES(); }
    }
    LDS_WAIT(); asm volatile("" ::: "memory");
#undef RG_FRONT
#undef RG_GATES
    unsigned long long* AGT = (unsigned long long*)(ws + WS_AGT) + ((size_t)(l * 128 + s * 16 + h) * 16) * 64 + lane;
    __hip_atomic_store(AGT + (size_t)c * 64, ((unsigned long long)__float_as_uint(hst) << 32) | __float_as_uint(fmaxf(aprod, 1e-30f)), __ATOMIC_RELAXED, __HIP_MEMORY_SCOPE_AGENT);
}
__device__ __forceinline__ void rg_unit_sp2(const Frame& F, const Args& A, int l, int s, int c, int h) {
    unsigned char* ws = A.ws;
    const int lane = F.lane, ch0 = 64 * h;
    const bf16* RX = (const bf16*)(ws + WS_RX); bf16* RY = (bf16*)(ws + WS_RY); bf16* XQ = (bf16*)(ws + WS_XN);
    const int rbase = s * TP + c * TC;
    unsigned long long* AGT = (unsigned long long*)(ws + WS_AGT) + ((size_t)(l * 128 + s * 16 + h) * 16) * 64 + lane;
    float hst, aprod; { const unsigned long long v = __hip_atomic_load(AGT + (size_t)c * 64, __ATOMIC_RELAXED, __HIP_MEMORY_SCOPE_AGENT); aprod = __uint_as_float((unsigned)v); hst = __uint_as_float((unsigned)(v >> 32)); }
    float hin = 0.f;
    {   unsigned long long av[NCH - 1];
#pragma unroll
        for (int cc = 0; cc < NCH - 1; ++cc) av[cc] = (cc < c) ? __hip_atomic_load(AGT + (size_t)cc * 64, __ATOMIC_RELAXED, __HIP_MEMORY_SCOPE_AGENT) : 0ull;
#pragma unroll
        for (int cc = 0; cc < NCH - 1; ++cc) if (cc < c) {
            unsigned long long v = av[cc]; unsigned sp_ = 0;
            while (!(__uint_as_float((unsigned)v) > 0.f) && sp_ < (1u << 22)) { __builtin_amdgcn_s_sleep(2); v = __hip_atomic_load(AGT + (size_t)cc * 64, __ATOMIC_RELAXED, __HIP_MEMORY_SCOPE_AGENT); ++sp_; }
            hin = __uint_as_float((unsigned)v) * hin + __uint_as_float((unsigned)(v >> 32));
        } }
    if (c > 0) {
        asm volatile("s_waitcnt vmcnt(0)" ::: "memory");
#pragma unroll 1
        for (int tile = 0; tile < 8; ++tile) {
            unsigned short pv[16], qv[16];
#pragma unroll
            for (int tt = 0; tt < 16; ++tt) { const size_t o = (size_t)(rbase + 16 * tile + tt) * DM + ch0 + lane; pv[tt] = RY[o]; qv[tt] = XQ[o]; }
#pragma unroll
            for (int tt = 0; tt < 16; ++tt) RY[(size_t)(rbase + 16 * tile + tt) * DM + ch0 + lane] = (bf16)f2bf(bf2f(pv[tt]) + bf2f(qv[tt]) * hin);
        }
    }
    if (c == NCH - 1) {
        A.out[O_PRGH + (size_t)(s * 2 + l) * DM + ch0 + lane] = hst + aprod * hin;
#pragma unroll
        for (int k = 0; k < 3; ++k) A.out[O_PRGC + (size_t)((s * 2 + l) * 3 + k) * DM + ch0 + lane] = bf2f(RX[(size_t)(s * TP + TP - 3 + k) * DM + ch0 + lane]);
    }
}

template <int MODE> __device__ __forceinline__ void s5_unit(const Frame& F, const Args& A, int l, bool sample, int s, int c, int g) {
    unsigned char* ws = A.ws;
    LAS float* BU = (LAS float*)(F.lds + F.wave * 15360);
    LAS bf16* XS = (LAS bf16*)(F.lds + F.wave * 15360 + 16 * 132 * 4);
    const int lane = F.lane, fr = lane & 15, fq = lane >> 4;
    bf16* SX = (bf16*)(ws + WS_SX);
    bf16x8 Bf[8], Cf[4];
    { const bf16* BBm = (const bf16*)(ws + WS_SMALL + SM_BBAR) + (size_t)g * 128 * 16;
#pragma unroll
      for (int n = 0; n < 8; ++n) { v4u z = {0u, 0u, 0u, 0u}; if (fq < 2) z = *(const v4u*)(BBm + (16 * n + fr) * 16 + 8 * fq); Bf[n] = __builtin_bit_cast(bf16x8, z); }
      const bf16* CM = (const bf16*)(ws + WS_SMALL + SM_CMAT) + (size_t)g * 16 * 128;
#pragma unroll
      for (int kk = 0; kk < 4; ++kk) Cf[kk] = *(const bf16x8*)(CM + fr * 128 + 32 * kk + 8 * fq); }
    const float ar = ((const float*)(ws + WS_SMALL + SM_ABAR))[(g * 64 + lane) * 2], ai = ((const float*)(ws + WS_SMALL + SM_ABAR))[(g * 64 + lane) * 2 + 1];
    const f32x4 dv = *(const f32x4*)(A.in[28] + l * 512 + 16 * g + 4 * fq);
    const int rbase = sample ? MP + s * 32 : s * TP + c * TC;
    float xr = 0.f, xi = 0.f;
    if (MODE == 1 && !sample) {
        const float tr = ((const float*)(ws + WS_SMALL + SM_ABARTC))[(g * 64 + lane) * 2], ti = ((const float*)(ws + WS_SMALL + SM_ABARTC))[(g * 64 + lane) * 2 + 1];
        const float* AG = (const float*)(ws + WS_AGGS5) + ((size_t)(s * NCH) * 2048 + g * 64 + lane) * 2;
        f32x2 ag[NCH - 1];
#pragma unroll
        for (int cc = 0; cc < NCH - 1; ++cc) ag[cc] = (cc < c) ? *(const f32x2*)(AG + (size_t)cc * 4096) : (f32x2){0.f, 0.f};
#pragma unroll
        for (int cc = 0; cc < NCH - 1; ++cc) if (cc < c) { const float nr = tr * xr - ti * xi + ag[cc].x, ni = tr * xi + ti * xr + ag[cc].y; xr = nr; xi = ni; }
    }
    const int ntile = sample ? 2 : 8;
#define S5_BU(uz_) do { const bf16x8 U_ = __builtin_bit_cast(bf16x8, uz_); _Pragma("unroll") for (int n = 0; n < 8; ++n) { \
        f32x4 a_ = __builtin_amdgcn_mfma_f32_16x16x32_bf16(Bf[n], U_, (f32x4){0.f, 0.f, 0.f, 0.f}, 0, 0, 0); *(LAS f32x4*)(BU + fr * 132 + 16 * n + 4 * fq) = a_; } } while (0)
    v4u un = {0u, 0u, 0u, 0u}; u32x2 sxc = {0u, 0u};
    { v4u u0 = {0u, 0u, 0u, 0u}; if (fq < 2) u0 = *(const v4u*)(SX + (size_t)(rbase + fr) * 512 + 16 * g + 8 * fq);
      if (fq < 2) un = *(const v4u*)(SX + (size_t)(rbase + 16 + fr) * 512 + 16 * g + 8 * fq);
      if (MODE == 1) sxc = *(const u32x2*)(SX + (size_t)(rbase + fr) * 512 + 16 * g + 4 * fq);
      S5_BU(u0); }
#pragma unroll 1
    for (int tile = 0; tile < ntile; ++tile) {
        const int row = rbase + 16 * tile + fr;
        LDS_WAIT(); asm volatile("" ::: "memory");
        float br[16], bi[16];
#pragma unroll
        for (int tt = 0; tt < 16; ++tt) { br[tt] = BU[tt * 132 + lane]; bi[tt] = BU[tt * 132 + 64 + lane]; }
        u32x2 sxn = {0u, 0u};
        if (tile + 1 < ntile) {
            S5_BU(un);
            if (tile + 2 < ntile && fq < 2) un = *(const v4u*)(SX + (size_t)(row + 32) * 512 + 16 * g + 8 * fq);
            if (MODE == 1) sxn = *(const u32x2*)(SX + (size_t)(row + 16) * 512 + 16 * g + 4 * fq);
        }
#pragma unroll
        for (int tt = 0; tt < 16; ++tt) {
            if (sample && (tt & 7) == 0) { const size_t si = ((size_t)((s * 4 + tile * 2 + (tt >> 3)) * 2 + l) * 32 + g) * 64 + lane; xr = A.in[4][si]; xi = A.in[5][si]; }
            const float nr = ar * xr - ai * xi + br[tt], ni = ar * xi + ai * xr + bi[tt]; xr = nr; xi = ni;
            if (MODE == 1) { const unsigned xx = pk2(xr, xi); XS[tt * 136 + lane] = (bf16)(xx & 0xffffu); XS[tt * 136 + 64 + lane] = (bf16)(xx >> 16); }
            if (MODE == 1 && sample && (tt & 7) == 7) { const size_t si = ((size_t)((s * 4 + tile * 2 + (tt >> 3)) * 2 + l) * 32 + g) * 64 + lane; A.out[O_SS5R + si] = xr; A.out[O_SS5I + si] = xi; }
        }
        if (MODE == 1) {
            LDS_WAIT(); asm volatile("" ::: "memory");
            f32x4 y = {0.f, 0.f, 0.f, 0.f};
#pragma unroll
            for (int kk = 0; kk < 4; ++kk) { const bf16x8 xb = *(const LAS bf16x8*)(XS + fr * 136 + 32 * kk + 8 * fq); y = __builtin_amdgcn_mfma_f32_16x16x32_bf16(Cf[kk], xb, y, 0, 0, 0); }
            bf16* p = SX + (size_t)row * 512 + 16 * g + 4 * fq; const u32x2 sx = sxc;
            u32x2 o; o.x = pk2(fgelu(y.x + dv.x * bflo(sx.x)), fgelu(y.y + dv.y * bfhi(sx.x))); o.y = pk2(fgelu(y.z + dv.z * bflo(sx.y)), fgelu(y.w + dv.w * bfhi(sx.y)));
            *(u32x2*)p = o;
        }
        sxc = sxn;
    }
    LDS_WAIT(); asm volatile("" ::: "memory");
#undef S5_BU
    if (MODE == 0) { float* AG = (float*)(ws + WS_AGGS5) + ((size_t)(s * NCH + c) * 2048 + g * 64 + lane) * 2; AG[0] = xr; AG[1] = xi; }
    if (MODE == 1 && !sample && c == NCH - 1) { const size_t si = ((size_t)(s * 2 + l) * 32 + g) * 64 + lane; A.out[O_PS5R + si] = xr; A.out[O_PS5I + si] = xi; }
}

template <int MODE> __device__ __forceinline__ void mixer_phase(const Frame& F0, const Args& A, int l, int qi, int b0) {
    const Frame F = refresh(F0);
    int bx_ = blockIdx.x; asm volatile("" : "+s"(bx_)); if (bx_ < b0) return;
    gu32* q = F.ctl + CW_Q + 64 * qi;
    constexpr int N_A = MODE == 0 ? 2048 : NSP * NCH * 32, N_B = MODE == 0 ? 32 * 16 : 32 * 32, N_C = MODE == 0 ? NSP * (NCH - 1) * 32 : 0;
    constexpr int NTOT = N_A + N_B + N_C;
    (void)q;
    const int nb_ = F.G - b0, gw = F.wave * nb_ + (bx_ - b0), NGW = nb_ * NWAVES;
    for (int u0 = gw; u0 < NTOT; u0 += NGW) {
        int u = u0;
        if (MODE == 0) {
            if (u < N_A) { const int c = u >> 7, sh = u & 127; rg_unit_sp(F, A, l, sh >> 4, c, sh & 15); continue; } u -= N_A;
            if (u < N_B) { rg_unit<1>(F, A, l, true, u >> 4, 0, u & 15); continue; } u -= N_B;
            { const int g = u & 31, r = u >> 5, c = r % (NCH - 1), s2 = r / (NCH - 1); s5_unit<0>(F, A, l, false, s2, c, g); }
        } else {
            if (u < N_A) { const int g = u & 31, r = u >> 5, c = r % NCH, s2 = r / NCH; s5_unit<1>(F, A, l, false, s2, c, g); continue; } u -= N_A;
            s5_unit<1>(F, A, l, true, u >> 5, 0, u & 31);
        }
    }
    if (MODE == 0 && gw < N_A) { const int c = gw >> 7, sh = gw & 127; rg_unit_sp2(F, A, l, sh >> 4, c, sh & 15); }
}

__device__ __forceinline__ void ffn_fixup_local(const Frame& F0, const Args& A, int l, int pm) {
    const Frame F = refresh(F0);
    if (pm < 64 && (pm & 7) != 0) {
        const float* HALO = (const float*)(A.ws + WS_HALO); bf16* HF = (bf16*)(A.ws + WS_HFF);
        const float* cw = A.in[34] + (size_t)l * 3 * FF2; const float* cb = A.in[35] + (size_t)l * FF2;
        for (int c = F.tid; c < FF; c += NWAVES * 64) {
            float uc0[2], uc1[2];
#pragma unroll
            for (int bj = 0; bj < 2; ++bj) {
                const float a254 = HALO[((size_t)((pm - 1) * 4 + 0) * 2 + bj) * FF + c], a255 = HALO[((size_t)((pm - 1) * 4 + 1) * 2 + bj) * FF + c];
                const float r0 = HALO[((size_t)(pm * 4 + 2) * 2 + bj) * FF + c], r1 = HALO[((size_t)(pm * 4 + 3) * 2 + bj) * FF + c];
                const float w0 = cw[bj * FF + c], w1 = cw[FF2 + bj * FF + c], w2 = cw[2 * FF2 + bj * FF + c], b = cb[bj * FF + c];
                uc0[bj] = b + w0 * a254 + w1 * a255 + w2 * r0; uc1[bj] = b + w0 * a255 + w1 * r0 + w2 * r1;
            }
            HF[(size_t)(pm * 256) * FF + c] = (bf16)f2bf(fgelu(uc0[0]) * uc0[1]); HF[(size_t)(pm * 256 + 1) * FF + c] = (bf16)f2bf(fgelu(uc1[0]) * uc1[1]);
        }
    }
    asm volatile("s_waitcnt vmcnt(0)" ::: "memory"); __syncthreads();
}

__global__ void __launch_bounds__(NWAVES * 64, 2) hawk_fwd(Args args) {
    extern __shared__ __attribute__((aligned(16))) unsigned char lds[];
    Frame F;
    F.lds = (LAS unsigned char*)lds;
    F.MISC = (volatile LAS unsigned*)(F.lds + MISC_OFF);
    F.tid = threadIdx.x; F.lane = F.tid & 63; F.wave = __builtin_amdgcn_readfirstlane(F.tid >> 6);
    F.G = gridDim.x; { const int bx = blockIdx.x; F.vcu = (F.G % 8 == 0) ? (bx % 8) * (F.G / 8) + bx / 8 : bx; }
    unsigned char* ws = args.ws;
    F.ctl = (gu32*)(ws + WS_CTL);
    for (int u = F.tid; u < (LDS_BYTES - LDSCTL_OFF) / 4; u += NWAVES * 64) ((LAS unsigned*)(F.lds + LDSCTL_OFF))[u] = 0u;
    __syncthreads();
    XcdBarrier bar = xcd_barrier_post((unsigned*)(F.ctl + CW_BAR), F.MISC + 8);
#define GRID_BAR() xcd_barrier(bar)

#pragma unroll 1
    for (int st = 0; st < NST_MAX; ++st) {
        unsigned char* ws = args.ws; float* outp = args.out; asm volatile("" : "+s"(ws), "+s"(outp));
        bf16* XRB = (bf16*)(ws + WS_XRB); float* MOD = (float*)(ws + WS_MOD); bf16* XN = (bf16*)(ws + WS_XN); int bid = (int)blockIdx.x; asm volatile("" : "+s"(bid));
        const int l = st < 2 ? 0 : (st - 2) / 10, sub = st < 2 ? st - 2 : (st == 22 ? 99 : (st - 2) % 10);
        const int ll = st == 22 ? 1 : l;
        const float* xin_p = ll == 0 ? args.in[0] : nullptr; const float* xin_s = ll == 0 ? args.in[1] - (size_t)MP * DM : nullptr;
        const float* modl = MOD + ll * 6144;
        bool is_gemm = false; pg8::Gemm g{nullptr, nullptr, 0, 0, 0, 0, 0}; pg8::EpiAny E{0, false, ws, nullptr, nullptr, nullptr, nullptr, 0, ll, (PG8_LAS float*)(F.lds + XCH_OFF)};
        switch (sub) {
            case -1: is_gemm = true; g = pg8::Gemm{(const pg8::bf16_t*)(ws + WS_SILUC), (const pg8::bf16_t*)(ws + WS_WADA), 256, MODW, DM, DM, DM}; E.mode = pg8::EM_ADA; E.perm = false; E.p0 = args.in[10]; E.out = MOD; break;
            case 1: is_gemm = true; g = pg8::Gemm{(const pg8::bf16_t*)XN, (const pg8::bf16_t*)(ws + WS_WIN), MROWS, INW, DM, DM, DM}; E.mode = pg8::EM_IN; E.perm = true; E.p0 = args.in[14] + l * INW; break;
            case 3: case 4: is_gemm = true; g = pg8::Gemm{(const pg8::bf16_t*)(ws + WS_RY), (const pg8::bf16_t*)(ws + WS_WRG), MROWS, DM, DM, DM, DM}; E.mode = pg8::EM_RGP; E.perm = true; break;
            case 5: is_gemm = true; g = pg8::Gemm{(const pg8::bf16_t*)(ws + WS_SX), (const pg8::bf16_t*)(ws + WS_WGLU), MROWS, 2048, 512, 512, 512}; E.mode = pg8::EM_GLU; E.perm = true; break;
            case 6: is_gemm = true; g = pg8::Gemm{(const pg8::bf16_t*)(ws + WS_GA), (const pg8::bf16_t*)(ws + WS_WOUT), MROWS, DM, DM, DM, DM}; E.mode = pg8::EM_RES; E.perm = true; E.p0 = xin_p; E.p2 = modl + 2048; E.row_off = 0; break;
            case 8: is_gemm = true; g = pg8::Gemm{(const pg8::bf16_t*)XN, (const pg8::bf16_t*)(ws + WS_WUP), MROWS, FF2, DM, DM, DM}; E.mode = pg8::EM_UPF; E.perm = true; E.p0 = args.in[34] + (size_t)l * 3 * FF2; E.p1 = args.in[35] + (size_t)l * FF2; E.p2 = args.in[6]; E.out = outp; break;
            case 9: is_gemm = true; g = pg8::Gemm{(const pg8::bf16_t*)(ws + WS_HFF), (const pg8::bf16_t*)(ws + WS_WDOWN), MROWS, DM, FF, FF, FF}; E.mode = pg8::EM_RES; E.perm = true; E.p0 = nullptr; E.p2 = modl + 5120; E.row_off = 1; break;
            default: break;
        }
#ifndef DUP
#define DUP 0
#endif
        const int nrep = (DUP == 1 && sub == 2) || (DUP == 2 && (st == 0 || (sub == 0 && l == 1))) || (DUP == 3 && sub == 8) || (DUP == 4 && (sub == 0 || sub == 7)) || (DUP == 5 && sub == 1) || (DUP == 6 && sub == 6 && l == 0) || (DUP == 7 && ((sub == 0 && l == 0 && st >= 2) || sub == 9)) ? 2 : 1;
#pragma unroll 1
        for (int rep = 0; rep < nrep; ++rep) {
        if (rep == 1) GRID_BAR();
        if (st < 2 || (sub == 0 && l == 1)) p0_weights(F, args, l, st == 0 ? 0 : 1, st == 1 ? 48 : 0, st == 1 ? F.G - 48 : F.G);
        if (sub == 0 || sub == 7) norm_rows(F, sub == 0 ? xin_p : nullptr, sub == 0 ? xin_s : nullptr, XRB, (sub == 0 ? args.in[11] : args.in[12]) + l * DM, modl + (sub == 0 ? 0 : 3072), modl + (sub == 0 ? 1024 : 4096), XN,
                                            sub == 7 ? 4 : (l == 1 ? 12 : 0), sub == 7 ? modl + 2048 : MOD + 5120, (const float*)(ws + (sub == 7 ? WS_PART_OUT : WS_PART_DOWN)));
        if (sub == 2) mixer_phase<0>(F, args, l, l * 2 + rep * 4, 0);
        if (sub == 3) mixer_phase<1>(F, args, l, l * 2 + 1, 16);
        if (is_gemm) { pg8::SplitOrder S; S.init(g.M, g.N, g.K, F.G, bid, (sub == 6 || sub == 9) ? 1 : (sub == 4 ? 2 : (sub == 3 ? 3 : 0)), 256);
            if (sub == 9) { pg8::Unit u0; ffn_fixup_local(F, args, l, S.next(0, u0) ? u0.pm : 64); } pg8::gemm_phase<pg8::EpiAny, pg8::SplitOrder, true, true>(F.lds, g, S, E); }
        }
        if (sub == 99) final_norm(F, XRB, outp + O_Y, args.in[37], 12, MOD + 6144 + 5120, (const float*)(ws + WS_PART_DOWN)); else GRID_BAR();
    }
}

extern "C" void kernel_launch(void* const* d_in, const int* in_sizes, int n_in, void* d_out, int out_size, void* d_ws, size_t ws_size, hipStream_t stream) {
    static int grid = 0;
    if (grid == 0) {
        if (n_in != 38 || out_size != 23396352 || ws_size < WS_END) { fprintf(stderr, "kernel_launch: unexpected shapes (n_in %d out %d ws %zu)\n", n_in, out_size, ws_size); grid = -1; return; }
        int dev = 0, cus = 0, per_cu = 0;
        if (hipGetDevice(&dev) != hipSuccess || hipDeviceGetAttribute(&cus, hipDeviceAttributeMultiprocessorCount, dev) != hipSuccess) { grid = -1; return; }
        if (hipFuncSetAttribute((const void*)hawk_fwd, hipFuncAttributeMaxDynamicSharedMemorySize, LDS_BYTES) != hipSuccess) { fprintf(stderr, "kernel_launch: hipFuncSetAttribute failed\n"); grid = -1; return; }
        if (hipOccupancyMaxActiveBlocksPerMultiprocessor(&per_cu, (const void*)hawk_fwd, NWAVES * 64, LDS_BYTES) != hipSuccess || per_cu < 1) { fprintf(stderr, "kernel_launch: occupancy query says %d\n", per_cu); per_cu = 1; }
        (void)hipGetLastError();
        grid = cus;
    }
    if (grid < 0) return;
    if (hipMemsetAsync((char*)d_ws + WS_CTL, 0, CTL_ZERO_BYTES, stream) != hipSuccess) { fprintf(stderr, "kernel_launch: memset failed\n"); return; }
    if (hipMemsetAsync((char*)d_ws + WS_AGT, 0, 2 * MiB, stream) != hipSuccess) { fprintf(stderr, "kernel_launch: memset 2 failed\n"); return; }
    Args a{};
    for (int i = 0; i < 38; ++i) a.in[i] = (const float*)d_in[i];
    a.out = (float*)d_out; a.ws = (unsigned char*)d_ws;
    hipLaunchKernelGGL(hawk_fwd, dim3(grid), dim3(NWAVES * 64), LDS_BYTES, stream, a);
}
```

```cpp
#include <hip/hip_runtime.h>
#include <cstdio>
#include <cstdint>
namespace pg8 {
#define PG8_LAS __attribute__((address_space(3)))
typedef unsigned short bf16_t;
typedef short bf16x8 __attribute__((ext_vector_type(8)));
typedef float f32x4 __attribute__((ext_vector_type(4)));
typedef unsigned u32x4 __attribute__((ext_vector_type(4)));
constexpr int BM = 256, BK = 64, HALF = 128, HTB = HALF * BK * 2  , STAGE_BYTES = 8 * HTB, NXCD = 8, WGM = 8;

__host__ __device__ __forceinline__ int lds_byte(int r, int c) { const int st = (r >> 4) * 2 + (c >> 5), rr = r & 15, cc = c & 31, ob = rr * 64 + cc * 2; return st * 1024 + (ob ^ (((ob >> 9) & 1) << 5)); }
__host__ __device__ __forceinline__ void stage_rc(int b, int& R, int& C) { const int st = b / 1024, sb = b % 1024, swz = sb ^ (((sb >> 9) & 1) << 5); R = (st >> 1) * 16 + swz / 64; C = (st & 1) * 32 + (swz % 64) / 2; }
__host__ __device__ __forceinline__ int perm32(int rho) { const int n = rho >> 4, i = rho & 15; return 8 * (i >> 2) + 4 * n + (i & 3); }

struct Unit { int pm, pn, koff, nt, mini, ksl; };
struct Gemm { const bf16_t* A; const bf16_t* Bt; int M, N, K, lda, ldb; };

struct StaticOrder {
    int nM, nN, nwg, G, c, ntK;
    __host__ __device__ void init(int M, int N, int G_, int c_, int K_ = 128) { nM = M / BM; nN = N / BM; nwg = nM * nN; G = G_; c = c_; ntK = K_ / BK; }
    __host__ __device__ bool next(int i, Unit& u) const {
        const long L = (long)i * G + c; if (L >= nwg) return false;
        int wgid = (int)L; { const int q = nwg / NXCD, r = nwg % NXCD, xcd = wgid % NXCD, off = wgid / NXCD; wgid = (xcd < r ? xcd * (q + 1) : r * (q + 1) + (xcd - r) * q) + off; }
        const int nig = WGM * nN, gid = wgid / nig, fm = gid * WGM, gsz = (nM - fm) < WGM ? (nM - fm) : WGM;
        u.pm = fm + ((wgid % nig) % gsz); u.pn = (wgid % nig) / gsz; u.koff = 0; u.nt = ntK; u.mini = 0; u.ksl = 256; return true;
    }
    __device__ __forceinline__ void a_ready(const Unit&) const {}
    __device__ __forceinline__ void done(const Unit&) const {}
};
struct SplitOrder {
    StaticOrder so; int nslice, nmini, rounds, smode, ksl;
    __device__ void init(int M, int N, int K, int G_, int c_, int smode_, int ksl_) { smode = smode_; ksl = ksl_; so.init(smode_ == 0 ? M : 16384, N, G_, c_, K); nslice = K / ksl_; nmini = smode_ == 1 ? 4 * (N / BM) * nslice : 0; rounds = (so.nwg + G_ - 1) / G_; }
    __device__ bool next(int i, Unit& u) const {
        const long L = (long)i * so.G + so.c;
        if (smode == 3) { if (L >= 4 * so.nN) return false; u.pm = 64 + (int)L / so.nN; u.pn = (int)L % so.nN; u.koff = 0; u.nt = so.ntK; u.mini = 0; u.ksl = 256; return true; }
        if (L < so.nwg) return so.next(i, u);
        const int mm = (int)(L - so.nwg);
        if (mm >= nmini) return false;
        const int kc = mm % nslice, t16 = mm / nslice; u.pm = 64 + t16 / so.nN; u.pn = t16 % so.nN; u.koff = kc * ksl; u.nt = ksl / BK; u.mini = 1; u.ksl = ksl; return true;
    }
    __device__ __forceinline__ void a_ready(const Unit&) const {}
    __device__ __forceinline__ void done(const Unit&) const {}
};


__device__ __forceinline__ unsigned cvt_pk_bf16(float lo, float hi) { unsigned r; asm volatile("v_cvt_pk_bf16_f32 %0, %1, %2" : "=v"(r) : "v"(lo), "v"(hi)); return r; }
typedef float f32x2 __attribute__((ext_vector_type(2)));
__device__ __forceinline__ f32x2 gelu_pk(f32x2 v) {
    const f32x2 av = __builtin_elementwise_abs(v), d = av * 0.2316418882f + 1.0f;
    f32x2 t; t.x = __builtin_amdgcn_rcpf(d.x); t.y = __builtin_amdgcn_rcpf(d.y);
    f32x2 q = t * 0.5307027145f + (-0.7265760135f); q = q * t + 0.7107068705f; q = q * t + (-0.142248368f); q = q * t + 0.127414796f; q = q * t;
    const f32x2 s = (v * v) * (-0.72134752044f);
    f32x2 e; e.x = __builtin_amdgcn_exp2f(s.x); e.y = __builtin_amdgcn_exp2f(s.y);
    const f32x2 m = v * (q * e), r = v - m;
    f32x2 o; o.x = v.x < 0.f ? m.x : r.x; o.y = v.y < 0.f ? m.y : r.y; return o;
}

template <int ACT  > struct EpiBf16 {
    static constexpr bool PERM = true, AFTER_DRAIN = false; static_assert(ACT == 0 || ACT == 1, "EpiBf16: ACT is 0 (none) or 1 (gelu_pk)");
    bf16_t* O; int ldc; const float* bias; int split_cols; size_t split_stride; float scale0;
    __device__ __forceinline__ void operator()(const f32x4 (&acc)[2][2][4][2], const Unit& u, int wr, int wc, int fr, int fq) const {
        const int row0 = u.pm * BM + wr * 64 + fr; int colt = u.pn * BM; bf16_t* base = O;
        float sc = 1.f; if (split_cols) { const int t = colt / split_cols; base += (size_t)t * split_stride; colt -= t * split_cols; if (t == 0) sc = scale0; }
        const int col0 = colt + wc * 32 + 8 * fq, bcol0 = u.pn * BM + wc * 32 + 8 * fq;
        f32x4 bv[2][2];
#pragma unroll
        for (int bj = 0; bj < 2; ++bj)
#pragma unroll
            for (int n = 0; n < 2; ++n) bv[bj][n] = bias ? *(const f32x4*)(bias + bcol0 + bj * HALF + 4 * n) : (f32x4){0.f, 0.f, 0.f, 0.f};
#pragma unroll
        for (int ai = 0; ai < 2; ++ai)
#pragma unroll
            for (int m = 0; m < 4; ++m) { bf16_t* rowp = base + (size_t)(row0 + ai * HALF + m * 16) * ldc + col0;
#pragma unroll
                for (int bj = 0; bj < 2; ++bj) { f32x4 v0 = acc[ai][bj][m][0] + bv[bj][0], v1 = acc[ai][bj][m][1] + bv[bj][1];
                    if (ACT == 1) { f32x2 a = gelu_pk((f32x2){v0[0], v0[1]}), b = gelu_pk((f32x2){v0[2], v0[3]}), c = gelu_pk((f32x2){v1[0], v1[1]}), d = gelu_pk((f32x2){v1[2], v1[3]});
                        v0 = (f32x4){a.x, a.y, b.x, b.y}; v1 = (f32x4){c.x, c.y, d.x, d.y}; }
                    v0 = v0 * sc; v1 = v1 * sc; u32x4 w; w.x = cvt_pk_bf16(v0[0], v0[1]); w.y = cvt_pk_bf16(v0[2], v0[3]); w.z = cvt_pk_bf16(v1[0], v1[1]); w.w = cvt_pk_bf16(v1[2], v1[3]);
                    *(u32x4*)(rowp + bj * HALF) = w; } }
    }
};

template <class Epi, class Sched, bool ALIGN_EPI, bool SP2>
__device__ __forceinline__ void gemm_phase(PG8_LAS unsigned char* lds, const Gemm g, const Sched& S, const Epi& E) {
    int tid_ = threadIdx.x; asm volatile("" : "+v"(tid_));
    const int tid = tid_, wid = __builtin_amdgcn_readfirstlane(tid >> 6), lane = tid & 63, wr = wid >> 2, wc = wid & 3, fr = lane & 15, fq = lane >> 4;
    const int lda = g.lda, ldb = g.ldb;
    unsigned voffA[2], voffB[2];
#pragma unroll
    for (int i = 0; i < 2; ++i) { int R, C; stage_rc(tid * 16 + i * 8192, R, C); const int Rb = E.perm ? ((R & ~31) + perm32(R & 31)) : R;
        voffA[i] = (unsigned)(R * lda + C) * 2u; voffB[i] = (unsigned)(Rb * ldb + C) * 2u; }
    const size_t kstep = (size_t)(BK * 2);
    const size_t hstepA = (size_t)HALF * lda * 2, hstepB = (size_t)HALF * ldb * 2;
    const size_t tstepA = 2 * hstepA, tstepB = 2 * hstepB;
    const unsigned ldsw = (unsigned)wid * 1024u;
    const int aoff = lds_byte(wr * 64 + fr, fq * 8), boff = lds_byte(wc * 32 + fr, fq * 8);
#define PG8_SA(b, h) (((b) * 2 + (h)) * HTB)
#define PG8_SB(b, h) ((4 + (b) * 2 + (h)) * HTB)
#define PG8_STAGE(bufoff, gbase, voff) do { _Pragma("unroll") for (int _i = 0; _i < 2; ++_i) \
        __builtin_amdgcn_global_load_lds((const unsigned*)((const char*)(gbase) + (voff)[_i]), (PG8_LAS unsigned*)(lds + (bufoff) + ldsw + _i * 8192), 16, 0, 0); } while (0)
#define PG8_LDA(dst, b, h) do { _Pragma("unroll") for (int m = 0; m < 4; ++m) _Pragma("unroll") for (int k = 0; k < 2; ++k) dst[m][k] = *(const PG8_LAS bf16x8*)(lds + PG8_SA(b, h) + aoff + m * 2048 + k * 1024); } while (0)
#define PG8_LDB(dst, b, h) do { _Pragma("unroll") for (int n = 0; n < 2; ++n) _Pragma("unroll") for (int k = 0; k < 2; ++k) dst[n][k] = *(const PG8_LAS bf16x8*)(lds + PG8_SB(b, h) + boff + n * 2048 + k * 1024); } while (0)
#define PG8_MMA(ai, bj, At, Bt) do { __builtin_amdgcn_s_setprio(1); _Pragma("unroll") for (int m = 0; m < 4; ++m) _Pragma("unroll") for (int n = 0; n < 2; ++n) _Pragma("unroll") for (int k = 0; k < 2; ++k) \
        acc[ai][bj][m][n] = __builtin_amdgcn_mfma_f32_16x16x32_bf16(Bt[n][k], At[m][k], acc[ai][bj][m][n], 0, 0, 0); __builtin_amdgcn_s_setprio(0); } while (0)
#define PG8_WAIT_V(n) asm volatile("s_waitcnt vmcnt(" #n ")" ::: "memory")
#define PG8_WAIT_L(n) asm volatile("s_waitcnt lgkmcnt(" #n ")" ::: "memory")
#define PG8_BAR __builtin_amdgcn_s_barrier()
#define PG8_SCHED __builtin_amdgcn_sched_barrier(0)
    Unit cur, nxt; int ui = 0;
    if (!S.next(0, cur)) return;
    f32x4 acc[2][2][4][2];
#pragma unroll
    for (int a = 0; a < 2; ++a)
#pragma unroll
        for (int b = 0; b < 2; ++b)
#pragma unroll
            for (int m = 0; m < 4; ++m)
#pragma unroll
                for (int n = 0; n < 2; ++n) acc[a][b][m][n] = (f32x4){0.f, 0.f, 0.f, 0.f};
    bf16x8 At[4][2], B0[2][2], B1[2][2];
    const char* cA = (const char*)g.A + (size_t)cur.pm * tstepA + (size_t)cur.koff * 2; const char* cB = (const char*)g.Bt + (size_t)cur.pn * tstepB + (size_t)cur.koff * 2;
    S.a_ready(cur);
    if constexpr (SP2) {
        PG8_STAGE(PG8_SB(0, 0), cB, voffB); PG8_STAGE(PG8_SB(0, 1), cB + hstepB, voffB); PG8_STAGE(PG8_SA(0, 0), cA, voffA); PG8_STAGE(PG8_SA(0, 1), cA + hstepA, voffA);
        if (wr == 1) PG8_BAR;
        PG8_WAIT_V(2); PG8_BAR;
        PG8_STAGE(PG8_SB(1, 0), cB + kstep, voffB); PG8_STAGE(PG8_SA(1, 0), cA + kstep, voffA); PG8_STAGE(PG8_SB(1, 1), cB + hstepB + kstep, voffB);
        PG8_WAIT_V(6); PG8_BAR;
    } else {
        PG8_STAGE(PG8_SB(0, 0), cB, voffB); PG8_STAGE(PG8_SA(0, 0), cA, voffA); PG8_STAGE(PG8_SB(0, 1), cB + hstepB, voffB); PG8_STAGE(PG8_SA(0, 1), cA + hstepA, voffA);
        if (wr == 1) PG8_BAR;
        PG8_WAIT_V(4); PG8_BAR;
        PG8_STAGE(PG8_SB(1, 0), cB + kstep, voffB); PG8_STAGE(PG8_SA(1, 0), cA + kstep, voffA); PG8_STAGE(PG8_SB(1, 1), cB + hstepB + kstep, voffB);
        PG8_WAIT_V(6); PG8_BAR;
    }
    for (;;) {
        const bool has_next = S.next(ui + 1, nxt);
        const char* nA = has_next ? (const char*)g.A + (size_t)nxt.pm * tstepA + (size_t)nxt.koff * 2 : cA; const char* nB = has_next ? (const char*)g.Bt + (size_t)nxt.pn * tstepB + (size_t)nxt.koff * 2 : cB;
        const int nt = cur.nt;
        for (int t = 0; t < nt; t += 2) {
            const bool last = (t == nt - 2);
            const char* a1 = cA + (size_t)(t + 1) * kstep;
            const char* a2 = last ? nA : cA + (size_t)(t + 2) * kstep; const char* b2 = last ? nB : cB + (size_t)(t + 2) * kstep;
            const char* a3 = a2 + kstep; const char* b3 = b2 + kstep;
            if (last && has_next) S.a_ready(nxt);
            if constexpr (SP2) {
            PG8_LDB(B0, 0, 0); PG8_LDB(B1, 0, 1); PG8_SCHED; PG8_LDA(At, 0, 0); PG8_STAGE(PG8_SA(1, 1), a1 + hstepA, voffA);
            PG8_WAIT_V(8); PG8_WAIT_L(0); PG8_BAR; PG8_MMA(0, 0, At, B0); PG8_MMA(0, 1, At, B1); PG8_BAR; PG8_SCHED;
            PG8_LDA(At, 0, 1); PG8_STAGE(PG8_SB(0, 0), b2, voffB); PG8_STAGE(PG8_SB(0, 1), b2 + hstepB, voffB); PG8_STAGE(PG8_SA(0, 0), a2, voffA);
            PG8_WAIT_V(8); PG8_WAIT_L(0); PG8_BAR; PG8_MMA(1, 0, At, B0); PG8_MMA(1, 1, At, B1); PG8_BAR; PG8_SCHED;
            PG8_LDB(B0, 1, 0); PG8_LDB(B1, 1, 1); PG8_SCHED; PG8_LDA(At, 1, 0); PG8_STAGE(PG8_SA(0, 1), a2 + hstepA, voffA);
            PG8_WAIT_V(8); PG8_WAIT_L(0); PG8_BAR; PG8_MMA(0, 0, At, B0); PG8_MMA(0, 1, At, B1); PG8_BAR; PG8_SCHED;
            PG8_LDA(At, 1, 1); PG8_STAGE(PG8_SB(1, 0), b3, voffB); PG8_STAGE(PG8_SB(1, 1), b3 + hstepB, voffB); PG8_STAGE(PG8_SA(1, 0), a3, voffA);
            PG8_WAIT_V(8); PG8_WAIT_L(0); PG8_BAR; PG8_MMA(1, 0, At, B0); PG8_MMA(1, 1, At, B1); PG8_BAR; PG8_SCHED;
            } else {
            PG8_LDB(B0, 0, 0); PG8_SCHED; PG8_LDA(At, 0, 0); PG8_STAGE(PG8_SA(1, 1), a1 + hstepA, voffA);
            PG8_WAIT_L(8); PG8_BAR; PG8_WAIT_L(0); PG8_MMA(0, 0, At, B0); PG8_BAR; PG8_SCHED;
            PG8_LDB(B1, 0, 1); PG8_STAGE(PG8_SB(0, 0), b2, voffB);
            PG8_BAR; PG8_WAIT_L(0); PG8_MMA(0, 1, At, B1); PG8_BAR;
            PG8_LDA(At, 0, 1); PG8_STAGE(PG8_SA(0, 0), a2, voffA);
            PG8_BAR; PG8_WAIT_L(0); PG8_MMA(1, 0, At, B0); PG8_BAR; PG8_SCHED;
            PG8_STAGE(PG8_SB(0, 1), b2 + hstepB, voffB);
            PG8_WAIT_V(6); PG8_BAR; PG8_MMA(1, 1, At, B1); PG8_BAR;
            PG8_LDB(B0, 1, 0); PG8_SCHED; PG8_LDA(At, 1, 0); PG8_STAGE(PG8_SA(0, 1), a2 + hstepA, voffA);
            PG8_WAIT_L(8); PG8_BAR; PG8_WAIT_L(0); PG8_MMA(0, 0, At, B0); PG8_BAR; PG8_SCHED;
            PG8_LDB(B1, 1, 1); PG8_STAGE(PG8_SB(1, 0), b3, voffB);
            PG8_BAR; PG8_WAIT_L(0); PG8_MMA(0, 1, At, B1); PG8_BAR;
            PG8_LDA(At, 1, 1); PG8_STAGE(PG8_SA(1, 0), a3, voffA);
            PG8_BAR; PG8_WAIT_L(0); PG8_MMA(1, 0, At, B0); PG8_BAR; PG8_SCHED;
            PG8_STAGE(PG8_SB(1, 1), b3 + hstepB, voffB);
            PG8_WAIT_V(6); PG8_BAR; PG8_MMA(1, 1, At, B1); PG8_BAR;
            }
        }
        if constexpr (ALIGN_EPI) { if (wr == 0) PG8_BAR; }
        if constexpr (!Epi::AFTER_DRAIN) { E(acc, cur, wr, wc, fr, fq); S.done(cur); }
        if (!has_next) break;
#pragma unroll
        for (int a = 0; a < 2; ++a)
#pragma unroll
            for (int b = 0; b < 2; ++b)
#pragma unroll
                for (int m = 0; m < 4; ++m)
#pragma unroll
                    for (int n = 0; n < 2; ++n) acc[a][b][m][n] = (f32x4){0.f, 0.f, 0.f, 0.f};
        cur = nxt; cA = nA; cB = nB; ++ui;
        if constexpr (ALIGN_EPI) { if (wr == 1) PG8_BAR; }
    }
    PG8_WAIT_V(0);
    if constexpr (!ALIGN_EPI) { if (wr == 0) PG8_BAR; }
    PG8_BAR;
    if constexpr (Epi::AFTER_DRAIN) { E.fused(acc, cur, wr, wc, fr, fq, lds, wid, lane); S.done(cur); }
#undef PG8_SA
#undef PG8_SB
#undef PG8_STAGE
#undef PG8_LDA
#undef PG8_LDB
#undef PG8_MMA
#undef PG8_WAIT_V
#undef PG8_WAIT_L
#undef PG8_BAR
#undef PG8_SCHED
}
}
#define GAS __attribute__((address_space(1)))
#define LAS __attribute__((address_space(3)))
typedef unsigned short bf16;
typedef unsigned v4u __attribute__((ext_vector_type(4)));
typedef float f32x4 __attribute__((ext_vector_type(4)));
typedef short bf16x8 __attribute__((ext_vector_type(8)));
typedef GAS unsigned gu32;
typedef GAS unsigned long long gu64;
#define RLX_AGENT __ATOMIC_RELAXED, __HIP_MEMORY_SCOPE_AGENT
#define LDS_WAIT() asm volatile("s_waitcnt lgkmcnt(0)" ::: "memory")
#define VM_WAIT() asm volatile("s_waitcnt vmcnt(0)" ::: "memory")
__device__ __forceinline__ unsigned long long rt() { return __builtin_amdgcn_s_memrealtime(); }
__device__ __forceinline__ unsigned pk2(float lo, float hi) { unsigned r; asm("v_cvt_pk_bf16_f32 %0, %1, %2" : "=v"(r) : "v"(lo), "v"(hi)); return r; }
__device__ __forceinline__ unsigned f2bf(float f) { return pk2(f, 0.f) & 0xffffu; }
#define XB_TMO      128
#define XB_XCNT(j)  (256  + 64 * (j))
#define XB_XSUB(j)  (1280 + 64 * (j))
#define XB_XGEN(j)  (2304 + 64 * (j))
#define XB_TOP      3328
#define XB_TOPGEN   3392
#define XCD_BAR_WORDS 3456
#define XB_SPIN_CAP (1u << 18)

__device__ __forceinline__ unsigned xb_ld(unsigned* p)              { return __hip_atomic_load(p, __ATOMIC_RELAXED, __HIP_MEMORY_SCOPE_AGENT); }
__device__ __forceinline__ unsigned xb_add(unsigned* p, unsigned v) { return __hip_atomic_fetch_add(p, v, __ATOMIC_RELAXED, __HIP_MEMORY_SCOPE_AGENT); }
__device__ __forceinline__ unsigned xb_xcc_id() { return (unsigned)__builtin_amdgcn_s_getreg((3 << 11) | 20) & 0xFu; }
#define XB_SPIN(cond, bar) do { unsigned _sp = 0; while (cond) { __builtin_amdgcn_s_sleep(1); \
    if ((++_sp & 255u) == 0u) { if (xb_ld(&(bar)[XB_TMO])) break; if (_sp > XB_SPIN_CAP) { atomicAdd(&(bar)[XB_TMO], 1u); break; } } } } while (0)

struct XcdBarrier {
    unsigned* bar; unsigned x;
    volatile LAS unsigned* st;
};

__device__ __forceinline__ XcdBarrier xcd_barrier_post(unsigned* bar, volatile LAS unsigned* st) {
    XcdBarrier b; b.bar = bar; b.x = xb_xcc_id(); b.st = st;
    if (threadIdx.x == 0) (void)xb_add(&bar[XB_XCNT(b.x)], 1u);
    return b;
}
__device__ __forceinline__ void xcd_barrier_complete(unsigned* bar, unsigned x, unsigned& nloc, unsigned& nx) {
    const unsigned G = gridDim.x * gridDim.y * gridDim.z;
    unsigned sum, cnt, mine, sp = 0u;
    for (;;) {
        sum = 0u; cnt = 0u; mine = 0u;
#pragma unroll
        for (unsigned j = 0; j < 16; ++j) { const unsigned c = xb_ld(&bar[XB_XCNT(j)]); sum += c; cnt += (c > 0u) ? 1u : 0u; mine = (j == x) ? c : mine; }
        if (sum == G) break;
        __builtin_amdgcn_s_sleep(1);
        if ((++sp & 255u) == 0u) { if (xb_ld(&bar[XB_TMO])) break; if (sp > XB_SPIN_CAP) { atomicAdd(&bar[XB_TMO], 1u); break; } }
    }
    nloc = mine > 0u ? mine : 1u; nx = cnt > 0u ? cnt : 1u;
}

__device__ __forceinline__ void xcd_barrier(const XcdBarrier& b) {
    asm volatile("s_waitcnt vmcnt(0)" ::: "memory");
    __syncthreads();
    if (threadIdx.x == 0) {
        unsigned* bar = b.bar;
        __builtin_amdgcn_s_waitcnt(0);
        unsigned nloc = b.st[0], nx = b.st[1];
        if (nloc == 0u) { xcd_barrier_complete(bar, b.x, nloc, nx); b.st[0] = nloc; b.st[1] = nx; }
        const unsigned old = xb_add(&bar[XB_XSUB(b.x)], 1u);
        const unsigned gen = old / nloc;
        if (old + 1u == (gen + 1u) * nloc) {
            __builtin_amdgcn_fence(__ATOMIC_RELEASE, "agent");
            asm volatile("s_waitcnt vmcnt(0)" ::: "memory");
            const unsigned og = xb_add(&bar[XB_TOP], 1u);
            const unsigned tg = og / nx;
            if (og + 1u == (tg + 1u) * nx) xb_add(&bar[XB_TOPGEN], 1u);
            else XB_SPIN(xb_ld(&bar[XB_TOPGEN]) == tg, bar);
            __builtin_amdgcn_fence(__ATOMIC_ACQUIRE, "agent");
            xb_add(&bar[XB_XGEN(b.x)], 1u);
            asm volatile("s_waitcnt vmcnt(0)" ::: "memory");
        } else {
            XB_SPIN(xb_ld(&bar[XB_XGEN(b.x)]) == gen, bar);
            __builtin_amdgcn_fence(__ATOMIC_ACQUIRE, "agent");
            asm volatile("s_waitcnt vmcnt(0)" ::: "memory");
        }
    }
    __syncthreads();
}

constexpr int NWAVES = 8;
#ifndef NST_MAX
#define NST_MAX 23
#endif
constexpr int DM = 1024, MROWS = 17408, MP = 16384, TP = 2048, NSP = 8, NSS = 128, TS = 8;
constexpr int INW = 4608, FF = 3072, FF2 = 6144, NCI = 136, MODW = 12288;
constexpr float EPSN = 1e-6f;
constexpr int TC = 128, NCH = TP / TC;

constexpr size_t MiB = 1u << 20;
constexpr size_t WS_CTL = 0, CTL_ZERO_BYTES = 1 * MiB;
constexpr size_t WS_MOD = 1 * MiB;
constexpr size_t WS_WIN = 8 * MiB, WS_WRG = 17 * MiB, WS_WGLU = 19 * MiB, WS_WOUT = 21 * MiB, WS_WUP = 23 * MiB, WS_WDOWN = 35 * MiB;
constexpr size_t WS_SMALL = 41 * MiB;
constexpr size_t SM_WG = 0, SM_BBAR = 256 * 1024, SM_CMAT = 384 * 1024, SM_ABAR = 512 * 1024, SM_ABARTC = 528 * 1024;
constexpr size_t WS_XN = 42 * MiB;
constexpr size_t WS_XRB = 76 * MiB;
constexpr size_t WS_RX = 110 * MiB, WS_RY = 144 * MiB, WS_SX = 178 * MiB, WS_GA = 195 * MiB, WS_GB = 229 * MiB;
constexpr size_t WS_UPH = 110 * MiB, WS_HFFH = 212 * MiB;
constexpr size_t WS_HFF = 110 * MiB, WS_HALO = 212 * MiB;
constexpr size_t WS_WADA = 110 * MiB, WS_SILUC = 135 * MiB;
constexpr size_t WS_AGGRG = 263 * MiB, WS_AGGS5 = 263 * MiB;
constexpr size_t WS_PART_OUT = 229 * MiB, WS_PART_DOWN = 219 * MiB;
constexpr size_t WS_AGT = 267 * MiB;
constexpr size_t WS_END = 269 * MiB;
constexpr int CW_BAR = 4096, CW_Q = 8192;

constexpr size_t O_Y = 0, O_PRGH = 17825792, O_PRGC = 17842176, O_PS5R = 17891328, O_PS5I = 17924096, O_PFFN = 17956864,
                 O_SRGH = 18153472, O_SRGC = 18415616, O_SS5R = 19202048, O_SS5I = 19726336, O_SFFN = 20250624;

constexpr int RING_BYTES = 131072, LDSCTL_OFF = RING_BYTES, MISC_OFF = LDSCTL_OFF + 320, LDS_BYTES = 147456;
constexpr int XCH_OFF = RING_BYTES + 1024;

typedef float f32x2 __attribute__((ext_vector_type(2)));
typedef unsigned u32x2 __attribute__((ext_vector_type(2)));

struct Args { const float* in[38]; float* out; unsigned char* ws; };

struct Frame { LAS unsigned char* lds; volatile LAS unsigned* MISC; gu32* ctl; int tid, lane, wave, vcu, G; };
__device__ __forceinline__ Frame refresh(const Frame& F0) {
    Frame F = F0; int t = threadIdx.x; asm volatile("" : "+v"(t)); int bx = blockIdx.x; asm volatile("" : "+s"(bx));
    F.tid = t; F.lane = t & 63; F.wave = __builtin_amdgcn_readfirstlane(t >> 6); F.G = gridDim.x; F.vcu = (F.G % 8 == 0) ? (bx % 8) * (F.G / 8) + bx / 8 : bx; return F;
}

__device__ __forceinline__ float bf2f(unsigned short b) { return __builtin_bit_cast(float, (unsigned)b << 16); }
__device__ __forceinline__ float bflo(unsigned w) { return __builtin_bit_cast(float, w << 16); }
__device__ __forceinline__ float bfhi(unsigned w) { return __builtin_bit_cast(float, w & 0xffff0000u); }
__device__ __forceinline__ float fsig(float x) { return __builtin_amdgcn_rcpf(1.f + __builtin_amdgcn_exp2f(-1.44269504f * x)); }
__device__ __forceinline__ float fgelu(float x) { const float u = x * (1.f + 0.044715f * x * x); return x * __builtin_amdgcn_rcpf(1.f + __builtin_amdgcn_exp2f(-2.302208198f * u)); }
__device__ __forceinline__ float wave_sum(float v) {
#pragma unroll
    for (int o = 1; o < 64; o <<= 1) v += __shfl_xor(v, o);
    return v;
}
__device__ __forceinline__ int row_ci(int row) { return row < MP ? (row >> 11) : 8 + ((row - MP) >> 3); }

namespace pg8 {
enum { EM_ADA = 0, EM_IN = 1, EM_GLU = 2, EM_RGP = 3, EM_RES = 4, EM_PLAIN = 5, EM_UPF = 6 };
struct EpiAny {
    static constexpr bool AFTER_DRAIN = false;
    int mode; bool perm; unsigned char* ws; const float* p0; const float* p1; const float* p2; float* out; int row_off; int lay; PG8_LAS float* xch;
    __device__ __forceinline__ void operator()(const f32x4 (&acc)[2][2][4][2], const Unit& u, int wr, int wc, int fr, int fq) const {
        asm volatile("" : "+v"(fr), "+v"(fq), "+s"(wr), "+s"(wc));
        if (mode == EM_IN || mode == EM_PLAIN) {
            const int pn = u.pn; int ldc = 1024, ct = pn; size_t wo = WS_UPH;
            if (mode == EM_IN) { if (pn < 4) { wo = WS_RX; ct = pn; } else if (pn < 8) { wo = WS_RY; ct = pn - 4; } else if (pn < 10) { wo = WS_SX; ct = pn - 8; ldc = 512; } else if (pn < 14) { wo = WS_GA; ct = pn - 10; } else { wo = WS_GB; ct = pn - 14; } }
            else ldc = FF2;
            bf16_t* base = (bf16_t*)(ws + wo);
            const int row0 = u.pm * BM + wr * 64 + fr, col0 = ct * BM + wc * 32 + 8 * fq, bcol0 = pn * BM + wc * 32 + 8 * fq;
#pragma unroll
            for (int bj = 0; bj < 2; ++bj) {
                f32x4 b0 = {0.f, 0.f, 0.f, 0.f}, b1 = {0.f, 0.f, 0.f, 0.f};
                if (mode == EM_IN) { b0 = *(const f32x4*)(p0 + bcol0 + bj * HALF); b1 = *(const f32x4*)(p0 + bcol0 + bj * HALF + 4); }
#pragma unroll
                for (int ai = 0; ai < 2; ++ai)
#pragma unroll
                    for (int m = 0; m < 4; ++m) { bf16_t* rowp = base + (size_t)(row0 + ai * HALF + m * 16) * ldc + col0;
                        const f32x4 v0 = acc[ai][bj][m][0] + b0, v1 = acc[ai][bj][m][1] + b1;
                        u32x4 w; w.x = cvt_pk_bf16(v0[0], v0[1]); w.y = cvt_pk_bf16(v0[2], v0[3]); w.z = cvt_pk_bf16(v1[0], v1[1]); w.w = cvt_pk_bf16(v1[2], v1[3]);
                        *(u32x4*)(rowp + bj * HALF) = w; } }
        } else if (mode == EM_UPF) {
            const int pm = u.pm, pn = u.pn; const bool smp = pm >= 64; const int lane = fq * 16 + fr;
            bf16_t* HF = (bf16_t*)(ws + WS_HFF); float* HALO = (float*)(ws + WS_HALO);
            const int cb = pn * HALF + wc * 32 + 8 * fq;
            if (fr >= 14) {
#pragma unroll
                for (int ai = 0; ai < 2; ++ai)
#pragma unroll
                    for (int bj = 0; bj < 2; ++bj)
#pragma unroll
                        for (int n = 0; n < 2; ++n) *(PG8_LAS f32x4*)(xch + ((((ai * 2 + wr) * 2 + (fr - 14)) * 4 + wc) * 4 + fq) * 16 + bj * 8 + n * 4) = acc[ai][bj][3][n];
            }
            if (!smp) {
                if (wr == 1 && fr >= 14) {
#pragma unroll
                    for (int bj = 0; bj < 2; ++bj)
#pragma unroll
                        for (int n = 0; n < 2; ++n) { *(f32x4*)(HALO + ((size_t)(pm * 4 + (fr - 14)) * 2 + bj) * FF + cb + 4 * n) = acc[1][bj][3][n];
                            if ((pm & 7) == 7) *(f32x4*)(out + O_PFFN + ((size_t)((pm >> 3) * 2 + lay) * 2 + (fr - 14)) * FF2 + bj * FF + cb + 4 * n) = acc[1][bj][3][n]; }
                }
                if (wr == 0 && fr < 2) {
#pragma unroll
                    for (int bj = 0; bj < 2; ++bj)
#pragma unroll
                        for (int n = 0; n < 2; ++n) *(f32x4*)(HALO + ((size_t)(pm * 4 + 2 + fr) * 2 + bj) * FF + cb + 4 * n) = acc[0][bj][0][n];
                }
            } else if ((fr & 7) >= 6) {
#pragma unroll
                for (int ai = 0; ai < 2; ++ai)
#pragma unroll
                    for (int m = 0; m < 4; ++m) { const int sq = ((pm - 64) * BM + ai * HALF + wr * 64 + m * 16 + fr) >> 3;
#pragma unroll
                        for (int bj = 0; bj < 2; ++bj)
#pragma unroll
                            for (int n = 0; n < 2; ++n) *(f32x4*)(out + O_SFFN + ((size_t)(sq * 2 + lay) * 2 + ((fr & 7) - 6)) * FF2 + bj * FF + cb + 4 * n) = acc[ai][bj][m][n]; }
            }
            asm volatile("s_waitcnt lgkmcnt(0)" ::: "memory"); __builtin_amdgcn_s_barrier(); asm volatile("" ::: "memory");
#pragma unroll
            for (int n = 0; n < 2; ++n) {
                const int c4 = cb + 4 * n;
                f32x4 w[2][3], bb[2];
#pragma unroll
                for (int bj = 0; bj < 2; ++bj) { bb[bj] = *(const f32x4*)(p1 + bj * FF + c4);
#pragma unroll
                    for (int k = 0; k < 3; ++k) w[bj][k] = *(const f32x4*)(p0 + k * FF2 + bj * FF + c4); }
#pragma unroll
                for (int ai = 0; ai < 2; ++ai) {
                    f32x4 pg[2] = {{0.f, 0.f, 0.f, 0.f}, {0.f, 0.f, 0.f, 0.f}};
                    const int blk = ai * 2 + wr;
                    if (!smp && blk > 0 && fr >= 14) {
#pragma unroll
                        for (int bj = 0; bj < 2; ++bj) pg[bj] = *(const PG8_LAS f32x4*)(xch + (((((blk - 1) * 2 + (fr - 14)) * 4 + wc) * 4 + fq) * 16 + bj * 8 + n * 4));
                    }
#pragma unroll
                    for (int m = 0; m < 4; ++m) {
                        const int trow = ai * HALF + wr * 64 + m * 16 + fr;
                        f32x4 uc[2];
#pragma unroll
                        for (int bj = 0; bj < 2; ++bj) {
                            const f32x4 cur = acc[ai][bj][m][n]; f32x4 p1v, p2v;
#pragma unroll
                            for (int j = 0; j < 4; ++j) { const float x1 = (fr == 15) ? pg[bj][j] : cur[j], x2 = (fr >= 14) ? pg[bj][j] : cur[j];
                                p1v[j] = __builtin_bit_cast(float, __builtin_amdgcn_update_dpp(0, __builtin_bit_cast(int, x1), 0x121, 0xF, 0xF, false));
                                p2v[j] = __builtin_bit_cast(float, __builtin_amdgcn_update_dpp(0, __builtin_bit_cast(int, x2), 0x122, 0xF, 0xF, false)); }
                            if (smp) { const int t = fr & 7;
                                if (t < 2) { const int sq = ((pm - 64) * BM + trow) >> 3; const float* st = p2 + ((size_t)(sq * 2 + lay) * 2) * FF2 + bj * FF + c4;
                                    const f32x4 s1 = *(const f32x4*)(st + FF2); p2v = s1; if (t == 0) { p1v = s1; p2v = *(const f32x4*)st; } } }
                            uc[bj] = bb[bj] + w[bj][0] * p2v + w[bj][1] * p1v + w[bj][2] * cur;
                            pg[bj] = cur;
                        }
                        u32x2 o; o.x = cvt_pk_bf16(fgelu(uc[0][0]) * uc[1][0], fgelu(uc[0][1]) * uc[1][1]); o.y = cvt_pk_bf16(fgelu(uc[0][2]) * uc[1][2], fgelu(uc[0][3]) * uc[1][3]);
                        *(u32x2*)(HF + (size_t)(pm * BM + trow) * FF + c4) = o;
                    }
                }
            }
        } else if (mode == EM_GLU) {
            bf16_t* GA = (bf16_t*)(ws + WS_GA); const bf16_t* GB = (const bf16_t*)(ws + WS_GB);
            const int row0 = u.pm * BM + wr * 64 + fr, col0 = u.pn * HALF + wc * 32 + 8 * fq;
#pragma unroll
            for (int ai = 0; ai < 2; ++ai) {
                u32x4 gq[4], aq[4];
#pragma unroll
                for (int m = 0; m < 4; ++m) { const size_t off = (size_t)(row0 + ai * HALF + m * 16) * 1024 + col0; gq[m] = *(const u32x4*)(GB + off); aq[m] = *(const u32x4*)(GA + off); }
#pragma unroll
                for (int m = 0; m < 4; ++m) { const size_t off = (size_t)(row0 + ai * HALF + m * 16) * 1024 + col0;
                    const u32x4 g = gq[m], a = aq[m];
                    float gv[8] = {bflo(g.x), bfhi(g.x), bflo(g.y), bfhi(g.y), bflo(g.z), bfhi(g.z), bflo(g.w), bfhi(g.w)};
                    float av[8] = {bflo(a.x), bfhi(a.x), bflo(a.y), bfhi(a.y), bflo(a.z), bfhi(a.z), bflo(a.w), bfhi(a.w)}; float o[8];
#pragma unroll
                    for (int n = 0; n < 2; ++n)
#pragma unroll
                        for (int j = 0; j < 4; ++j) o[4 * n + j] = av[4 * n + j] + fsig(gv[4 * n + j]) * acc[ai][0][m][n][j] * fsig(acc[ai][1][m][n][j]);
                    u32x4 w; w.x = cvt_pk_bf16(o[0], o[1]); w.y = cvt_pk_bf16(o[2], o[3]); w.z = cvt_pk_bf16(o[4], o[5]); w.w = cvt_pk_bf16(o[6], o[7]);
                    *(u32x4*)(GA + off) = w; } }
        } else if (mode == EM_RGP) {
            bf16_t* GA = (bf16_t*)(ws + WS_GA);
            const int row0 = u.pm * BM + wr * 64 + fr, col0 = u.pn * BM + wc * 32 + 8 * fq;
#pragma unroll
            for (int ai = 0; ai < 2; ++ai) {
                u32x4 gq[4][2];
#pragma unroll
                for (int m = 0; m < 4; ++m)
#pragma unroll
                    for (int bj = 0; bj < 2; ++bj) gq[m][bj] = *(const u32x4*)(GA + (size_t)(row0 + ai * HALF + m * 16) * 1024 + col0 + bj * HALF);
#pragma unroll
                for (int m = 0; m < 4; ++m)
#pragma unroll
                    for (int bj = 0; bj < 2; ++bj) { const size_t off = (size_t)(row0 + ai * HALF + m * 16) * 1024 + col0 + bj * HALF;
                        const u32x4 g = gq[m][bj];
                        float gv[8] = {bflo(g.x), bfhi(g.x), bflo(g.y), bfhi(g.y), bflo(g.z), bfhi(g.z), bflo(g.w), bfhi(g.w)}; float o[8];
#pragma unroll
                        for (int n = 0; n < 2; ++n)
#pragma unroll
                            for (int j = 0; j < 4; ++j) o[4 * n + j] = fsig(gv[4 * n + j]) * acc[ai][bj][m][n][j];
                        u32x4 w; w.x = cvt_pk_bf16(o[0], o[1]); w.y = cvt_pk_bf16(o[2], o[3]); w.z = cvt_pk_bf16(o[4], o[5]); w.w = cvt_pk_bf16(o[6], o[7]);
                        *(u32x4*)(GA + off) = w; } }
        } else if (mode == EM_RES) {
            bf16_t* XB = (bf16_t*)(ws + WS_XRB);
            const int col0 = u.pn * BM + wc * 32 + 8 * fq;
            if (u.mini) {
#pragma unroll
                for (int ai = 0; ai < 2; ++ai)
#pragma unroll
                    for (int m = 0; m < 4; ++m) { const int r = u.pm * BM + ai * HALF + wr * 64 + m * 16 + fr;
#pragma unroll
                        for (int bj = 0; bj < 2; ++bj) { float* P = (float*)(ws + (row_off ? WS_PART_DOWN : WS_PART_OUT)) + ((size_t)(u.koff / u.ksl) * (MROWS - MP) + (r - MP)) * DM + col0 + bj * HALF;
                            *(f32x4*)P = acc[ai][bj][m][0]; *(f32x4*)(P + 4) = acc[ai][bj][m][1]; } }
            } else {
                const float* gt = p2 + (size_t)(u.pm >> 3) * MODW;
                f32x4 gq[2][2];
#pragma unroll
                for (int bj = 0; bj < 2; ++bj) { gq[bj][0] = *(const f32x4*)(gt + col0 + bj * HALF); gq[bj][1] = *(const f32x4*)(gt + col0 + bj * HALF + 4); }
#pragma unroll
                for (int ai = 0; ai < 2; ++ai) {
                    f32x4 sq[4][2][2];
#pragma unroll
                    for (int m = 0; m < 4; ++m)
#pragma unroll
                        for (int bj = 0; bj < 2; ++bj) { const size_t off = (size_t)(u.pm * BM + ai * HALF + wr * 64 + m * 16 + fr) * DM + col0 + bj * HALF;
                            if (p0) { sq[m][bj][0] = *(const f32x4*)(p0 + off); sq[m][bj][1] = *(const f32x4*)(p0 + off + 4); }
                            else { const u32x4 b = *(const u32x4*)(XB + off); sq[m][bj][0] = (f32x4){bflo(b.x), bfhi(b.x), bflo(b.y), bfhi(b.y)}; sq[m][bj][1] = (f32x4){bflo(b.z), bfhi(b.z), bflo(b.w), bfhi(b.w)}; } }
#pragma unroll
                    for (int m = 0; m < 4; ++m)
#pragma unroll
                        for (int bj = 0; bj < 2; ++bj) { const size_t off = (size_t)(u.pm * BM + ai * HALF + wr * 64 + m * 16 + fr) * DM + col0 + bj * HALF;
                            const f32x4 o0 = sq[m][bj][0] + gq[bj][0] * acc[ai][bj][m][0], o1 = sq[m][bj][1] + gq[bj][1] * acc[ai][bj][m][1];
                            u32x4 w; w.x = cvt_pk_bf16(o0[0], o0[1]); w.y = cvt_pk_bf16(o0[2], o0[3]); w.z = cvt_pk_bf16(o1[0], o1[1]); w.w = cvt_pk_bf16(o1[2], o1[3]);
                            *(u32x4*)(XB + off) = w; } }
            }
        } else {
            const int col0 = u.pn * BM + wc * 32 + 4 * fq;
#pragma unroll
            for (int ai = 0; ai < 2; ++ai)
#pragma unroll
                for (int m = 0; m < 4; ++m) { const int r = ai * HALF + wr * 64 + m * 16 + fr;
                    if (r < NCI) {
#pragma unroll
                        for (int bj = 0; bj < 2; ++bj)
#pragma unroll
                            for (int n = 0; n < 2; ++n) { const int c = col0 + bj * HALF + n * 16; *(f32x4*)(out + (size_t)r * MODW + c) = acc[ai][bj][m][n] + *(const f32x4*)(p0 + c); } } }
        }
    }
};
}

template <int MAP> __device__ __forceinline__ int wt_row(int n) {
    if (MAP == 1) { return n < 1024 ? ((n >> 7) << 8) + (n & 127) : (((n - 1024) >> 7) << 8) + 128 + (n & 127); }
    if (MAP == 2) { return n < 3072 ? ((n >> 7) << 8) + (n & 127) : (((n - 3072) >> 7) << 8) + 128 + (n & 127); }
    return n;
}
template <int MAP> __device__ __forceinline__ void p0_transpose_item(const float* W, int K, int N, bf16* WT, int row_off, LAS float* scr, int item, int lane) {
    const int nblk = N / 32, kb = item / nblk, nb = item % nblk, k0 = 64 * kb, n0 = 32 * nb;
    { f32x4 v[8];
#pragma unroll
      for (int i = 0; i < 8; ++i) v[i] = *(const f32x4*)(W + (size_t)(k0 + 8 * i + (lane >> 3)) * N + n0 + 4 * (lane & 7));
#pragma unroll
      for (int i = 0; i < 8; ++i) { LAS float* d = scr + (8 * i + (lane >> 3)) * 33 + 4 * (lane & 7); d[0] = v[i].x; d[1] = v[i].y; d[2] = v[i].z; d[3] = v[i].w; } }
    LDS_WAIT(); asm volatile("" ::: "memory");
    const int c = lane & 7;
#pragma unroll
    for (int j = 0; j < 4; ++j) { const int n = (lane >> 3) + 8 * j; const LAS float* s = scr + (8 * c) * 33 + n;
        v4u o; o.x = pk2(s[0 * 33], s[1 * 33]); o.y = pk2(s[2 * 33], s[3 * 33]); o.z = pk2(s[4 * 33], s[5 * 33]); o.w = pk2(s[6 * 33], s[7 * 33]);
        *(GAS v4u*)(WT + (size_t)(row_off + wt_row<MAP>(n0 + n)) * K + k0 + 8 * c) = o; }
    LDS_WAIT(); asm volatile("" ::: "memory");
}

__device__ __forceinline__ void p0_weights(const Frame& F0, const Args& A, int l, int part, int b0, int nb) {
    const Frame F = refresh(F0);
    unsigned char* ws = A.ws;
    LAS float* scr = (LAS float*)(F.lds + F.wave * 16384);
    int bx = blockIdx.x; asm volatile("" : "+s"(bx));
    if (bx < b0) return;
    const bool first = part == 0;
    const int gw = (bx - b0) * NWAVES + F.wave, NGW = nb * NWAVES;
    constexpr int I_IN = (DM / 64) * (INW / 32), I_SQ = (DM / 64) * (DM / 32), I_GLU = (512 / 64) * (2048 / 32), I_UP = (DM / 64) * (FF2 / 32), I_DN = (FF / 64) * (DM / 32), I_ADA = (DM / 64) * (FF2 / 32);
    constexpr int NLAYER = I_IN + 2 * I_SQ + I_GLU + I_UP + I_DN;
    const int nitems = first ? 2 * I_ADA : NLAYER;
    const int per_ = (nitems + NGW - 1) / NGW, it_hi = (gw + 1) * per_ < nitems ? (gw + 1) * per_ : nitems;
    for (int it = gw * per_; it < it_hi; ++it) {
        int r = first ? it + NLAYER : it;
        if (r < I_IN) { p0_transpose_item<0>(A.in[13] + (size_t)l * DM * INW, DM, INW, (bf16*)(ws + WS_WIN), 0, scr, r, F.lane); continue; } r -= I_IN;
        if (r < I_SQ) { p0_transpose_item<0>(A.in[30] + (size_t)l * DM * DM, DM, DM, (bf16*)(ws + WS_WRG), 0, scr, r, F.lane); continue; } r -= I_SQ;
        if (r < I_SQ) { p0_transpose_item<0>(A.in[32] + (size_t)l * DM * DM, DM, DM, (bf16*)(ws + WS_WOUT), 0, scr, r, F.lane); continue; } r -= I_SQ;
        if (r < I_GLU) { p0_transpose_item<1>(A.in[31] + (size_t)l * 512 * 2048, 512, 2048, (bf16*)(ws + WS_WGLU), 0, scr, r, F.lane); continue; } r -= I_GLU;
        if (r < I_UP) { p0_transpose_item<2>(A.in[33] + (size_t)l * DM * FF2, DM, FF2, (bf16*)(ws + WS_WUP), 0, scr, r, F.lane); continue; } r -= I_UP;
        if (r < I_DN) { p0_transpose_item<0>(A.in[36] + (size_t)l * FF * DM, FF, DM, (bf16*)(ws + WS_WDOWN), 0, scr, r, F.lane); continue; } r -= I_DN;
        if (r < I_ADA) { p0_transpose_item<0>(A.in[9], DM, FF2, (bf16*)(ws + WS_WADA), 0, scr, r, F.lane); continue; } r -= I_ADA;
        p0_transpose_item<0>(A.in[9] + (size_t)DM * FF2, DM, FF2, (bf16*)(ws + WS_WADA), FF2, scr, r, F.lane);
    }
    const int gt = (bx - b0) * (NWAVES * 64) + F.tid, NGT = nb * NWAVES * 64;
    if (!first) {
    bf16* WG = (bf16*)(ws + WS_SMALL + SM_WG);
    for (int e = gt; e < 2 * 16 * 4096; e += NGT) { const int gate = e >> 16, rem = e & 65535, h = rem >> 12, j = (rem >> 6) & 63, i = rem & 63;
        const float* src = (gate ? A.in[19] : A.in[17]) + (size_t)l * 65536 + h * 4096 + i * 64 + j;
        WG[((h * 2 + gate) * 64 + j) * 64 + i] = (bf16)f2bf(*src); }
    for (int e = gt; e < 2048; e += NGT) { const int g = e >> 6, p = e & 63;
        const float dt = expf(A.in[29][l * 32 + g]);
        const float lr = A.in[22][l * 2048 + e], li = A.in[23][l * 2048 + e];
        const float mag = expf(lr * dt); float sn, cs; sincosf(li * dt, &sn, &cs);
        const float ar = mag * cs, ai = mag * sn, den = lr * lr + li * li;
        const float zr = ((ar - 1.f) * lr + ai * li) / den, zi = (ai * lr - (ar - 1.f) * li) / den;
        float* AB = (float*)(ws + WS_SMALL + SM_ABAR); AB[e * 2] = ar; AB[e * 2 + 1] = ai;
        float pr = ar, pi = ai;
#pragma unroll 1
        for (int s = 0; s < 7; ++s) { const float nr = pr * pr - pi * pi, ni = 2.f * pr * pi; pr = nr; pi = ni; }
        float* ABT = (float*)(ws + WS_SMALL + SM_ABARTC); ABT[e * 2] = pr; ABT[e * 2 + 1] = pi;
        bf16* BB = (bf16*)(ws + WS_SMALL + SM_BBAR) + (size_t)g * 128 * 16;
        const float* bre = A.in[24] + ((size_t)l * 2048 + e) * 16; const float* bim = A.in[25] + ((size_t)l * 2048 + e) * 16;
#pragma unroll 4
        for (int c = 0; c < 16; ++c) { const float br = bre[c], bi = bim[c]; BB[p * 16 + c] = (bf16)f2bf(zr * br - zi * bi); BB[(64 + p) * 16 + c] = (bf16)f2bf(zr * bi + zi * br); }
        bf16* CM = (bf16*)(ws + WS_SMALL + SM_CMAT) + (size_t)g * 16 * 128;
        const float* cre = A.in[26] + ((size_t)l * 32 + g) * 1024; const float* cim = A.in[27] + ((size_t)l * 32 + g) * 1024;
#pragma unroll 4
        for (int c = 0; c < 16; ++c) { CM[c * 128 + p] = (bf16)f2bf(cre[c * 64 + p]); CM[c * 128 + 64 + p] = (bf16)f2bf(-cim[c * 64 + p]); }
    }
    }
    if (first) {
        bf16* XRs = (bf16*)(ws + WS_XRB) + (size_t)MP * DM;
        for (int e = gt; e < (MROWS - MP) * DM / 4; e += NGT) { const f32x4 v = ((const f32x4*)A.in[1])[e]; ((unsigned long long*)XRs)[e] = (unsigned long long)pk2(v.x, v.y) | ((unsigned long long)pk2(v.z, v.w) << 32); }
    }
    if (first) {
        bf16* SC = (bf16*)(ws + WS_SILUC);
        for (int e = gt; e < 256 * DM; e += NGT) { const int r = e >> 10, c = e & 1023; float v = 0.f;
            if (r < NSP) v = A.in[7][r * DM + c]; else if (r < NCI) v = A.in[8][(r - NSP) * DM + c];
            SC[e] = (bf16)f2bf(v * fsig(v)); }
    }
}

__device__ __forceinline__ void cvt8(const v4u w, float (&o)[8]) { o[0] = bflo(w.x); o[1] = bfhi(w.x); o[2] = bflo(w.y); o[3] = bfhi(w.y); o[4] = bflo(w.z); o[5] = bfhi(w.z); o[6] = bflo(w.w); o[7] = bfhi(w.w); }
__device__ __forceinline__ f32x4 ld_row4(const float* xf, const bf16* xb, size_t row, int idx) {
    if (xf) return ((const GAS f32x4*)(xf + row * DM))[idx];
    const u32x2 b = ((const GAS u32x2*)(xb + row * DM))[idx]; return (f32x4){bflo(b.x), bfhi(b.x), bflo(b.y), bfhi(b.y)};
}
__device__ __forceinline__ void norm_rows(const Frame& F0, const float* xp, const float* xs_adj, bf16* XRB, const float* g, const float* mod_sh, const float* mod_sc, bf16* XN, int npart, const float* pgate, const float* PART) {
    const Frame F = refresh(F0);
    const int gw = F.vcu * NWAVES + F.wave, NGW = F.G * NWAVES;
    if (!xp) {
        for (int m0 = 8 * gw; m0 < MP; m0 += 8 * NGW) {
            const int ci = m0 >> 11;
            v4u w[8][2]; float sr[8];
#pragma unroll
            for (int r = 0; r < 8; ++r)
#pragma unroll
                for (int j = 0; j < 2; ++j) w[r][j] = ((const GAS v4u*)(XRB + (size_t)(m0 + r) * DM))[64 * j + F.lane];
#pragma unroll
            for (int r = 0; r < 8; ++r) { float q = 0.f;
#pragma unroll
                for (int j = 0; j < 2; ++j) { float v[8]; cvt8(w[r][j], v);
#pragma unroll
                    for (int e = 0; e < 8; ++e) q += v[e] * v[e]; }
                sr[r] = __builtin_amdgcn_rsqf(wave_sum(q) * (1.f / DM) + EPSN); }
#pragma unroll
            for (int j = 0; j < 2; ++j) { const int c = 512 * j + 8 * F.lane; float gs[8], sh[8];
#pragma unroll
                for (int h2 = 0; h2 < 2; ++h2) { const f32x4 gg = *(const f32x4*)(g + c + 4 * h2), s4 = *(const f32x4*)(mod_sh + (size_t)ci * MODW + c + 4 * h2), c4 = *(const f32x4*)(mod_sc + (size_t)ci * MODW + c + 4 * h2);
#pragma unroll
                    for (int e = 0; e < 4; ++e) { gs[4 * h2 + e] = gg[e] * (c4[e] + 1.f); sh[4 * h2 + e] = s4[e]; } }
#pragma unroll
                for (int r = 0; r < 8; ++r) { float v[8]; cvt8(w[r][j], v); v4u o;
                    o.x = pk2(v[0] * sr[r] * gs[0] + sh[0], v[1] * sr[r] * gs[1] + sh[1]); o.y = pk2(v[2] * sr[r] * gs[2] + sh[2], v[3] * sr[r] * gs[3] + sh[3]);
                    o.z = pk2(v[4] * sr[r] * gs[4] + sh[4], v[5] * sr[r] * gs[5] + sh[5]); o.w = pk2(v[6] * sr[r] * gs[6] + sh[6], v[7] * sr[r] * gs[7] + sh[7]);
                    ((GAS v4u*)(XN + (size_t)(m0 + r) * DM))[64 * j + F.lane] = o; } }
        }
    } else
    for (int m0 = 4 * gw; m0 < MP; m0 += 4 * NGW) {
        const int ci = m0 >> 11;
        f32x4 v[4][4]; float s[4];
#pragma unroll
        for (int r = 0; r < 4; ++r)
#pragma unroll
            for (int j = 0; j < 4; ++j) v[r][j] = ld_row4(xp, XRB, (size_t)(m0 + r), 64 * j + F.lane);
#pragma unroll
        for (int r = 0; r < 4; ++r) { float q = 0.f;
#pragma unroll
            for (int j = 0; j < 4; ++j) q += (v[r][j].x * v[r][j].x + v[r][j].y * v[r][j].y) + (v[r][j].z * v[r][j].z + v[r][j].w * v[r][j].w);
            s[r] = 1.f / sqrtf(wave_sum(q) * (1.f / DM) + EPSN); }
#pragma unroll
        for (int j = 0; j < 4; ++j) { const int c = 256 * j + 4 * F.lane;
            const f32x4 gg = *(const f32x4*)(g + c), sh = *(const f32x4*)(mod_sh + (size_t)ci * MODW + c), sc = *(const f32x4*)(mod_sc + (size_t)ci * MODW + c);
            const f32x4 gs = gg * (sc + 1.f);
#pragma unroll
            for (int r = 0; r < 4; ++r) { const f32x4 y = v[r][j] * s[r] * gs + sh;
                ((GAS unsigned long long*)(XN + (size_t)(m0 + r) * DM))[64 * j + F.lane] = (unsigned long long)pk2(y.x, y.y) | ((unsigned long long)pk2(y.z, y.w) << 32); } }
    }
    for (int m = MP + gw; m < MROWS; m += NGW) {
        const int ci = row_ci(m);
        f32x4 v[4]; float q = 0.f;
#pragma unroll
        for (int j = 0; j < 4; ++j) { v[j] = ld_row4(xs_adj, XRB, (size_t)m, 64 * j + F.lane);
            if (npart > 0) {
                f32x4 ps = {0.f, 0.f, 0.f, 0.f};
#pragma unroll
                for (int k = 0; k < 12; ++k) if (k < npart) ps += *(const f32x4*)(PART + ((size_t)k * (MROWS - MP) + (m - MP)) * DM + 256 * j + 4 * F.lane);
                v[j] += *(const f32x4*)(pgate + (size_t)ci * MODW + 256 * j + 4 * F.lane) * ps;
                ((GAS unsigned long long*)(XRB + (size_t)m * DM))[64 * j + F.lane] = (unsigned long long)pk2(v[j].x, v[j].y) | ((unsigned long long)pk2(v[j].z, v[j].w) << 32);
            }
            q += (v[j].x * v[j].x + v[j].y * v[j].y) + (v[j].z * v[j].z + v[j].w * v[j].w); }
        const float rstd = 1.f / sqrtf(wave_sum(q) * (1.f / DM) + EPSN);
#pragma unroll
        for (int j = 0; j < 4; ++j) { const int c = 256 * j + 4 * F.lane;
            const f32x4 gg = *(const f32x4*)(g + c), sh = *(const f32x4*)(mod_sh + (size_t)ci * MODW + c), sc = *(const f32x4*)(mod_sc + (size_t)ci * MODW + c);
            const f32x4 y = v[j] * rstd * gg * (sc + 1.f) + sh;
            ((GAS unsigned long long*)(XN + (size_t)m * DM))[64 * j + F.lane] = (unsigned long long)pk2(y.x, y.y) | ((unsigned long long)pk2(y.z, y.w) << 32); }
    }
}
__device__ __forceinline__ void final_norm(const Frame& F0, const bf16* XRB, float* y, const float* g, int npart, const float* pgate, const float* PART) {
    const Frame F = refresh(F0);
    const int gw = F.vcu * NWAVES + F.wave, NGW = F.G * NWAVES;
    for (int m0 = 8 * gw; m0 < MP; m0 += 8 * NGW) {
        v4u w[8][2]; float sr[8];
#pragma unroll
        for (int r = 0; r < 8; ++r)
#pragma unroll
            for (int j = 0; j < 2; ++j) w[r][j] = ((const GAS v4u*)(XRB + (size_t)(m0 + r) * DM))[64 * j + F.lane];
#pragma unroll
        for (int r = 0; r < 8; ++r) { float q = 0.f;
#pragma unroll
            for (int j = 0; j < 2; ++j) { float v[8]; cvt8(w[r][j], v);
#pragma unroll
                for (int e = 0; e < 8; ++e) q += v[e] * v[e]; }
            sr[r] = __builtin_amdgcn_rsqf(wave_sum(q) * (1.f / DM) + EPSN); }
#pragma unroll
        for (int j = 0; j < 2; ++j) { const int c = 512 * j + 8 * F.lane; const f32x4 g0 = *(const f32x4*)(g + c), g1 = *(const f32x4*)(g + c + 4);
#pragma unroll
            for (int r = 0; r < 8; ++r) { float v[8]; cvt8(w[r][j], v); float* yp = y + (size_t)(m0 + r) * DM + c;
                *(f32x4*)yp = (f32x4){v[0], v[1], v[2], v[3]} * sr[r] * g0; *(f32x4*)(yp + 4) = (f32x4){v[4], v[5], v[6], v[7]} * sr[r] * g1; } }
    }
    for (int m = MP + gw; m < MROWS; m += NGW) {
        const int ci = row_ci(m);
        f32x4 v[4]; float q = 0.f;
#pragma unroll
        for (int j = 0; j < 4; ++j) { v[j] = ld_row4(nullptr, XRB, (size_t)m, 64 * j + F.lane);
            f32x4 ps = {0.f, 0.f, 0.f, 0.f};
#pragma unroll
            for (int k = 0; k < 12; ++k) if (k < npart) ps += *(const f32x4*)(PART + ((size_t)k * (MROWS - MP) + (m - MP)) * DM + 256 * j + 4 * F.lane);
            v[j] += *(const f32x4*)(pgate + (size_t)ci * MODW + 256 * j + 4 * F.lane) * ps;
            q += (v[j].x * v[j].x + v[j].y * v[j].y) + (v[j].z * v[j].z + v[j].w * v[j].w); }
        const float rstd = 1.f / sqrtf(wave_sum(q) * (1.f / DM) + EPSN);
#pragma unroll
        for (int j = 0; j < 4; ++j) { const f32x4 gg = *(const f32x4*)(g + 256 * j + 4 * F.lane); ((GAS f32x4*)(y + (size_t)m * DM))[64 * j + F.lane] = v[j] * rstd * gg; }
    }
}


template <int MODE> __device__ __forceinline__ void rg_unit(const Frame& F, const Args& A, int l, bool sample, int s, int c, int h) {
    unsigned char* ws = A.ws;
    LAS float* TAB = (LAS float*)(F.lds + F.wave * 15360);
    LAS float* XC = TAB + 512;
    LAS float* AA = XC + 16 * 68;
    LAS float* BB = AA + 16 * 68;
    const int lane = F.lane, fr = lane & 15, fq = lane >> 4, ch0 = 64 * h;
    const bf16* RX = (const bf16*)(ws + WS_RX); bf16* RY = (bf16*)(ws + WS_RY);
    {
        const int chg = l * DM + ch0 + lane;
#pragma unroll
        for (int j = 0; j < 4; ++j) TAB[j * 64 + lane] = A.in[15][(size_t)(l * 4 + j) * DM + ch0 + lane];
        TAB[4 * 64 + lane] = A.in[16][chg]; TAB[5 * 64 + lane] = A.in[18][chg]; TAB[6 * 64 + lane] = A.in[20][chg];
        const float lam = A.in[21][chg]; TAB[7 * 64 + lane] = -8.f * 1.44269504f * log1pf(expf(-lam));
    }
    bf16x8 Wf[2][4][2];
    { const bf16* WG = (const bf16*)(ws + WS_SMALL + SM_WG);
#pragma unroll
      for (int g = 0; g < 2; ++g)
#pragma unroll
        for (int n = 0; n < 4; ++n)
#pragma unroll
            for (int k = 0; k < 2; ++k) Wf[g][n][k] = *(const bf16x8*)(WG + ((h * 2 + g) * 64 + 16 * n + fr) * 64 + 32 * k + 8 * fq); }
    LDS_WAIT(); asm volatile("" ::: "memory");
    const int rbase = sample ? MP + s * 32 : s * TP + c * TC;
    float hst = 0.f, aprod = 1.f;
    if (MODE == 1 && !sample) {
        const float* AG = (const float*)(ws + WS_AGGRG) + ((size_t)(s * NCH) * DM + ch0 + lane) * 2;
        for (int cc = 0; cc < c; ++cc) { const float a = AG[(size_t)cc * DM * 2], b = AG[(size_t)cc * DM * 2 + 1]; hst = a * hst + b; }
    }
    const int ntile = sample ? 2 : 8;
#pragma unroll 1
    for (int tile = 0; tile < ntile; ++tile) {
        const int row = rbase + 16 * tile + fr;
        const int t = sample ? (fr & 7) : c * TC + 16 * tile + fr;
        const int sq = sample ? s * 4 + tile * 2 + (fr >> 3) : s;
        bf16x8 X[2];
#pragma unroll
        for (int k = 0; k < 2; ++k) {
            const int cl = 32 * k + 8 * fq; float xc[8];
            { const f32x4 b0 = *(const LAS f32x4*)(TAB + 4 * 64 + cl), b1 = *(const LAS f32x4*)(TAB + 4 * 64 + cl + 4); xc[0] = b0.x; xc[1] = b0.y; xc[2] = b0.z; xc[3] = b0.w; xc[4] = b1.x; xc[5] = b1.y; xc[6] = b1.z; xc[7] = b1.w; }
#pragma unroll
            for (int d = 0; d < 4; ++d) {
                float v[8];
                if (t - d >= 0) { cvt8(*(const v4u*)(RX + (size_t)(row - d) * DM + ch0 + cl), v); }
                else if (sample) { const float* st = A.in[3] + ((size_t)(sq * 2 + l) * 3 + (3 + t - d)) * DM + ch0 + cl; const f32x4 a0 = *(const f32x4*)st, a1 = *(const f32x4*)(st + 4);
                    v[0] = a0.x; v[1] = a0.y; v[2] = a0.z; v[3] = a0.w; v[4] = a1.x; v[5] = a1.y; v[6] = a1.z; v[7] = a1.w; }
                else {
#pragma unroll
                    for (int q = 0; q < 8; ++q) v[q] = 0.f; }
                const f32x4 w0 = *(const LAS f32x4*)(TAB + (3 - d) * 64 + cl), w1 = *(const LAS f32x4*)(TAB + (3 - d) * 64 + cl + 4);
                xc[0] += w0.x * v[0]; xc[1] += w0.y * v[1]; xc[2] += w0.z * v[2]; xc[3] += w0.w * v[3]; xc[4] += w1.x * v[4]; xc[5] += w1.y * v[5]; xc[6] += w1.z * v[6]; xc[7] += w1.w * v[7];
            }
            *(LAS f32x4*)(XC + fr * 68 + cl) = (f32x4){xc[0], xc[1], xc[2], xc[3]}; *(LAS f32x4*)(XC + fr * 68 + cl + 4) = (f32x4){xc[4], xc[5], xc[6], xc[7]};
            v4u pk; pk.x = pk2(xc[0], xc[1]); pk.y = pk2(xc[2], xc[3]); pk.z = pk2(xc[4], xc[5]); pk.w = pk2(xc[6], xc[7]);
            X[k] = __builtin_bit_cast(bf16x8, pk);
        }
        f32x4 acc[2][4];
#pragma unroll
        for (int g = 0; g < 2; ++g)
#pragma unroll
            for (int n = 0; n < 4; ++n) { acc[g][n] = (f32x4){0.f, 0.f, 0.f, 0.f};
#pragma unroll
                for (int k = 0; k < 2; ++k) acc[g][n] = __builtin_amdgcn_mfma_f32_16x16x32_bf16(Wf[g][n][k], X[k], acc[g][n], 0, 0, 0); }
        LDS_WAIT(); asm volatile("" ::: "memory");
#pragma unroll
        for (int n = 0; n < 4; ++n) { const int cl = 16 * n + 4 * fq;
            const f32x4 xv = *(const LAS f32x4*)(XC + fr * 68 + cl), ba = *(const LAS f32x4*)(TAB + 5 * 64 + cl), bx = *(const LAS f32x4*)(TAB + 6 * 64 + cl), c8 = *(const LAS f32x4*)(TAB + 7 * 64 + cl);
            f32x4 av, bv;
#pragma unroll
            for (int j = 0; j < 4; ++j) { const float r = fsig(acc[0][n][j] + ba[j]), ig = fsig(acc[1][n][j] + bx[j]); const float a = __builtin_amdgcn_exp2f(r * c8[j]);
                av[j] = a; bv[j] = __builtin_amdgcn_sqrtf(fmaxf(1.f - a * a, 0.f)) * ig * xv[j]; }
            *(LAS f32x4*)(AA + fr * 68 + cl) = av; *(LAS f32x4*)(BB + fr * 68 + cl) = bv; }
        LDS_WAIT(); asm volatile("" ::: "memory");
#pragma unroll
        for (int tt = 0; tt < 16; ++tt) {
            if (sample && (tt & 7) == 0) hst = A.in[2][(size_t)((s * 4 + tile * 2 + (tt >> 3)) * 2 + l) * DM + ch0 + lane];
            const float a = AA[tt * 68 + lane], b = BB[tt * 68 + lane];
            hst = a * hst + b; if (MODE == 0) aprod *= a;
            if (MODE == 1) BB[tt * 68 + lane] = hst;
            if (MODE == 1 && sample && (tt & 7) == 7) A.out[O_SRGH + (size_t)((s * 4 + tile * 2 + (tt >> 3)) * 2 + l) * DM + ch0 + lane] = hst;
        }
        if (MODE == 1) {
            LDS_WAIT(); asm volatile("" ::: "memory");
#pragma unroll
            for (int n = 0; n < 4; ++n) { const int cl = 16 * n + 4 * fq; const f32x4 hv = *(const LAS f32x4*)(BB + fr * 68 + cl);
                bf16* p = RY + (size_t)row * DM + ch0 + cl; const u32x2 ry = *(const u32x2*)p;
                u32x2 o; o.x = pk2(hv.x * fgelu(bflo(ry.x)), hv.y * fgelu(bfhi(ry.x))); o.y = pk2(hv.z * fgelu(bflo(ry.y)), hv.w * fgelu(bfhi(ry.y)));
                *(u32x2*)p = o; }
            LDS_WAIT(); asm volatile("" ::: "memory");
        }
    }
    if (MODE == 0) { float* AG = (float*)(ws + WS_AGGRG) + ((size_t)(s * NCH + c) * DM + ch0 + lane) * 2; AG[0] = aprod; AG[1] = hst; }
    if (MODE == 1) {
        if (!sample && c == NCH - 1) {
            A.out[O_PRGH + (size_t)(s * 2 + l) * DM + ch0 + lane] = hst;
#pragma unroll
            for (int k = 0; k < 3; ++k) A.out[O_PRGC + (size_t)((s * 2 + l) * 3 + k) * DM + ch0 + lane] = bf2f(RX[(size_t)(s * TP + TP - 3 + k) * DM + ch0 + lane]);
        }
        if (sample) {
#pragma unroll 1
            for (int q = 0; q < 4; ++q) { const int n = s * 4 + q;
#pragma unroll
                for (int k = 0; k < 3; ++k) A.out[O_SRGC + (size_t)((n * 2 + l) * 3 + k) * DM + ch0 + lane] = bf2f(RX[(size_t)(MP + n * TS + 5 + k) * DM + ch0 + lane]); }
        }
    }
}

__device__ __forceinline__ void rg_unit_sp(const Frame& F, const Args& A, int l, int s, int c, int h) {
    constexpr int MODE = 0; constexpr bool sample = false;
    unsigned char* ws = A.ws;
    LAS float* TAB = (LAS float*)(F.lds + F.wave * 15360);
    LAS float* XC = TAB + 512;
    LAS float* AA = XC + 16 * 68;
    LAS float* BB = AA + 16 * 68;
    const int lane = F.lane, fr = lane & 15, fq = lane >> 4, ch0 = 64 * h;
    const bf16* RX = (const bf16*)(ws + WS_RX); bf16* RY = (bf16*)(ws + WS_RY);
    {
        const int chg = l * DM + ch0 + lane;
#pragma unroll
        for (int j = 0; j < 4; ++j) TAB[j * 64 + lane] = A.in[15][(size_t)(l * 4 + j) * DM + ch0 + lane];
        TAB[4 * 64 + lane] = A.in[16][chg]; TAB[5 * 64 + lane] = A.in[18][chg]; TAB[6 * 64 + lane] = A.in[20][chg];
        const float lam = A.in[21][chg]; TAB[7 * 64 + lane] = -8.f * 1.44269504f * log1pf(expf(-lam));
    }
    bf16x8 Wf[2][4][2];
    { const bf16* WG = (const bf16*)(ws + WS_SMALL + SM_WG);
#pragma unroll
      for (int g = 0; g < 2; ++g)
#pragma unroll
        for (int n = 0; n < 4; ++n)
#pragma unroll
            for (int k = 0; k < 2; ++k) Wf[g][n][k] = *(const bf16x8*)(WG + ((h * 2 + g) * 64 + 16 * n + fr) * 64 + 32 * k + 8 * fq); }
    LDS_WAIT(); asm volatile("" ::: "memory");
    const int rbase = s * TP + c * TC;
    bf16* XQ = (bf16*)(ws + WS_XN);
    float hst = 0.f, aprod = 1.f;
    if (MODE == 1 && !sample) {
        const float* AG = (const float*)(ws + WS_AGGRG) + ((size_t)(s * NCH) * DM + ch0 + lane) * 2;
        for (int cc = 0; cc < c; ++cc) { const float a = AG[(size_t)cc * DM * 2], b = AG[(size_t)cc * DM * 2 + 1]; hst = a * hst + b; }
    }
    v4u nx[2][4]; unsigned short nry[16];
#define RG_LOAD_RX(tl) do { const int row_ = rbase + 16 * (tl) + fr, t_ = c * TC + 16 * (tl) + fr; \
        _Pragma("unroll") for (int k = 0; k < 2; ++k) _Pragma("unroll") for (int d = 0; d < 4; ++d) nx[k][d] = *(const v4u*)(RX + (size_t)(t_ - d >= 0 ? row_ - d : row_) * DM + ch0 + 32 * k + 8 * fq); } while (0)
#define RG_LOAD_RY(tl) do { _Pragma("unroll") for (int tt = 0; tt < 16; ++tt) nry[tt] = RY[(size_t)(rbase + 16 * (tl) + tt) * DM + ch0 + lane]; } while (0)
    RG_LOAD_RX(0); RG_LOAD_RY(0);
#pragma unroll 1
    for (int tile = 0; tile < 8; ++tile) {
        const int row = rbase + 16 * tile + fr;
        const int t = c * TC + 16 * tile + fr;
        const int sq = sample ? s * 16 + tile * 2 + (fr >> 3) : s;
        bf16x8 X[2];
#pragma unroll
        for (int k = 0; k < 2; ++k) {
            const int cl = 32 * k + 8 * fq; float xc[8];
            { const f32x4 b0 = *(const LAS f32x4*)(TAB + 4 * 64 + cl), b1 = *(const LAS f32x4*)(TAB + 4 * 64 + cl + 4); xc[0] = b0.x; xc[1] = b0.y; xc[2] = b0.z; xc[3] = b0.w; xc[4] = b1.x; xc[5] = b1.y; xc[6] = b1.z; xc[7] = b1.w; }
#pragma unroll
            for (int d = 0; d < 4; ++d) {
                float v[8];
                { v4u w_ = nx[k][d]; if (t - d < 0) w_ = (v4u){0u, 0u, 0u, 0u}; cvt8(w_, v); }
                const f32x4 w0 = *(const LAS f32x4*)(TAB + (3 - d) * 64 + cl), w1 = *(const LAS f32x4*)(TAB + (3 - d) * 64 + cl + 4);
                xc[0] += w0.x * v[0]; xc[1] += w0.y * v[1]; xc[2] += w0.z * v[2]; xc[3] += w0.w * v[3]; xc[4] += w1.x * v[4]; xc[5] += w1.y * v[5]; xc[6] += w1.z * v[6]; xc[7] += w1.w * v[7];
            }
            *(LAS f32x4*)(XC + fr * 68 + cl) = (f32x4){xc[0], xc[1], xc[2], xc[3]}; *(LAS f32x4*)(XC + fr * 68 + cl + 4) = (f32x4){xc[4], xc[5], xc[6], xc[7]};
            v4u pk; pk.x = pk2(xc[0], xc[1]); pk.y = pk2(xc[2], xc[3]); pk.z = pk2(xc[4], xc[5]); pk.w = pk2(xc[6], xc[7]);
            X[k] = __builtin_bit_cast(bf16x8, pk);
        }
        if (tile < 7) RG_LOAD_RX(tile + 1);
        f32x4 acc[2][4];
#pragma unroll
        for (int g = 0; g < 2; ++g)
#pragma unroll
            for (int n = 0; n < 4; ++n) { acc[g][n] = (f32x4){0.f, 0.f, 0.f, 0.f};
#pragma unroll
                for (int k = 0; k < 2; ++k) acc[g][n] = __builtin_amdgcn_mfma_f32_16x16x32_bf16(Wf[g][n][k], X[k], acc[g][n], 0, 0, 0); }
        LDS_WAIT(); asm volatile("" ::: "memory");
#pragma unroll
        for (int n = 0; n < 4; ++n) { const int cl = 16 * n + 4 * fq;
            const f32x4 xv = *(const LAS f32x4*)(XC + fr * 68 + cl), ba = *(const LAS f32x4*)(TAB + 5 * 64 + cl), bx = *(const LAS f32x4*)(TAB + 6 * 64 + cl), c8 = *(const LAS f32x4*)(TAB + 7 * 64 + cl);
            f32x4 av, bv;
#pragma unroll
            for (int j = 0; j < 4; ++j) { const float r = fsig(acc[0][n][j] + ba[j]), ig = fsig(acc[1][n][j] + bx[j]); const float a = __builtin_amdgcn_exp2f(r * c8[j]);
                av[j] = a; bv[j] = __builtin_amdgcn_sqrtf(fmaxf(1.f - a * a, 0.f)) * ig * xv[j]; }
            *(LAS f32x4*)(AA + fr * 68 + cl) = av; *(LAS f32x4*)(BB + fr * 68 + cl) = bv; }
        LDS_WAIT(); asm volatile("" ::: "memory");
#pragma unroll
        for (int tt = 0; tt < 16; ++tt) {
            const float a = AA[tt * 68 + lane], b = BB[tt * 68 + lane];
            hst = a * hst + b; aprod *= a;
            const float g = fgelu(bf2f(nry[tt]));
            const size_t o = (size_t)(rbase + 16 * tile + tt) * DM + ch0 + lane; const unsigned pq = pk2(hst * g, aprod * g); RY[o] = (bf16)(pq & 0xffffu); XQ[o] = (bf16)(pq >> 16);
        }
        if (tile < 7) RG_LOAD_RY(tile + 1);
        LDS_WAIT(); asm volatile("" ::: "memory");
    }
    unsigned long long* AGT = (unsigned long long*)(ws + WS_AGT) + ((size_t)(l * 128 + s * 16 + h) * 16) * 64 + lane;
    __hip_atomic_store(AGT + (size_t)c * 64, ((unsigned long long)__float_as_uint(hst) << 32) | __float_as_uint(fmaxf(aprod, 1e-30f)), __ATOMIC_RELAXED, __HIP_MEMORY_SCOPE_AGENT);
}
__device__ __forceinline__ void rg_unit_sp2(const Frame& F, const Args& A, int l, int s, int c, int h) {
    unsigned char* ws = A.ws;
    const int lane = F.lane, ch0 = 64 * h;
    const bf16* RX = (const bf16*)(ws + WS_RX); bf16* RY = (bf16*)(ws + WS_RY); bf16* XQ = (bf16*)(ws + WS_XN);
    const int rbase = s * TP + c * TC;
    unsigned long long* AGT = (unsigned long long*)(ws + WS_AGT) + ((size_t)(l * 128 + s * 16 + h) * 16) * 64 + lane;
    float hst, aprod; { const unsigned long long v = __hip_atomic_load(AGT + (size_t)c * 64, __ATOMIC_RELAXED, __HIP_MEMORY_SCOPE_AGENT); aprod = __uint_as_float((unsigned)v); hst = __uint_as_float((unsigned)(v >> 32)); }
    float hin = 0.f;
    {   unsigned long long av[NCH - 1];
#pragma unroll
        for (int cc = 0; cc < NCH - 1; ++cc) av[cc] = (cc < c) ? __hip_atomic_load(AGT + (size_t)cc * 64, __ATOMIC_RELAXED, __HIP_MEMORY_SCOPE_AGENT) : 0ull;
#pragma unroll
        for (int cc = 0; cc < NCH - 1; ++cc) if (cc < c) {
            unsigned long long v = av[cc]; unsigned sp_ = 0;
            while (!(__uint_as_float((unsigned)v) > 0.f) && sp_ < (1u << 22)) { __builtin_amdgcn_s_sleep(2); v = __hip_atomic_load(AGT + (size_t)cc * 64, __ATOMIC_RELAXED, __HIP_MEMORY_SCOPE_AGENT); ++sp_; }
            hin = __uint_as_float((unsigned)v) * hin + __uint_as_float((unsigned)(v >> 32));
        } }
    if (c > 0) {
        asm volatile("s_waitcnt vmcnt(0)" ::: "memory");
#pragma unroll 1
        for (int tile = 0; tile < 8; ++tile) {
            unsigned short pv[16], qv[16];
#pragma unroll
            for (int tt = 0; tt < 16; ++tt) { const size_t o = (size_t)(rbase + 16 * tile + tt) * DM + ch0 + lane; pv[tt] = RY[o]; qv[tt] = XQ[o]; }
#pragma unroll
            for (int tt = 0; tt < 16; ++tt) RY[(size_t)(rbase + 16 * tile + tt) * DM + ch0 + lane] = (bf16)f2bf(bf2f(pv[tt]) + bf2f(qv[tt]) * hin);
        }
    }
    if (c == NCH - 1) {
        A.out[O_PRGH + (size_t)(s * 2 + l) * DM + ch0 + lane] = hst + aprod * hin;
#pragma unroll
        for (int k = 0; k < 3; ++k) A.out[O_PRGC + (size_t)((s * 2 + l) * 3 + k) * DM + ch0 + lane] = bf2f(RX[(size_t)(s * TP + TP - 3 + k) * DM + ch0 + lane]);
    }
}

template <int MODE> __device__ __forceinline__ void s5_unit(const Frame& F, const Args& A, int l, bool sample, int s, int c, int g) {
    unsigned char* ws = A.ws;
    LAS float* BU = (LAS float*)(F.lds + F.wave * 15360);
    LAS bf16* XS = (LAS bf16*)(F.lds + F.wave * 15360 + 16 * 132 * 4);
    const int lane = F.lane, fr = lane & 15, fq = lane >> 4;
    bf16* SX = (bf16*)(ws + WS_SX);
    bf16x8 Bf[8], Cf[4];
    { const bf16* BBm = (const bf16*)(ws + WS_SMALL + SM_BBAR) + (size_t)g * 128 * 16;
#pragma unroll
      for (int n = 0; n < 8; ++n) { v4u z = {0u, 0u, 0u, 0u}; if (fq < 2) z = *(const v4u*)(BBm + (16 * n + fr) * 16 + 8 * fq); Bf[n] = __builtin_bit_cast(bf16x8, z); }
      const bf16* CM = (const bf16*)(ws + WS_SMALL + SM_CMAT) + (size_t)g * 16 * 128;
#pragma unroll
      for (int kk = 0; kk < 4; ++kk) Cf[kk] = *(const bf16x8*)(CM + fr * 128 + 32 * kk + 8 * fq); }
    const float ar = ((const float*)(ws + WS_SMALL + SM_ABAR))[(g * 64 + lane) * 2], ai = ((const float*)(ws + WS_SMALL + SM_ABAR))[(g * 64 + lane) * 2 + 1];
    const f32x4 dv = *(const f32x4*)(A.in[28] + l * 512 + 16 * g + 4 * fq);
    const int rbase = sample ? MP + s * 32 : s * TP + c * TC;
    float xr = 0.f, xi = 0.f;
    if (MODE == 1 && !sample) {
        const float tr = ((const float*)(ws + WS_SMALL + SM_ABARTC))[(g * 64 + lane) * 2], ti = ((const float*)(ws + WS_SMALL + SM_ABARTC))[(g * 64 + lane) * 2 + 1];
        const float* AG = (const float*)(ws + WS_AGGS5) + ((size_t)(s * NCH) * 2048 + g * 64 + lane) * 2;
        f32x2 ag[NCH - 1];
#pragma unroll
        for (int cc = 0; cc < NCH - 1; ++cc) ag[cc] = (cc < c) ? *(const f32x2*)(AG + (size_t)cc * 4096) : (f32x2){0.f, 0.f};
#pragma unroll
        for (int cc = 0; cc < NCH - 1; ++cc) if (cc < c) { const float nr = tr * xr - ti * xi + ag[cc].x, ni = tr * xi + ti * xr + ag[cc].y; xr = nr; xi = ni; }
    }
    const int ntile = sample ? 2 : 8;
#define S5_BU(uz_) do { const bf16x8 U_ = __builtin_bit_cast(bf16x8, uz_); _Pragma("unroll") for (int n = 0; n < 8; ++n) { \
        f32x4 a_ = __builtin_amdgcn_mfma_f32_16x16x32_bf16(Bf[n], U_, (f32x4){0.f, 0.f, 0.f, 0.f}, 0, 0, 0); *(LAS f32x4*)(BU + fr * 132 + 16 * n + 4 * fq) = a_; } } while (0)
    v4u un = {0u, 0u, 0u, 0u}; u32x2 sxc = {0u, 0u};
    { v4u u0 = {0u, 0u, 0u, 0u}; if (fq < 2) u0 = *(const v4u*)(SX + (size_t)(rbase + fr) * 512 + 16 * g + 8 * fq);
      if (fq < 2) un = *(const v4u*)(SX + (size_t)(rbase + 16 + fr) * 512 + 16 * g + 8 * fq);
      if (MODE == 1) sxc = *(const u32x2*)(SX + (size_t)(rbase + fr) * 512 + 16 * g + 4 * fq);
      S5_BU(u0); }
#pragma unroll 1
    for (int tile = 0; tile < ntile; ++tile) {
        const int row = rbase + 16 * tile + fr;
        LDS_WAIT(); asm volatile("" ::: "memory");
        float br[16], bi[16];
#pragma unroll
        for (int tt = 0; tt < 16; ++tt) { br[tt] = BU[tt * 132 + lane]; bi[tt] = BU[tt * 132 + 64 + lane]; }
        u32x2 sxn = {0u, 0u};
        if (tile + 1 < ntile) {
            S5_BU(un);
            if (tile + 2 < ntile && fq < 2) un = *(const v4u*)(SX + (size_t)(row + 32) * 512 + 16 * g + 8 * fq);
            if (MODE == 1) sxn = *(const u32x2*)(SX + (size_t)(row + 16) * 512 + 16 * g + 4 * fq);
        }
#pragma unroll
        for (int tt = 0; tt < 16; ++tt) {
            if (sample && (tt & 7) == 0) { const size_t si = ((size_t)((s * 4 + tile * 2 + (tt >> 3)) * 2 + l) * 32 + g) * 64 + lane; xr = A.in[4][si]; xi = A.in[5][si]; }
            const float nr = ar * xr - ai * xi + br[tt], ni = ar * xi + ai * xr + bi[tt]; xr = nr; xi = ni;
            if (MODE == 1) { const unsigned xx = pk2(xr, xi); XS[tt * 136 + lane] = (bf16)(xx & 0xffffu); XS[tt * 136 + 64 + lane] = (bf16)(xx >> 16); }
            if (MODE == 1 && sample && (tt & 7) == 7) { const size_t si = ((size_t)((s * 4 + tile * 2 + (tt >> 3)) * 2 + l) * 32 + g) * 64 + lane; A.out[O_SS5R + si] = xr; A.out[O_SS5I + si] = xi; }
        }
        if (MODE == 1) {
            LDS_WAIT(); asm volatile("" ::: "memory");
            f32x4 y = {0.f, 0.f, 0.f, 0.f};
#pragma unroll
            for (int kk = 0; kk < 4; ++kk) { const bf16x8 xb = *(const LAS bf16x8*)(XS + fr * 136 + 32 * kk + 8 * fq); y = __builtin_amdgcn_mfma_f32_16x16x32_bf16(Cf[kk], xb, y, 0, 0, 0); }
            bf16* p = SX + (size_t)row * 512 + 16 * g + 4 * fq; const u32x2 sx = sxc;
            u32x2 o; o.x = pk2(fgelu(y.x + dv.x * bflo(sx.x)), fgelu(y.y + dv.y * bfhi(sx.x))); o.y = pk2(fgelu(y.z + dv.z * bflo(sx.y)), fgelu(y.w + dv.w * bfhi(sx.y)));
            *(u32x2*)p = o;
        }
        sxc = sxn;
    }
    LDS_WAIT(); asm volatile("" ::: "memory");
#undef S5_BU
    if (MODE == 0) { float* AG = (float*)(ws + WS_AGGS5) + ((size_t)(s * NCH + c) * 2048 + g * 64 + lane) * 2; AG[0] = xr; AG[1] = xi; }
    if (MODE == 1 && !sample && c == NCH - 1) { const size_t si = ((size_t)(s * 2 + l) * 32 + g) * 64 + lane; A.out[O_PS5R + si] = xr; A.out[O_PS5I + si] = xi; }
}

template <int MODE> __device__ __forceinline__ void mixer_phase(const Frame& F0, const Args& A, int l, int qi, int b0) {
    const Frame F = refresh(F0);
    int bx_ = blockIdx.x; asm volatile("" : "+s"(bx_)); if (bx_ < b0) return;
    gu32* q = F.ctl + CW_Q + 64 * qi;
    constexpr int N_A = MODE == 0 ? 2048 : NSP * NCH * 32, N_B = MODE == 0 ? 32 * 16 : 32 * 32, N_C = MODE == 0 ? NSP * (NCH - 1) * 32 : 0;
    constexpr int NTOT = N_A + N_B + N_C;
    (void)q;
    const int nb_ = F.G - b0, bl_ = bx_ - b0, vb_ = (nb_ % 8 == 0) ? (bl_ % 8) * (nb_ / 8) + bl_ / 8 : bl_, gw = F.wave * nb_ + vb_, NGW = nb_ * NWAVES;
    for (int u0 = gw; u0 < NTOT; u0 += NGW) {
        int u = u0;
        if (MODE == 0) {
            if (u < N_A) { const int c = u >> 7, sh = u & 127; rg_unit_sp(F, A, l, sh >> 4, c, sh & 15); continue; } u -= N_A;
            if (u < N_B) { rg_unit<1>(F, A, l, true, u >> 4, 0, u & 15); continue; } u -= N_B;
            { const int g = u & 31, r = u >> 5, c = r % (NCH - 1), s2 = r / (NCH - 1); s5_unit<0>(F, A, l, false, s2, c, g); }
        } else {
            if (u < N_A) { const int g = u & 31, r = u >> 5, c = r % NCH, s2 = r / NCH; s5_unit<1>(F, A, l, false, s2, c, g); continue; } u -= N_A;
            s5_unit<1>(F, A, l, true, u >> 5, 0, u & 31);
        }
    }
    if (MODE == 0 && gw < N_A) { const int c = gw >> 7, sh = gw & 127; rg_unit_sp2(F, A, l, sh >> 4, c, sh & 15); }
}

__device__ __forceinline__ void ffn_fixup_local(const Frame& F0, const Args& A, int l, int pm) {
    const Frame F = refresh(F0);
    if (pm < 64 && (pm & 7) != 0) {
        const float* HALO = (const float*)(A.ws + WS_HALO); bf16* HF = (bf16*)(A.ws + WS_HFF);
        const float* cw = A.in[34] + (size_t)l * 3 * FF2; const float* cb = A.in[35] + (size_t)l * FF2;
        for (int c = F.tid; c < FF; c += NWAVES * 64) {
            float uc0[2], uc1[2];
#pragma unroll
            for (int bj = 0; bj < 2; ++bj) {
                const float a254 = HALO[((size_t)((pm - 1) * 4 + 0) * 2 + bj) * FF + c], a255 = HALO[((size_t)((pm - 1) * 4 + 1) * 2 + bj) * FF + c];
                const float r0 = HALO[((size_t)(pm * 4 + 2) * 2 + bj) * FF + c], r1 = HALO[((size_t)(pm * 4 + 3) * 2 + bj) * FF + c];
                const float w0 = cw[bj * FF + c], w1 = cw[FF2 + bj * FF + c], w2 = cw[2 * FF2 + bj * FF + c], b = cb[bj * FF + c];
                uc0[bj] = b + w0 * a254 + w1 * a255 + w2 * r0; uc1[bj] = b + w0 * a255 + w1 * r0 + w2 * r1;
            }
            HF[(size_t)(pm * 256) * FF + c] = (bf16)f2bf(fgelu(uc0[0]) * uc0[1]); HF[(size_t)(pm * 256 + 1) * FF + c] = (bf16)f2bf(fgelu(uc1[0]) * uc1[1]);
        }
    }
    asm volatile("s_waitcnt vmcnt(0)" ::: "memory"); __syncthreads();
}

__global__ void __launch_bounds__(NWAVES * 64, 2) hawk_fwd(Args args) {
    extern __shared__ __attribute__((aligned(16))) unsigned char lds[];
    Frame F;
    F.lds = (LAS unsigned char*)lds;
    F.MISC = (volatile LAS unsigned*)(F.lds + MISC_OFF);
    F.tid = threadIdx.x; F.lane = F.tid & 63; F.wave = __builtin_amdgcn_readfirstlane(F.tid >> 6);
    F.G = gridDim.x; { const int bx = blockIdx.x; F.vcu = (F.G % 8 == 0) ? (bx % 8) * (F.G / 8) + bx / 8 : bx; }
    unsigned char* ws = args.ws;
    F.ctl = (gu32*)(ws + WS_CTL);
    for (int u = F.tid; u < (LDS_BYTES - LDSCTL_OFF) / 4; u += NWAVES * 64) ((LAS unsigned*)(F.lds + LDSCTL_OFF))[u] = 0u;
    __syncthreads();
    XcdBarrier bar = xcd_barrier_post((unsigned*)(F.ctl + CW_BAR), F.MISC + 8);
#define GRID_BAR() xcd_barrier(bar)

#pragma unroll 1
    for (int st = 0; st < NST_MAX; ++st) {
        unsigned char* ws = args.ws; float* outp = args.out; asm volatile("" : "+s"(ws), "+s"(outp));
        bf16* XRB = (bf16*)(ws + WS_XRB); float* MOD = (float*)(ws + WS_MOD); bf16* XN = (bf16*)(ws + WS_XN); int bid = (int)blockIdx.x; asm volatile("" : "+s"(bid));
        const int l = st < 2 ? 0 : (st - 2) / 10, sub = st < 2 ? st - 2 : (st == 22 ? 99 : (st - 2) % 10);
        const int ll = st == 22 ? 1 : l;
        const float* xin_p = ll == 0 ? args.in[0] : nullptr; const float* xin_s = ll == 0 ? args.in[1] - (size_t)MP * DM : nullptr;
        const float* modl = MOD + ll * 6144;
        bool is_gemm = false; pg8::Gemm g{nullptr, nullptr, 0, 0, 0, 0, 0}; pg8::EpiAny E{0, false, ws, nullptr, nullptr, nullptr, nullptr, 0, ll, (PG8_LAS float*)(F.lds + XCH_OFF)};
        switch (sub) {
            case -1: is_gemm = true; g = pg8::Gemm{(const pg8::bf16_t*)(ws + WS_SILUC), (const pg8::bf16_t*)(ws + WS_WADA), 256, MODW, DM, DM, DM}; E.mode = pg8::EM_ADA; E.perm = false; E.p0 = args.in[10]; E.out = MOD; break;
            case 1: is_gemm = true; g = pg8::Gemm{(const pg8::bf16_t*)XN, (const pg8::bf16_t*)(ws + WS_WIN), MROWS, INW, DM, DM, DM}; E.mode = pg8::EM_IN; E.perm = true; E.p0 = args.in[14] + l * INW; break;
            case 3: case 4: is_gemm = true; g = pg8::Gemm{(const pg8::bf16_t*)(ws + WS_RY), (const pg8::bf16_t*)(ws + WS_WRG), MROWS, DM, DM, DM, DM}; E.mode = pg8::EM_RGP; E.perm = true; break;
            case 5: is_gemm = true; g = pg8::Gemm{(const pg8::bf16_t*)(ws + WS_SX), (const pg8::bf16_t*)(ws + WS_WGLU), MROWS, 2048, 512, 512, 512}; E.mode = pg8::EM_GLU; E.perm = true; break;
            case 6: is_gemm = true; g = pg8::Gemm{(const pg8::bf16_t*)(ws + WS_GA), (const pg8::bf16_t*)(ws + WS_WOUT), MROWS, DM, DM, DM, DM}; E.mode = pg8::EM_RES; E.perm = true; E.p0 = xin_p; E.p2 = modl + 2048; E.row_off = 0; break;
            case 8: is_gemm = true; g = pg8::Gemm{(const pg8::bf16_t*)XN, (const pg8::bf16_t*)(ws + WS_WUP), MROWS, FF2, DM, DM, DM}; E.mode = pg8::EM_UPF; E.perm = true; E.p0 = args.in[34] + (size_t)l * 3 * FF2; E.p1 = args.in[35] + (size_t)l * FF2; E.p2 = args.in[6]; E.out = outp; break;
            case 9: is_gemm = true; g = pg8::Gemm{(const pg8::bf16_t*)(ws + WS_HFF), (const pg8::bf16_t*)(ws + WS_WDOWN), MROWS, DM, FF, FF, FF}; E.mode = pg8::EM_RES; E.perm = true; E.p0 = nullptr; E.p2 = modl + 5120; E.row_off = 1; break;
            default: break;
        }
#ifndef DUP
#define DUP 0
#endif
        const int nrep = (DUP == 1 && sub == 2) || (DUP == 2 && (st == 0 || (sub == 0 && l == 1))) || (DUP == 3 && sub == 8) || (DUP == 4 && (sub == 0 || sub == 7)) || (DUP == 5 && sub == 1) || (DUP == 6 && sub == 6 && l == 0) || (DUP == 7 && ((sub == 0 && l == 0 && st >= 2) || sub == 9)) ? 2 : 1;
#pragma unroll 1
        for (int rep = 0; rep < nrep; ++rep) {
        if (rep == 1) GRID_BAR();
        if (st < 2 || (sub == 0 && l == 1)) p0_weights(F, args, l, st == 0 ? 0 : 1, st == 1 ? 48 : 0, st == 1 ? F.G - 48 : F.G);
        if (sub == 0 || sub == 7) norm_rows(F, sub == 0 ? xin_p : nullptr, sub == 0 ? xin_s : nullptr, XRB, (sub == 0 ? args.in[11] : args.in[12]) + l * DM, modl + (sub == 0 ? 0 : 3072), modl + (sub == 0 ? 1024 : 4096), XN,
                                            sub == 7 ? 4 : (l == 1 ? 12 : 0), sub == 7 ? modl + 2048 : MOD + 5120, (const float*)(ws + (sub == 7 ? WS_PART_OUT : WS_PART_DOWN)));
        if (sub == 2) mixer_phase<0>(F, args, l, l * 2 + rep * 4, 0);
        if (sub == 3) mixer_phase<1>(F, args, l, l * 2 + 1, 16);
        if (is_gemm) { pg8::SplitOrder S; S.init(g.M, g.N, g.K, F.G, bid, (sub == 6 || sub == 9) ? 1 : (sub == 4 ? 2 : (sub == 3 ? 3 : 0)), 256);
            if (sub == 9) { pg8::Unit u0; ffn_fixup_local(F, args, l, S.next(0, u0) ? u0.pm : 64); } pg8::gemm_phase<pg8::EpiAny, pg8::SplitOrder, true, true>(F.lds, g, S, E); }
        }
        if (sub == 99) final_norm(F, XRB, outp + O_Y, args.in[37], 12, MOD + 6144 + 5120, (const float*)(ws + WS_PART_DOWN)); else GRID_BAR();
    }
}

extern "C" void kernel_launch(void* const* d_in, const int* in_sizes, int n_in, void* d_out, int out_size, void* d_ws, size_t ws_size, hipStream_t stream) {
    static int grid = 0;
    if (grid == 0) {
        if (n_in != 38 || out_size != 23396352 || ws_size < WS_END) { fprintf(stderr, "kernel_launch: unexpected shapes (n_in %d out %d ws %zu)\n", n_in, out_size, ws_size); grid = -1; return; }
        int dev = 0, cus = 0, per_cu = 0;
        if (hipGetDevice(&dev) != hipSuccess || hipDeviceGetAttribute(&cus, hipDeviceAttributeMultiprocessorCount, dev) != hipSuccess) { grid = -1; return; }
        if (hipFuncSetAttribute((const void*)hawk_fwd, hipFuncAttributeMaxDynamicSharedMemorySize, LDS_BYTES) != hipSuccess) { fprintf(stderr, "kernel_launch: hipFuncSetAttribute failed\n"); grid = -1; return; }
        if (hipOccupancyMaxActiveBlocksPerMultiprocessor(&per_cu, (const void*)hawk_fwd, NWAVES * 64, LDS_BYTES) != hipSuccess || per_cu < 1) { fprintf(stderr, "kernel_launch: occupancy query says %d\n", per_cu); per_cu = 1; }
        (void)hipGetLastError();
        grid = cus;
    }
    if (grid < 0) return;
    if (hipMemsetAsync((char*)d_ws + WS_CTL, 0, CTL_ZERO_BYTES, stream) != hipSuccess) { fprintf(stderr, "kernel_launch: memset failed\n"); return; }
    if (hipMemsetAsync((char*)d_ws + WS_AGT, 0, 2 * MiB, stream) != hipSuccess) { fprintf(stderr, "kernel_launch: memset 2 failed\n"); return; }
    Args a{};
    for (int i = 0; i < 38; ++i) a.in[i] = (const float*)d_in[i];
    a.out = (float*)d_out; a.ws = (unsigned char*)d_ws;
    hipLaunchKernelGGL(hawk_fwd, dim3(grid), dim3(NWAVES * 64), LDS_BYTES, stream, a);
}
```

```cpp
#include <hip/hip_runtime.h>
#include <cstdio>
#include <cstdint>
namespace pg8 {
#define PG8_LAS __attribute__((address_space(3)))
typedef unsigned short bf16_t;
typedef short bf16x8 __attribute__((ext_vector_type(8)));
typedef float f32x4 __attribute__((ext_vector_type(4)));
typedef unsigned u32x4 __attribute__((ext_vector_type(4)));
constexpr int BM = 256, BK = 64, HALF = 128, HTB = HALF * BK * 2  , STAGE_BYTES = 8 * HTB, NXCD = 8, WGM = 8;

__host__ __device__ __forceinline__ int lds_byte(int r, int c) { const int st = (r >> 4) * 2 + (c >> 5), rr = r & 15, cc = c & 31, ob = rr * 64 + cc * 2; return st * 1024 + (ob ^ (((ob >> 9) & 1) << 5)); }
__host__ __device__ __forceinline__ void stage_rc(int b, int& R, int& C) { const int st = b / 1024, sb = b % 1024, swz = sb ^ (((sb >> 9) & 1) << 5); R = (st >> 1) * 16 + swz / 64; C = (st & 1) * 32 + (swz % 64) / 2; }
__host__ __device__ __forceinline__ int perm32(int rho) { const int n = rho >> 4, i = rho & 15; return 8 * (i >> 2) + 4 * n + (i & 3); }

struct Unit { int pm, pn, koff, nt, mini, ksl; };
struct Gemm { const bf16_t* A; const bf16_t* Bt; int M, N, K, lda, ldb; };

struct StaticOrder {
    int nM, nN, nwg, G, c, ntK;
    __host__ __device__ void init(int M, int N, int G_, int c_, int K_ = 128) { nM = M / BM; nN = N / BM; nwg = nM * nN; G = G_; c = c_; ntK = K_ / BK; }
    __host__ __device__ bool next(int i, Unit& u) const {
        const long L = (long)i * G + c; if (L >= nwg) return false;
        int wgid = (int)L; { const int q = nwg / NXCD, r = nwg % NXCD, xcd = wgid % NXCD, off = wgid / NXCD; wgid = (xcd < r ? xcd * (q + 1) : r * (q + 1) + (xcd - r) * q) + off; }
        const int nig = WGM * nN, gid = wgid / nig, fm = gid * WGM, gsz = (nM - fm) < WGM ? (nM - fm) : WGM;
        u.pm = fm + ((wgid % nig) % gsz); u.pn = (wgid % nig) / gsz; u.koff = 0; u.nt = ntK; u.mini = 0; u.ksl = 256; return true;
    }
    __device__ __forceinline__ void a_ready(const Unit&) const {}
    __device__ __forceinline__ void done(const Unit&) const {}
};
struct SplitOrder {
    StaticOrder so; int nslice, nmini, rounds, smode, ksl;
    __device__ void init(int M, int N, int K, int G_, int c_, int smode_, int ksl_) { smode = smode_; ksl = ksl_; so.init(smode_ == 0 ? M : 16384, N, G_, c_, K); nslice = K / ksl_; nmini = smode_ == 1 ? 4 * (N / BM) * nslice : 0; rounds = (so.nwg + G_ - 1) / G_; }
    __device__ bool next(int i, Unit& u) const {
        const long L = (long)i * so.G + so.c;
        if (smode == 3) { if (L >= 4 * so.nN) return false; u.pm = 64 + (int)L / so.nN; u.pn = (int)L % so.nN; u.koff = 0; u.nt = so.ntK; u.mini = 0; u.ksl = 256; return true; }
        if (L < so.nwg) return so.next(i, u);
        const int mm = (int)(L - so.nwg);
        if (mm >= nmini) return false;
        const int kc = mm % nslice, t16 = mm / nslice; u.pm = 64 + t16 / so.nN; u.pn = t16 % so.nN; u.koff = kc * ksl; u.nt = ksl / BK; u.mini = 1; u.ksl = ksl; return true;
    }
    __device__ __forceinline__ void a_ready(const Unit&) const {}
    __device__ __forceinline__ void done(const Unit&) const {}
};


__device__ __forceinline__ unsigned cvt_pk_bf16(float lo, float hi) { unsigned r; asm volatile("v_cvt_pk_bf16_f32 %0, %1, %2" : "=v"(r) : "v"(lo), "v"(hi)); return r; }
typedef float f32x2 __attribute__((ext_vector_type(2)));
__device__ __forceinline__ f32x2 gelu_pk(f32x2 v) {
    const f32x2 av = __builtin_elementwise_abs(v), d = av * 0.2316418882f + 1.0f;
    f32x2 t; t.x = __builtin_amdgcn_rcpf(d.x); t.y = __builtin_amdgcn_rcpf(d.y);
    f32x2 q = t * 0.5307027145f + (-0.7265760135f); q = q * t + 0.7107068705f; q = q * t + (-0.142248368f); q = q * t + 0.127414796f; q = q * t;
    const f32x2 s = (v * v) * (-0.72134752044f);
    f32x2 e; e.x = __builtin_amdgcn_exp2f(s.x); e.y = __builtin_amdgcn_exp2f(s.y);
    const f32x2 m = v * (q * e), r = v - m;
    f32x2 o; o.x = v.x < 0.f ? m.x : r.x; o.y = v.y < 0.f ? m.y : r.y; return o;
}

template <int ACT  > struct EpiBf16 {
    static constexpr bool PERM = true, AFTER_DRAIN = false; static_assert(ACT == 0 || ACT == 1, "EpiBf16: ACT is 0 (none) or 1 (gelu_pk)");
    bf16_t* O; int ldc; const float* bias; int split_cols; size_t split_stride; float scale0;
    __device__ __forceinline__ void operator()(const f32x4 (&acc)[2][2][4][2], const Unit& u, int wr, int wc, int fr, int fq) const {
        const int row0 = u.pm * BM + wr * 64 + fr; int colt = u.pn * BM; bf16_t* base = O;
        float sc = 1.f; if (split_cols) { const int t = colt / split_cols; base += (size_t)t * split_stride; colt -= t * split_cols; if (t == 0) sc = scale0; }
        const int col0 = colt + wc * 32 + 8 * fq, bcol0 = u.pn * BM + wc * 32 + 8 * fq;
        f32x4 bv[2][2];
#pragma unroll
        for (int bj = 0; bj < 2; ++bj)
#pragma unroll
            for (int n = 0; n < 2; ++n) bv[bj][n] = bias ? *(const f32x4*)(bias + bcol0 + bj * HALF + 4 * n) : (f32x4){0.f, 0.f, 0.f, 0.f};
#pragma unroll
        for (int ai = 0; ai < 2; ++ai)
#pragma unroll
            for (int m = 0; m < 4; ++m) { bf16_t* rowp = base + (size_t)(row0 + ai * HALF + m * 16) * ldc + col0;
#pragma unroll
                for (int bj = 0; bj < 2; ++bj) { f32x4 v0 = acc[ai][bj][m][0] + bv[bj][0], v1 = acc[ai][bj][m][1] + bv[bj][1];
                    if (ACT == 1) { f32x2 a = gelu_pk((f32x2){v0[0], v0[1]}), b = gelu_pk((f32x2){v0[2], v0[3]}), c = gelu_pk((f32x2){v1[0], v1[1]}), d = gelu_pk((f32x2){v1[2], v1[3]});
                        v0 = (f32x4){a.x, a.y, b.x, b.y}; v1 = (f32x4){c.x, c.y, d.x, d.y}; }
                    v0 = v0 * sc; v1 = v1 * sc; u32x4 w; w.x = cvt_pk_bf16(v0[0], v0[1]); w.y = cvt_pk_bf16(v0[2], v0[3]); w.z = cvt_pk_bf16(v1[0], v1[1]); w.w = cvt_pk_bf16(v1[2], v1[3]);
                    *(u32x4*)(rowp + bj * HALF) = w; } }
    }
};

template <class Epi, class Sched, bool ALIGN_EPI, bool SP2>
__device__ __forceinline__ void gemm_phase(PG8_LAS unsigned char* lds, const Gemm g, const Sched& S, const Epi& E) {
    int tid_ = threadIdx.x; asm volatile("" : "+v"(tid_));
    const int tid = tid_, wid = __builtin_amdgcn_readfirstlane(tid >> 6), lane = tid & 63, wr = wid >> 2, wc = wid & 3, fr = lane & 15, fq = lane >> 4;
    const int lda = g.lda, ldb = g.ldb;
    unsigned voffA[2], voffB[2];
#pragma unroll
    for (int i = 0; i < 2; ++i) { int R, C; stage_rc(tid * 16 + i * 8192, R, C); const int Rb = E.perm ? ((R & ~31) + perm32(R & 31)) : R;
        voffA[i] = (unsigned)(R * lda + C) * 2u; voffB[i] = (unsigned)(Rb * ldb + C) * 2u; }
    const size_t kstep = (size_t)(BK * 2);
    const size_t hstepA = (size_t)HALF * lda * 2, hstepB = (size_t)HALF * ldb * 2;
    const size_t tstepA = 2 * hstepA, tstepB = 2 * hstepB;
    const unsigned ldsw = (unsigned)wid * 1024u;
    const int aoff = lds_byte(wr * 64 + fr, fq * 8), boff = lds_byte(wc * 32 + fr, fq * 8);
#define PG8_SA(b, h) (((b) * 2 + (h)) * HTB)
#define PG8_SB(b, h) ((4 + (b) * 2 + (h)) * HTB)
#define PG8_STAGE(bufoff, gbase, voff) do { _Pragma("unroll") for (int _i = 0; _i < 2; ++_i) \
        __builtin_amdgcn_global_load_lds((const unsigned*)((const char*)(gbase) + (voff)[_i]), (PG8_LAS unsigned*)(lds + (bufoff) + ldsw + _i * 8192), 16, 0, 0); } while (0)
#define PG8_LDA(dst, b, h) do { _Pragma("unroll") for (int m = 0; m < 4; ++m) _Pragma("unroll") for (int k = 0; k < 2; ++k) dst[m][k] = *(const PG8_LAS bf16x8*)(lds + PG8_SA(b, h) + aoff + m * 2048 + k * 1024); } while (0)
#define PG8_LDB(dst, b, h) do { _Pragma("unroll") for (int n = 0; n < 2; ++n) _Pragma("unroll") for (int k = 0; k < 2; ++k) dst[n][k] = *(const PG8_LAS bf16x8*)(lds + PG8_SB(b, h) + boff + n * 2048 + k * 1024); } while (0)
#define PG8_MMA(ai, bj, At, Bt) do { __builtin_amdgcn_s_setprio(1); _Pragma("unroll") for (int m = 0; m < 4; ++m) _Pragma("unroll") for (int n = 0; n < 2; ++n) _Pragma("unroll") for (int k = 0; k < 2; ++k) \
        acc[ai][bj][m][n] = __builtin_amdgcn_mfma_f32_16x16x32_bf16(Bt[n][k], At[m][k], acc[ai][bj][m][n], 0, 0, 0); __builtin_amdgcn_s_setprio(0); } while (0)
#define PG8_WAIT_V(n) asm volatile("s_waitcnt vmcnt(" #n ")" ::: "memory")
#define PG8_WAIT_L(n) asm volatile("s_waitcnt lgkmcnt(" #n ")" ::: "memory")
#define PG8_BAR __builtin_amdgcn_s_barrier()
#define PG8_SCHED __builtin_amdgcn_sched_barrier(0)
    Unit cur, nxt; int ui = 0;
    if (!S.next(0, cur)) return;
    f32x4 acc[2][2][4][2];
#pragma unroll
    for (int a = 0; a < 2; ++a)
#pragma unroll
        for (int b = 0; b < 2; ++b)
#pragma unroll
            for (int m = 0; m < 4; ++m)
#pragma unroll
                for (int n = 0; n < 2; ++n) acc[a][b][m][n] = (f32x4){0.f, 0.f, 0.f, 0.f};
    bf16x8 At[4][2], B0[2][2], B1[2][2];
    const char* cA = (const char*)g.A + (size_t)cur.pm * tstepA + (size_t)cur.koff * 2; const char* cB = (const char*)g.Bt + (size_t)cur.pn * tstepB + (size_t)cur.koff * 2;
    S.a_ready(cur);
    if constexpr (SP2) {
        PG8_STAGE(PG8_SB(0, 0), cB, voffB); PG8_STAGE(PG8_SB(0, 1), cB + hstepB, voffB); PG8_STAGE(PG8_SA(0, 0), cA, voffA); PG8_STAGE(PG8_SA(0, 1), cA + hstepA, voffA);
        if (wr == 1) PG8_BAR;
        PG8_WAIT_V(2); PG8_BAR;
        PG8_STAGE(PG8_SB(1, 0), cB + kstep, voffB); PG8_STAGE(PG8_SA(1, 0), cA + kstep, voffA); PG8_STAGE(PG8_SB(1, 1), cB + hstepB + kstep, voffB);
        PG8_WAIT_V(6); PG8_BAR;
    } else {
        PG8_STAGE(PG8_SB(0, 0), cB, voffB); PG8_STAGE(PG8_SA(0, 0), cA, voffA); PG8_STAGE(PG8_SB(0, 1), cB + hstepB, voffB); PG8_STAGE(PG8_SA(0, 1), cA + hstepA, voffA);
        if (wr == 1) PG8_BAR;
        PG8_WAIT_V(4); PG8_BAR;
        PG8_STAGE(PG8_SB(1, 0), cB + kstep, voffB); PG8_STAGE(PG8_SA(1, 0), cA + kstep, voffA); PG8_STAGE(PG8_SB(1, 1), cB + hstepB + kstep, voffB);
        PG8_WAIT_V(6); PG8_BAR;
    }
    for (;;) {
        const bool has_next = S.next(ui + 1, nxt);
        const char* nA = has_next ? (const char*)g.A + (size_t)nxt.pm * tstepA + (size_t)nxt.koff * 2 : cA; const char* nB = has_next ? (const char*)g.Bt + (size_t)nxt.pn * tstepB + (size_t)nxt.koff * 2 : cB;
        const int nt = cur.nt;
        for (int t = 0; t < nt; t += 2) {
            const bool last = (t == nt - 2);
            const char* a1 = cA + (size_t)(t + 1) * kstep;
            const char* a2 = last ? nA : cA + (size_t)(t + 2) * kstep; const char* b2 = last ? nB : cB + (size_t)(t + 2) * kstep;
            const char* a3 = a2 + kstep; const char* b3 = b2 + kstep;
            if (last && has_next) S.a_ready(nxt);
            if constexpr (SP2) {
            PG8_LDB(B0, 0, 0); PG8_LDB(B1, 0, 1); PG8_SCHED; PG8_LDA(At, 0, 0); PG8_STAGE(PG8_SA(1, 1), a1 + hstepA, voffA);
            PG8_WAIT_V(8); PG8_WAIT_L(0); PG8_BAR; PG8_MMA(0, 0, At, B0); PG8_MMA(0, 1, At, B1); PG8_BAR; PG8_SCHED;
            PG8_LDA(At, 0, 1); PG8_STAGE(PG8_SB(0, 0), b2, voffB); PG8_STAGE(PG8_SB(0, 1), b2 + hstepB, voffB); PG8_STAGE(PG8_SA(0, 0), a2, voffA);
            PG8_WAIT_V(8); PG8_WAIT_L(0); PG8_BAR; PG8_MMA(1, 0, At, B0); PG8_MMA(1, 1, At, B1); PG8_BAR; PG8_SCHED;
            PG8_LDB(B0, 1, 0); PG8_LDB(B1, 1, 1); PG8_SCHED; PG8_LDA(At, 1, 0); PG8_STAGE(PG8_SA(0, 1), a2 + hstepA, voffA);
            PG8_WAIT_V(8); PG8_WAIT_L(0); PG8_BAR; PG8_MMA(0, 0, At, B0); PG8_MMA(0, 1, At, B1); PG8_BAR; PG8_SCHED;
            PG8_LDA(At, 1, 1); PG8_STAGE(PG8_SB(1, 0), b3, voffB); PG8_STAGE(PG8_SB(1, 1), b3 + hstepB, voffB); PG8_STAGE(PG8_SA(1, 0), a3, voffA);
            PG8_WAIT_V(8); PG8_WAIT_L(0); PG8_BAR; PG8_MMA(1, 0, At, B0); PG8_MMA(1, 1, At, B1); PG8_BAR; PG8_SCHED;
            } else {
            PG8_LDB(B0, 0, 0); PG8_SCHED; PG8_LDA(At, 0, 0); PG8_STAGE(PG8_SA(1, 1), a1 + hstepA, voffA);
            PG8_WAIT_L(8); PG8_BAR; PG8_WAIT_L(0); PG8_MMA(0, 0, At, B0); PG8_BAR; PG8_SCHED;
            PG8_LDB(B1, 0, 1); PG8_STAGE(PG8_SB(0, 0), b2, voffB);
            PG8_BAR; PG8_WAIT_L(0); PG8_MMA(0, 1, At, B1); PG8_BAR;
            PG8_LDA(At, 0, 1); PG8_STAGE(PG8_SA(0, 0), a2, voffA);
            PG8_BAR; PG8_WAIT_L(0); PG8_MMA(1, 0, At, B0); PG8_BAR; PG8_SCHED;
            PG8_STAGE(PG8_SB(0, 1), b2 + hstepB, voffB);
            PG8_WAIT_V(6); PG8_BAR; PG8_MMA(1, 1, At, B1); PG8_BAR;
            PG8_LDB(B0, 1, 0); PG8_SCHED; PG8_LDA(At, 1, 0); PG8_STAGE(PG8_SA(0, 1), a2 + hstepA, voffA);
            PG8_WAIT_L(8); PG8_BAR; PG8_WAIT_L(0); PG8_MMA(0, 0, At, B0); PG8_BAR; PG8_SCHED;
            PG8_LDB(B1, 1, 1); PG8_STAGE(PG8_SB(1, 0), b3, voffB);
            PG8_BAR; PG8_WAIT_L(0); PG8_MMA(0, 1, At, B1); PG8_BAR;
            PG8_LDA(At, 1, 1); PG8_STAGE(PG8_SA(1, 0), a3, voffA);
            PG8_BAR; PG8_WAIT_L(0); PG8_MMA(1, 0, At, B0); PG8_BAR; PG8_SCHED;
            PG8_STAGE(PG8_SB(1, 1), b3 + hstepB, voffB);
            PG8_WAIT_V(6); PG8_BAR; PG8_MMA(1, 1, At, B1); PG8_BAR;
            }
        }
        if constexpr (ALIGN_EPI) { if (wr == 0) PG8_BAR; }
        if constexpr (!Epi::AFTER_DRAIN) { E(acc, cur, wr, wc, fr, fq); S.done(cur); }
        if (!has_next) break;
#pragma unroll
        for (int a = 0; a < 2; ++a)
#pragma unroll
            for (int b = 0; b < 2; ++b)
#pragma unroll
                for (int m = 0; m < 4; ++m)
#pragma unroll
                    for (int n = 0; n < 2; ++n) acc[a][b][m][n] = (f32x4){0.f, 0.f, 0.f, 0.f};
        cur = nxt; cA = nA; cB = nB; ++ui;
        if constexpr (ALIGN_EPI) { if (wr == 1) PG8_BAR; }
    }
    PG8_WAIT_V(0);
    if constexpr (!ALIGN_EPI) { if (wr == 0) PG8_BAR; }
    PG8_BAR;
    if constexpr (Epi::AFTER_DRAIN) { E.fused(acc, cur, wr, wc, fr, fq, lds, wid, lane); S.done(cur); }
#undef PG8_SA
#undef PG8_SB
#undef PG8_STAGE
#undef PG8_LDA
#undef PG8_LDB
#undef PG8_MMA
#undef PG8_WAIT_V
#undef PG8_WAIT_L
#undef PG8_BAR
#undef PG8_SCHED
}
}
#define GAS __attribute__((address_space(1)))
#define LAS __attribute__((address_space(3)))
typedef unsigned short bf16;
typedef unsigned v4u __attribute__((ext_vector_type(4)));
typedef float f32x4 __attribute__((ext_vector_type(4)));
typedef short bf16x8 __attribute__((ext_vector_type(8)));
typedef GAS unsigned gu32;
typedef GAS unsigned long long gu64;
#define RLX_AGENT __ATOMIC_RELAXED, __HIP_MEMORY_SCOPE_AGENT
#define LDS_WAIT() asm volatile("s_waitcnt lgkmcnt(0)" ::: "memory")
#define VM_WAIT() asm volatile("s_waitcnt vmcnt(0)" ::: "memory")
__device__ __forceinline__ unsigned long long rt() { return __builtin_amdgcn_s_memrealtime(); }
__device__ __forceinline__ unsigned pk2(float lo, float hi) { unsigned r; asm("v_cvt_pk_bf16_f32 %0, %1, %2" : "=v"(r) : "v"(lo), "v"(hi)); return r; }
__device__ __forceinline__ unsigned f2bf(float f) { return pk2(f, 0.f) & 0xffffu; }
#define XB_TMO      128
#define XB_XCNT(j)  (256  + 64 * (j))
#define XB_XSUB(j)  (1280 + 64 * (j))
#define XB_XGEN(j)  (2304 + 64 * (j))
#define XB_TOP      3328
#define XB_TOPGEN   3392
#define XCD_BAR_WORDS 3456
#define XB_SPIN_CAP (1u << 18)

__device__ __forceinline__ unsigned xb_ld(unsigned* p)              { return __hip_atomic_load(p, __ATOMIC_RELAXED, __HIP_MEMORY_SCOPE_AGENT); }
__device__ __forceinline__ unsigned xb_add(unsigned* p, unsigned v) { return __hip_atomic_fetch_add(p, v, __ATOMIC_RELAXED, __HIP_MEMORY_SCOPE_AGENT); }
__device__ __forceinline__ unsigned xb_xcc_id() { return (unsigned)__builtin_amdgcn_s_getreg((3 << 11) | 20) & 0xFu; }
#define XB_SPIN(cond, bar) do { unsigned _sp = 0; while (cond) { __builtin_amdgcn_s_sleep(1); \
    if ((++_sp & 255u) == 0u) { if (xb_ld(&(bar)[XB_TMO])) break; if (_sp > XB_SPIN_CAP) { atomicAdd(&(bar)[XB_TMO], 1u); break; } } } } while (0)

struct XcdBarrier {
    unsigned* bar; unsigned x;
    volatile LAS unsigned* st;
};

__device__ __forceinline__ XcdBarrier xcd_barrier_post(unsigned* bar, volatile LAS unsigned* st) {
    XcdBarrier b; b.bar = bar; b.x = xb_xcc_id(); b.st = st;
    if (threadIdx.x == 0) (void)xb_add(&bar[XB_XCNT(b.x)], 1u);
    return b;
}
__device__ __forceinline__ void xcd_barrier_complete(unsigned* bar, unsigned x, unsigned& nloc, unsigned& nx) {
    const unsigned G = gridDim.x * gridDim.y * gridDim.z;
    unsigned sum, cnt, mine, sp = 0u;
    for (;;) {
        sum = 0u; cnt = 0u; mine = 0u;
#pragma unroll
        for (unsigned j = 0; j < 16; ++j) { const unsigned c = xb_ld(&bar[XB_XCNT(j)]); sum += c; cnt += (c > 0u) ? 1u : 0u; mine = (j == x) ? c : mine; }
        if (sum == G) break;
        __builtin_amdgcn_s_sleep(1);
        if ((++sp & 255u) == 0u) { if (xb_ld(&bar[XB_TMO])) break; if (sp > XB_SPIN_CAP) { atomicAdd(&bar[XB_TMO], 1u); break; } }
    }
    nloc = mine > 0u ? mine : 1u; nx = cnt > 0u ? cnt : 1u;
}

__device__ __forceinline__ void xcd_barrier(const XcdBarrier& b) {
    asm volatile("s_waitcnt vmcnt(0)" ::: "memory");
    __syncthreads();
    if (threadIdx.x == 0) {
        unsigned* bar = b.bar;
        __builtin_amdgcn_s_waitcnt(0);
        unsigned nloc = b.st[0], nx = b.st[1];
        if (nloc == 0u) { xcd_barrier_complete(bar, b.x, nloc, nx); b.st[0] = nloc; b.st[1] = nx; }
        const unsigned old = xb_add(&bar[XB_XSUB(b.x)], 1u);
        const unsigned gen = old / nloc;
        if (old + 1u == (gen + 1u) * nloc) {
            __builtin_amdgcn_fence(__ATOMIC_RELEASE, "agent");
            asm volatile("s_waitcnt vmcnt(0)" ::: "memory");
            const unsigned og = xb_add(&bar[XB_TOP], 1u);
            const unsigned tg = og / nx;
            if (og + 1u == (tg + 1u) * nx) xb_add(&bar[XB_TOPGEN], 1u);
            else XB_SPIN(xb_ld(&bar[XB_TOPGEN]) == tg, bar);
            __builtin_amdgcn_fence(__ATOMIC_ACQUIRE, "agent");
            xb_add(&bar[XB_XGEN(b.x)], 1u);
            asm volatile("s_waitcnt vmcnt(0)" ::: "memory");
        } else {
            XB_SPIN(xb_ld(&bar[XB_XGEN(b.x)]) == gen, bar);
            __builtin_amdgcn_fence(__ATOMIC_ACQUIRE, "agent");
            asm volatile("s_waitcnt vmcnt(0)" ::: "memory");
        }
    }
    __syncthreads();
}

constexpr int NWAVES = 8;
#ifndef NST_MAX
#define NST_MAX 23
#endif
constexpr int DM = 1024, MROWS = 17408, MP = 16384, TP = 2048, NSP = 8, NSS = 128, TS = 8;
constexpr int INW = 4608, FF = 3072, FF2 = 6144, NCI = 136, MODW = 12288;
constexpr float EPSN = 1e-6f;
constexpr int TC = 128, NCH = TP / TC;

constexpr size_t MiB = 1u << 20;
constexpr size_t WS_CTL = 0, CTL_ZERO_BYTES = 1 * MiB;
constexpr size_t WS_MOD = 1 * MiB;
constexpr size_t WS_WIN = 8 * MiB, WS_WRG = 17 * MiB, WS_WGLU = 19 * MiB, WS_WOUT = 21 * MiB, WS_WUP = 23 * MiB, WS_WDOWN = 35 * MiB;
constexpr size_t WS_SMALL = 41 * MiB;
constexpr size_t SM_WG = 0, SM_BBAR = 256 * 1024, SM_CMAT = 384 * 1024, SM_ABAR = 512 * 1024, SM_ABARTC = 528 * 1024;
constexpr size_t WS_XN = 42 * MiB;
constexpr size_t WS_XRB = 76 * MiB;
constexpr size_t WS_RX = 110 * MiB, WS_RY = 144 * MiB, WS_SX = 178 * MiB, WS_GA = 195 * MiB, WS_GB = 229 * MiB;
constexpr size_t WS_UPH = 110 * MiB, WS_HFFH = 212 * MiB;
constexpr size_t WS_HFF = 110 * MiB, WS_HALO = 212 * MiB;
constexpr size_t WS_WADA = 110 * MiB, WS_SILUC = 135 * MiB;
constexpr size_t WS_AGGRG = 263 * MiB, WS_AGGS5 = 263 * MiB;
constexpr size_t WS_PART_OUT = 229 * MiB, WS_PART_DOWN = 219 * MiB;
constexpr size_t WS_AGT = 267 * MiB;
constexpr size_t WS_END = 269 * MiB;
constexpr int CW_BAR = 4096, CW_Q = 8192;

constexpr size_t O_Y = 0, O_PRGH = 17825792, O_PRGC = 17842176, O_PS5R = 17891328, O_PS5I = 17924096, O_PFFN = 17956864,
                 O_SRGH = 18153472, O_SRGC = 18415616, O_SS5R = 19202048, O_SS5I = 19726336, O_SFFN = 20250624;

constexpr int RING_BYTES = 131072, LDSCTL_OFF = RING_BYTES, MISC_OFF = LDSCTL_OFF + 320, LDS_BYTES = 147456;
constexpr int XCH_OFF = RING_BYTES + 1024;

typedef float f32x2 __attribute__((ext_vector_type(2)));
typedef unsigned u32x2 __attribute__((ext_vector_type(2)));

struct Args { const float* in[38]; float* out; unsigned char* ws; };

struct Frame { LAS unsigned char* lds; volatile LAS unsigned* MISC; gu32* ctl; int tid, lane, wave, vcu, G; };
__device__ __forceinline__ Frame refresh(const Frame& F0) {
    Frame F = F0; int t = threadIdx.x; asm volatile("" : "+v"(t)); int bx = blockIdx.x; asm volatile("" : "+s"(bx));
    F.tid = t; F.lane = t & 63; F.wave = __builtin_amdgcn_readfirstlane(t >> 6); F.G = gridDim.x; F.vcu = (F.G % 8 == 0) ? (bx % 8) * (F.G / 8) + bx / 8 : bx; return F;
}

__device__ __forceinline__ float bf2f(unsigned short b) { return __builtin_bit_cast(float, (unsigned)b << 16); }
__device__ __forceinline__ float bflo(unsigned w) { return __builtin_bit_cast(float, w << 16); }
__device__ __forceinline__ float bfhi(unsigned w) { return __builtin_bit_cast(float, w & 0xffff0000u); }
__device__ __forceinline__ float fsig(float x) { return __builtin_amdgcn_rcpf(1.f + __builtin_amdgcn_exp2f(-1.44269504f * x)); }
__device__ __forceinline__ float fgelu(float x) { const float u = x * (1.f + 0.044715f * x * x); return x * __builtin_amdgcn_rcpf(1.f + __builtin_amdgcn_exp2f(-2.302208198f * u)); }
__device__ __forceinline__ float wave_sum(float v) {
#pragma unroll
    for (int o = 1; o < 64; o <<= 1) v += __shfl_xor(v, o);
    return v;
}
__device__ __forceinline__ int row_ci(int row) { return row < MP ? (row >> 11) : 8 + ((row - MP) >> 3); }

namespace pg8 {
enum { EM_ADA = 0, EM_IN = 1, EM_GLU = 2, EM_RGP = 3, EM_RES = 4, EM_PLAIN = 5, EM_UPF = 6 };
struct EpiAny {
    static constexpr bool AFTER_DRAIN = false;
    int mode; bool perm; unsigned char* ws; const float* p0; const float* p1; const float* p2; float* out; int row_off; int lay; PG8_LAS float* xch;
    __device__ __forceinline__ void operator()(const f32x4 (&acc)[2][2][4][2], const Unit& u, int wr, int wc, int fr, int fq) const {
        asm volatile("" : "+v"(fr), "+v"(fq), "+s"(wr), "+s"(wc));
        if (mode == EM_IN || mode == EM_PLAIN) {
            const int pn = u.pn; int ldc = 1024, ct = pn; size_t wo = WS_UPH;
            if (mode == EM_IN) { if (pn < 4) { wo = WS_RX; ct = pn; } else if (pn < 8) { wo = WS_RY; ct = pn - 4; } else if (pn < 10) { wo = WS_SX; ct = pn - 8; ldc = 512; } else if (pn < 14) { wo = WS_GA; ct = pn - 10; } else { wo = WS_GB; ct = pn - 14; } }
            else ldc = FF2;
            bf16_t* base = (bf16_t*)(ws + wo);
            const int row0 = u.pm * BM + wr * 64 + fr, col0 = ct * BM + wc * 32 + 8 * fq, bcol0 = pn * BM + wc * 32 + 8 * fq;
#pragma unroll
            for (int bj = 0; bj < 2; ++bj) {
                f32x4 b0 = {0.f, 0.f, 0.f, 0.f}, b1 = {0.f, 0.f, 0.f, 0.f};
                if (mode == EM_IN) { b0 = *(const f32x4*)(p0 + bcol0 + bj * HALF); b1 = *(const f32x4*)(p0 + bcol0 + bj * HALF + 4); }
#pragma unroll
                for (int ai = 0; ai < 2; ++ai)
#pragma unroll
                    for (int m = 0; m < 4; ++m) { bf16_t* rowp = base + (size_t)(row0 + ai * HALF + m * 16) * ldc + col0;
                        const f32x4 v0 = acc[ai][bj][m][0] + b0, v1 = acc[ai][bj][m][1] + b1;
                        u32x4 w; w.x = cvt_pk_bf16(v0[0], v0[1]); w.y = cvt_pk_bf16(v0[2], v0[3]); w.z = cvt_pk_bf16(v1[0], v1[1]); w.w = cvt_pk_bf16(v1[2], v1[3]);
                        *(u32x4*)(rowp + bj * HALF) = w; } }
        } else if (mode == EM_UPF) {
            const int pm = u.pm, pn = u.pn; const bool smp = pm >= 64; const int lane = fq * 16 + fr;
            bf16_t* HF = (bf16_t*)(ws + WS_HFF); float* HALO = (float*)(ws + WS_HALO);
            const int cb = pn * HALF + wc * 32 + 8 * fq;
            if (fr >= 14) {
#pragma unroll
                for (int ai = 0; ai < 2; ++ai)
#pragma unroll
                    for (int bj = 0; bj < 2; ++bj)
#pragma unroll
                        for (int n = 0; n < 2; ++n) *(PG8_LAS f32x4*)(xch + ((((ai * 2 + wr) * 2 + (fr - 14)) * 4 + wc) * 4 + fq) * 16 + bj * 8 + n * 4) = acc[ai][bj][3][n];
            }
            if (!smp) {
                if (wr == 1 && fr >= 14) {
#pragma unroll
                    for (int bj = 0; bj < 2; ++bj)
#pragma unroll
                        for (int n = 0; n < 2; ++n) { *(f32x4*)(HALO + ((size_t)(pm * 4 + (fr - 14)) * 2 + bj) * FF + cb + 4 * n) = acc[1][bj][3][n];
                            if ((pm & 7) == 7) *(f32x4*)(out + O_PFFN + ((size_t)((pm >> 3) * 2 + lay) * 2 + (fr - 14)) * FF2 + bj * FF + cb + 4 * n) = acc[1][bj][3][n]; }
                }
                if (wr == 0 && fr < 2) {
#pragma unroll
                    for (int bj = 0; bj < 2; ++bj)
#pragma unroll
                        for (int n = 0; n < 2; ++n) *(f32x4*)(HALO + ((size_t)(pm * 4 + 2 + fr) * 2 + bj) * FF + cb + 4 * n) = acc[0][bj][0][n];
                }
            } else if ((fr & 7) >= 6) {
#pragma unroll
                for (int ai = 0; ai < 2; ++ai)
#pragma unroll
                    for (int m = 0; m < 4; ++m) { const int sq = ((pm - 64) * BM + ai * HALF + wr * 64 + m * 16 + fr) >> 3;
#pragma unroll
                        for (int bj = 0; bj < 2; ++bj)
#pragma unroll
                            for (int n = 0; n < 2; ++n) *(f32x4*)(out + O_SFFN + ((size_t)(sq * 2 + lay) * 2 + ((fr & 7) - 6)) * FF2 + bj * FF + cb + 4 * n) = acc[ai][bj][m][n]; }
            }
            asm volatile("s_waitcnt lgkmcnt(0)" ::: "memory"); __builtin_amdgcn_s_barrier(); asm volatile("" ::: "memory");
#pragma unroll
            for (int n = 0; n < 2; ++n) {
                const int c4 = cb + 4 * n;
                f32x4 w[2][3], bb[2];
#pragma unroll
                for (int bj = 0; bj < 2; ++bj) { bb[bj] = *(const f32x4*)(p1 + bj * FF + c4);
#pragma unroll
                    for (int k = 0; k < 3; ++k) w[bj][k] = *(const f32x4*)(p0 + k * FF2 + bj * FF + c4); }
#pragma unroll
                for (int ai = 0; ai < 2; ++ai) {
                    f32x4 pg[2] = {{0.f, 0.f, 0.f, 0.f}, {0.f, 0.f, 0.f, 0.f}};
                    const int blk = ai * 2 + wr;
                    if (!smp && blk > 0 && fr >= 14) {
#pragma unroll
                        for (int bj = 0; bj < 2; ++bj) pg[bj] = *(const PG8_LAS f32x4*)(xch + (((((blk - 1) * 2 + (fr - 14)) * 4 + wc) * 4 + fq) * 16 + bj * 8 + n * 4));
                    }
#pragma unroll
                    for (int m = 0; m < 4; ++m) {
                        const int trow = ai * HALF + wr * 64 + m * 16 + fr;
                        f32x4 uc[2];
#pragma unroll
                        for (int bj = 0; bj < 2; ++bj) {
                            const f32x4 cur = acc[ai][bj][m][n]; f32x4 p1v, p2v;
#pragma unroll
                            for (int j = 0; j < 4; ++j) { const float x1 = (fr == 15) ? pg[bj][j] : cur[j], x2 = (fr >= 14) ? pg[bj][j] : cur[j];
                                p1v[j] = __builtin_bit_cast(float, __builtin_amdgcn_update_dpp(0, __builtin_bit_cast(int, x1), 0x121, 0xF, 0xF, false));
                                p2v[j] = __builtin_bit_cast(float, __builtin_amdgcn_update_dpp(0, __builtin_bit_cast(int, x2), 0x122, 0xF, 0xF, false)); }
                            if (smp) { const int t = fr & 7;
                                if (t < 2) { const int sq = ((pm - 64) * BM + trow) >> 3; const float* st = p2 + ((size_t)(sq * 2 + lay) * 2) * FF2 + bj * FF + c4;
                                    const f32x4 s1 = *(const f32x4*)(st + FF2); p2v = s1; if (t == 0) { p1v = s1; p2v = *(const f32x4*)st; } } }
                            uc[bj] = bb[bj] + w[bj][0] * p2v + w[bj][1] * p1v + w[bj][2] * cur;
                            pg[bj] = cur;
                        }
                        u32x2 o; o.x = cvt_pk_bf16(fgelu(uc[0][0]) * uc[1][0], fgelu(uc[0][1]) * uc[1][1]); o.y = cvt_pk_bf16(fgelu(uc[0][2]) * uc[1][2], fgelu(uc[0][3]) * uc[1][3]);
                        *(u32x2*)(HF + (size_t)(pm * BM + trow) * FF + c4) = o;
                    }
                }
            }
        } else if (mode == EM_GLU) {
            bf16_t* GA = (bf16_t*)(ws + WS_GA); const bf16_t* GB = (const bf16_t*)(ws + WS_GB);
            const int row0 = u.pm * BM + wr * 64 + fr, col0 = u.pn * HALF + wc * 32 + 8 * fq;
#pragma unroll
            for (int ai = 0; ai < 2; ++ai) {
                u32x4 gq[4], aq[4];
#pragma unroll
                for (int m = 0; m < 4; ++m) { const size_t off = (size_t)(row0 + ai * HALF + m * 16) * 1024 + col0; gq[m] = *(const u32x4*)(GB + off); aq[m] = *(const u32x4*)(GA + off); }
#pragma unroll
                for (int m = 0; m < 4; ++m) { const size_t off = (size_t)(row0 + ai * HALF + m * 16) * 1024 + col0;
                    const u32x4 g = gq[m], a = aq[m];
                    float gv[8] = {bflo(g.x), bfhi(g.x), bflo(g.y), bfhi(g.y), bflo(g.z), bfhi(g.z), bflo(g.w), bfhi(g.w)};
                    float av[8] = {bflo(a.x), bfhi(a.x), bflo(a.y), bfhi(a.y), bflo(a.z), bfhi(a.z), bflo(a.w), bfhi(a.w)}; float o[8];
#pragma unroll
                    for (int n = 0; n < 2; ++n)
#pragma unroll
                        for (int j = 0; j < 4; ++j) o[4 * n + j] = av[4 * n + j] + fsig(gv[4 * n + j]) * acc[ai][0][m][n][j] * fsig(acc[ai][1][m][n][j]);
                    u32x4 w; w.x = cvt_pk_bf16(o[0], o[1]); w.y = cvt_pk_bf16(o[2], o[3]); w.z = cvt_pk_bf16(o[4], o[5]); w.w = cvt_pk_bf16(o[6], o[7]);
                    *(u32x4*)(GA + off) = w; } }
        } else if (mode == EM_RGP) {
            bf16_t* GA = (bf16_t*)(ws + WS_GA);
            const int row0 = u.pm * BM + wr * 64 + fr, col0 = u.pn * BM + wc * 32 + 8 * fq;
#pragma unroll
            for (int ai = 0; ai < 2; ++ai) {
                u32x4 gq[4][2];
#pragma unroll
                for (int m = 0; m < 4; ++m)
#pragma unroll
                    for (int bj = 0; bj < 2; ++bj) gq[m][bj] = *(const u32x4*)(GA + (size_t)(row0 + ai * HALF + m * 16) * 1024 + col0 + bj * HALF);
#pragma unroll
                for (int m = 0; m < 4; ++m)
#pragma unroll
                    for (int bj = 0; bj < 2; ++bj) { const size_t off = (size_t)(row0 + ai * HALF + m * 16) * 1024 + col0 + bj * HALF;
                        const u32x4 g = gq[m][bj];
                        float gv[8] = {bflo(g.x), bfhi(g.x), bflo(g.y), bfhi(g.y), bflo(g.z), bfhi(g.z), bflo(g.w), bfhi(g.w)}; float o[8];
#pragma unroll
                        for (int n = 0; n < 2; ++n)
#pragma unroll
                            for (int j = 0; j < 4; ++j) o[4 * n + j] = fsig(gv[4 * n + j]) * acc[ai][bj][m][n][j];
                        u32x4 w; w.x = cvt_pk_bf16(o[0], o[1]); w.y = cvt_pk_bf16(o[2], o[3]); w.z = cvt_pk_bf16(o[4], o[5]); w.w = cvt_pk_bf16(o[6], o[7]);
                        *(u32x4*)(GA + off) = w; } }
        } else if (mode == EM_RES) {
            bf16_t* XB = (bf16_t*)(ws + WS_XRB);
            const int col0 = u.pn * BM + wc * 32 + 8 * fq;
            if (u.mini) {
#pragma unroll
                for (int ai = 0; ai < 2; ++ai)
#pragma unroll
                    for (int m = 0; m < 4; ++m) { const int r = u.pm * BM + ai * HALF + wr * 64 + m * 16 + fr;
#pragma unroll
                        for (int bj = 0; bj < 2; ++bj) { float* P = (float*)(ws + (row_off ? WS_PART_DOWN : WS_PART_OUT)) + ((size_t)(u.koff / u.ksl) * (MROWS - MP) + (r - MP)) * DM + col0 + bj * HALF;
                            *(f32x4*)P = acc[ai][bj][m][0]; *(f32x4*)(P + 4) = acc[ai][bj][m][1]; } }
            } else {
                const float* gt = p2 + (size_t)(u.pm >> 3) * MODW;
                f32x4 gq[2][2];
#pragma unroll
                for (int bj = 0; bj < 2; ++bj) { gq[bj][0] = *(const f32x4*)(gt + col0 + bj * HALF); gq[bj][1] = *(const f32x4*)(gt + col0 + bj * HALF + 4); }
#pragma unroll
                for (int ai = 0; ai < 2; ++ai) {
                    f32x4 sq[4][2][2];
#pragma unroll
                    for (int m = 0; m < 4; ++m)
#pragma unroll
                        for (int bj = 0; bj < 2; ++bj) { const size_t off = (size_t)(u.pm * BM + ai * HALF + wr * 64 + m * 16 + fr) * DM + col0 + bj * HALF;
                            if (p0) { sq[m][bj][0] = *(const f32x4*)(p0 + off); sq[m][bj][1] = *(const f32x4*)(p0 + off + 4); }
                            else { const u32x4 b = *(const u32x4*)(XB + off); sq[m][bj][0] = (f32x4){bflo(b.x), bfhi(b.x), bflo(b.y), bfhi(b.y)}; sq[m][bj][1] = (f32x4){bflo(b.z), bfhi(b.z), bflo(b.w), bfhi(b.w)}; } }
#pragma unroll
                    for (int m = 0; m < 4; ++m)
#pragma unroll
                        for (int bj = 0; bj < 2; ++bj) { const size_t off = (size_t)(u.pm * BM + ai * HALF + wr * 64 + m * 16 + fr) * DM + col0 + bj * HALF;
                            const f32x4 o0 = sq[m][bj][0] + gq[bj][0] * acc[ai][bj][m][0], o1 = sq[m][bj][1] + gq[bj][1] * acc[ai][bj][m][1];
                            u32x4 w; w.x = cvt_pk_bf16(o0[0], o0[1]); w.y = cvt_pk_bf16(o0[2], o0[3]); w.z = cvt_pk_bf16(o1[0], o1[1]); w.w = cvt_pk_bf16(o1[2], o1[3]);
                            *(u32x4*)(XB + off) = w; } }
            }
        } else {
            const int col0 = u.pn * BM + wc * 32 + 4 * fq;
#pragma unroll
            for (int ai = 0; ai < 2; ++ai)
#pragma unroll
                for (int m = 0; m < 4; ++m) { const int r = ai * HALF + wr * 64 + m * 16 + fr;
                    if (r < NCI) {
#pragma unroll
                        for (int bj = 0; bj < 2; ++bj)
#pragma unroll
                            for (int n = 0; n < 2; ++n) { const int c = col0 + bj * HALF + n * 16; *(f32x4*)(out + (size_t)r * MODW + c) = acc[ai][bj][m][n] + *(const f32x4*)(p0 + c); } } }
        }
    }
};
}

template <int MAP> __device__ __forceinline__ int wt_row(int n) {
    if (MAP == 1) { return n < 1024 ? ((n >> 7) << 8) + (n & 127) : (((n - 1024) >> 7) << 8) + 128 + (n & 127); }
    if (MAP == 2) { return n < 3072 ? ((n >> 7) << 8) + (n & 127) : (((n - 3072) >> 7) << 8) + 128 + (n & 127); }
    return n;
}
template <int MAP> __device__ __forceinline__ void p0_transpose_item(const float* W, int K, int N, bf16* WT, int row_off, LAS float* scr, int item, int lane) {
    const int nblk = N / 32, kb = item / nblk, nb = item % nblk, k0 = 64 * kb, n0 = 32 * nb;
    { f32x4 v[8];
#pragma unroll
      for (int i = 0; i < 8; ++i) v[i] = *(const f32x4*)(W + (size_t)(k0 + 8 * i + (lane >> 3)) * N + n0 + 4 * (lane & 7));
#pragma unroll
      for (int i = 0; i < 8; ++i) { LAS float* d = scr + (8 * i + (lane >> 3)) * 33 + 4 * (lane & 7); d[0] = v[i].x; d[1] = v[i].y; d[2] = v[i].z; d[3] = v[i].w; } }
    LDS_WAIT(); asm volatile("" ::: "memory");
    const int c = lane & 7;
#pragma unroll
    for (int j = 0; j < 4; ++j) { const int n = (lane >> 3) + 8 * j; const LAS float* s = scr + (8 * c) * 33 + n;
        v4u o; o.x = pk2(s[0 * 33], s[1 * 33]); o.y = pk2(s[2 * 33], s[3 * 33]); o.z = pk2(s[4 * 33], s[5 * 33]); o.w = pk2(s[6 * 33], s[7 * 33]);
        *(GAS v4u*)(WT + (size_t)(row_off + wt_row<MAP>(n0 + n)) * K + k0 + 8 * c) = o; }
    LDS_WAIT(); asm volatile("" ::: "memory");
}

__device__ __forceinline__ void p0_weights(const Frame& F0, const Args& A, int l, int part, int b0, int nb) {
    const Frame F = refresh(F0);
    unsigned char* ws = A.ws;
    LAS float* scr = (LAS float*)(F.lds + F.wave * 16384);
    int bx = blockIdx.x; asm volatile("" : "+s"(bx));
    if (bx < b0) return;
    const bool first = part == 0;
    const int gw = (bx - b0) * NWAVES + F.wave, NGW = nb * NWAVES;
    constexpr int I_IN = (DM / 64) * (INW / 32), I_SQ = (DM / 64) * (DM / 32), I_GLU = (512 / 64) * (2048 / 32), I_UP = (DM / 64) * (FF2 / 32), I_DN = (FF / 64) * (DM / 32), I_ADA = (DM / 64) * (FF2 / 32);
    constexpr int NLAYER = I_IN + 2 * I_SQ + I_GLU + I_UP + I_DN;
    const int nitems = first ? 2 * I_ADA : NLAYER;
    const int per_ = (nitems + NGW - 1) / NGW, it_hi = (gw + 1) * per_ < nitems ? (gw + 1) * per_ : nitems;
    for (int it = gw * per_; it < it_hi; ++it) {
        int r = first ? it + NLAYER : it;
        if (r < I_IN) { p0_transpose_item<0>(A.in[13] + (size_t)l * DM * INW, DM, INW, (bf16*)(ws + WS_WIN), 0, scr, r, F.lane); continue; } r -= I_IN;
        if (r < I_SQ) { p0_transpose_item<0>(A.in[30] + (size_t)l * DM * DM, DM, DM, (bf16*)(ws + WS_WRG), 0, scr, r, F.lane); continue; } r -= I_SQ;
        if (r < I_SQ) { p0_transpose_item<0>(A.in[32] + (size_t)l * DM * DM, DM, DM, (bf16*)(ws + WS_WOUT), 0, scr, r, F.lane); continue; } r -= I_SQ;
        if (r < I_GLU) { p0_transpose_item<1>(A.in[31] + (size_t)l * 512 * 2048, 512, 2048, (bf16*)(ws + WS_WGLU), 0, scr, r, F.lane); continue; } r -= I_GLU;
        if (r < I_UP) { p0_transpose_item<2>(A.in[33] + (size_t)l * DM * FF2, DM, FF2, (bf16*)(ws + WS_WUP), 0, scr, r, F.lane); continue; } r -= I_UP;
        if (r < I_DN) { p0_transpose_item<0>(A.in[36] + (size_t)l * FF * DM, FF, DM, (bf16*)(ws + WS_WDOWN), 0, scr, r, F.lane); continue; } r -= I_DN;
        if (r < I_ADA) { p0_transpose_item<0>(A.in[9], DM, FF2, (bf16*)(ws + WS_WADA), 0, scr, r, F.lane); continue; } r -= I_ADA;
        p0_transpose_item<0>(A.in[9] + (size_t)DM * FF2, DM, FF2, (bf16*)(ws + WS_WADA), FF2, scr, r, F.lane);
    }
    const int gt = (bx - b0) * (NWAVES * 64) + F.tid, NGT = nb * NWAVES * 64;
    if (!first) {
    bf16* WG = (bf16*)(ws + WS_SMALL + SM_WG);
    for (int e = gt; e < 2 * 16 * 4096; e += NGT) { const int gate = e >> 16, rem = e & 65535, h = rem >> 12, j = (rem >> 6) & 63, i = rem & 63;
        const float* src = (gate ? A.in[19] : A.in[17]) + (size_t)l * 65536 + h * 4096 + i * 64 + j;
        WG[((h * 2 + gate) * 64 + j) * 64 + i] = (bf16)f2bf(*src); }
    for (int e = gt; e < 2048; e += NGT) { const int g = e >> 6, p = e & 63;
        const float dt = expf(A.in[29][l * 32 + g]);
        const float lr = A.in[22][l * 2048 + e], li = A.in[23][l * 2048 + e];
        const float mag = expf(lr * dt); float sn, cs; sincosf(li * dt, &sn, &cs);
        const float ar = mag * cs, ai = mag * sn, den = lr * lr + li * li;
        const float zr = ((ar - 1.f) * lr + ai * li) / den, zi = (ai * lr - (ar - 1.f) * li) / den;
        float* AB = (float*)(ws + WS_SMALL + SM_ABAR); AB[e * 2] = ar; AB[e * 2 + 1] = ai;
        float pr = ar, pi = ai;
#pragma unroll 1
        for (int s = 0; s < 7; ++s) { const float nr = pr * pr - pi * pi, ni = 2.f * pr * pi; pr = nr; pi = ni; }
        float* ABT = (float*)(ws + WS_SMALL + SM_ABARTC); ABT[e * 2] = pr; ABT[e * 2 + 1] = pi;
        bf16* BB = (bf16*)(ws + WS_SMALL + SM_BBAR) + (size_t)g * 128 * 16;
        const float* bre = A.in[24] + ((size_t)l * 2048 + e) * 16; const float* bim = A.in[25] + ((size_t)l * 2048 + e) * 16;
#pragma unroll 4
        for (int c = 0; c < 16; ++c) { const float br = bre[c], bi = bim[c]; BB[p * 16 + c] = (bf16)f2bf(zr * br - zi * bi); BB[(64 + p) * 16 + c] = (bf16)f2bf(zr * bi + zi * br); }
        bf16* CM = (bf16*)(ws + WS_SMALL + SM_CMAT) + (size_t)g * 16 * 128;
        const float* cre = A.in[26] + ((size_t)l * 32 + g) * 1024; const float* cim = A.in[27] + ((size_t)l * 32 + g) * 1024;
#pragma unroll 4
        for (int c = 0; c < 16; ++c) { CM[c * 128 + p] = (bf16)f2bf(cre[c * 64 + p]); CM[c * 128 + 64 + p] = (bf16)f2bf(-cim[c * 64 + p]); }
    }
    }
    if (first) {
        bf16* XRs = (bf16*)(ws + WS_XRB) + (size_t)MP * DM;
        for (int e = gt; e < (MROWS - MP) * DM / 4; e += NGT) { const f32x4 v = ((const f32x4*)A.in[1])[e]; ((unsigned long long*)XRs)[e] = (unsigned long long)pk2(v.x, v.y) | ((unsigned long long)pk2(v.z, v.w) << 32); }
    }
    if (first) {
        bf16* SC = (bf16*)(ws + WS_SILUC);
        for (int e = gt; e < 256 * DM; e += NGT) { const int r = e >> 10, c = e & 1023; float v = 0.f;
            if (r < NSP) v = A.in[7][r * DM + c]; else if (r < NCI) v = A.in[8][(r - NSP) * DM + c];
            SC[e] = (bf16)f2bf(v * fsig(v)); }
    }
}

__device__ __forceinline__ void cvt8(const v4u w, float (&o)[8]) { o[0] = bflo(w.x); o[1] = bfhi(w.x); o[2] = bflo(w.y); o[3] = bfhi(w.y); o[4] = bflo(w.z); o[5] = bfhi(w.z); o[6] = bflo(w.w); o[7] = bfhi(w.w); }
__device__ __forceinline__ f32x4 ld_row4(const float* xf, const bf16* xb, size_t row, int idx) {
    if (xf) return ((const GAS f32x4*)(xf + row * DM))[idx];
    const u32x2 b = ((const GAS u32x2*)(xb + row * DM))[idx]; return (f32x4){bflo(b.x), bfhi(b.x), bflo(b.y), bfhi(b.y)};
}
__device__ __forceinline__ void norm_rows(const Frame& F0, const float* xp, const float* xs_adj, bf16* XRB, const float* g, const float* mod_sh, const float* mod_sc, bf16* XN, int npart, const float* pgate, const float* PART) {
    const Frame F = refresh(F0);
    const int gw = F.vcu * NWAVES + F.wave, NGW = F.G * NWAVES;
    if (!xp) {
        for (int m0 = 8 * gw; m0 < MP; m0 += 8 * NGW) {
            const int ci = m0 >> 11;
            v4u w[8][2]; float sr[8];
#pragma unroll
            for (int r = 0; r < 8; ++r)
#pragma unroll
                for (int j = 0; j < 2; ++j) w[r][j] = ((const GAS v4u*)(XRB + (size_t)(m0 + r) * DM))[64 * j + F.lane];
#pragma unroll
            for (int r = 0; r < 8; ++r) { float q = 0.f;
#pragma unroll
                for (int j = 0; j < 2; ++j) { float v[8]; cvt8(w[r][j], v);
#pragma unroll
                    for (int e = 0; e < 8; ++e) q += v[e] * v[e]; }
                sr[r] = __builtin_amdgcn_rsqf(wave_sum(q) * (1.f / DM) + EPSN); }
#pragma unroll
            for (int j = 0; j < 2; ++j) { const int c = 512 * j + 8 * F.lane; float gs[8], sh[8];
#pragma unroll
                for (int h2 = 0; h2 < 2; ++h2) { const f32x4 gg = *(const f32x4*)(g + c + 4 * h2), s4 = *(const f32x4*)(mod_sh + (size_t)ci * MODW + c + 4 * h2), c4 = *(const f32x4*)(mod_sc + (size_t)ci * MODW + c + 4 * h2);
#pragma unroll
                    for (int e = 0; e < 4; ++e) { gs[4 * h2 + e] = gg[e] * (c4[e] + 1.f); sh[4 * h2 + e] = s4[e]; } }
#pragma unroll
                for (int r = 0; r < 8; ++r) { float v[8]; cvt8(w[r][j], v); v4u o;
                    o.x = pk2(v[0] * sr[r] * gs[0] + sh[0], v[1] * sr[r] * gs[1] + sh[1]); o.y = pk2(v[2] * sr[r] * gs[2] + sh[2], v[3] * sr[r] * gs[3] + sh[3]);
                    o.z = pk2(v[4] * sr[r] * gs[4] + sh[4], v[5] * sr[r] * gs[5] + sh[5]); o.w = pk2(v[6] * sr[r] * gs[6] + sh[6], v[7] * sr[r] * gs[7] + sh[7]);
                    ((GAS v4u*)(XN + (size_t)(m0 + r) * DM))[64 * j + F.lane] = o; } }
        }
    } else
    for (int m0 = 4 * gw; m0 < MP; m0 += 4 * NGW) {
        const int ci = m0 >> 11;
        f32x4 v[4][4]; float s[4];
#pragma unroll
        for (int r = 0; r < 4; ++r)
#pragma unroll
            for (int j = 0; j < 4; ++j) v[r][j] = ld_row4(xp, XRB, (size_t)(m0 + r), 64 * j + F.lane);
#pragma unroll
        for (int r = 0; r < 4; ++r) { float q = 0.f;
#pragma unroll
            for (int j = 0; j < 4; ++j) q += (v[r][j].x * v[r][j].x + v[r][j].y * v[r][j].y) + (v[r][j].z * v[r][j].z + v[r][j].w * v[r][j].w);
            s[r] = 1.f / sqrtf(wave_sum(q) * (1.f / DM) + EPSN); }
#pragma unroll
        for (int j = 0; j < 4; ++j) { const int c = 256 * j + 4 * F.lane;
            const f32x4 gg = *(const f32x4*)(g + c), sh = *(const f32x4*)(mod_sh + (size_t)ci * MODW + c), sc = *(const f32x4*)(mod_sc + (size_t)ci * MODW + c);
            const f32x4 gs = gg * (sc + 1.f);
#pragma unroll
            for (int r = 0; r < 4; ++r) { const f32x4 y = v[r][j] * s[r] * gs + sh;
                ((GAS unsigned long long*)(XN + (size_t)(m0 + r) * DM))[64 * j + F.lane] = (unsigned long long)pk2(y.x, y.y) | ((unsigned long long)pk2(y.z, y.w) << 32); } }
    }
    for (int m = MP + F.wave * F.G + F.vcu; m < MROWS; m += NGW) {
        const int ci = row_ci(m);
        f32x4 v[4]; float q = 0.f;
#pragma unroll
        for (int j = 0; j < 4; ++j) { v[j] = ld_row4(xs_adj, XRB, (size_t)m, 64 * j + F.lane);
            if (npart > 0) {
                f32x4 ps = {0.f, 0.f, 0.f, 0.f};
#pragma unroll
                for (int k = 0; k < 12; ++k) if (k < npart) ps += *(const f32x4*)(PART + ((size_t)k * (MROWS - MP) + (m - MP)) * DM + 256 * j + 4 * F.lane);
                v[j] += *(const f32x4*)(pgate + (size_t)ci * MODW + 256 * j + 4 * F.lane) * ps;
                ((GAS unsigned long long*)(XRB + (size_t)m * DM))[64 * j + F.lane] = (unsigned long long)pk2(v[j].x, v[j].y) | ((unsigned long long)pk2(v[j].z, v[j].w) << 32);
            }
            q += (v[j].x * v[j].x + v[j].y * v[j].y) + (v[j].z * v[j].z + v[j].w * v[j].w); }
        const float rstd = 1.f / sqrtf(wave_sum(q) * (1.f / DM) + EPSN);
#pragma unroll
        for (int j = 0; j < 4; ++j) { const int c = 256 * j + 4 * F.lane;
            const f32x4 gg = *(const f32x4*)(g + c), sh = *(const f32x4*)(mod_sh + (size_t)ci * MODW + c), sc = *(const f32x4*)(mod_sc + (size_t)ci * MODW + c);
            const f32x4 y = v[j] * rstd * gg * (sc + 1.f) + sh;
            ((GAS unsigned long long*)(XN + (size_t)m * DM))[64 * j + F.lane] = (unsigned long long)pk2(y.x, y.y) | ((unsigned long long)pk2(y.z, y.w) << 32); }
    }
}
__device__ __forceinline__ void final_norm(const Frame& F0, const bf16* XRB, float* y, const float* g, int npart, const float* pgate, const float* PART) {
    const Frame F = refresh(F0);
    const int gw = F.vcu * NWAVES + F.wave, NGW = F.G * NWAVES;
    for (int m0 = 8 * gw; m0 < MP; m0 += 8 * NGW) {
        v4u w[8][2]; float sr[8];
#pragma unroll
        for (int r = 0; r < 8; ++r)
#pragma unroll
            for (int j = 0; j < 2; ++j) w[r][j] = ((const GAS v4u*)(XRB + (size_t)(m0 + r) * DM))[64 * j + F.lane];
#pragma unroll
        for (int r = 0; r < 8; ++r) { float q = 0.f;
#pragma unroll
            for (int j = 0; j < 2; ++j) { float v[8]; cvt8(w[r][j], v);
#pragma unroll
                for (int e = 0; e < 8; ++e) q += v[e] * v[e]; }
            sr[r] = __builtin_amdgcn_rsqf(wave_sum(q) * (1.f / DM) + EPSN); }
#pragma unroll
        for (int j = 0; j < 2; ++j) { const int c = 512 * j + 8 * F.lane; const f32x4 g0 = *(const f32x4*)(g + c), g1 = *(const f32x4*)(g + c + 4);
#pragma unroll
            for (int r = 0; r < 8; ++r) { float v[8]; cvt8(w[r][j], v); float* yp = y + (size_t)(m0 + r) * DM + c;
                *(f32x4*)yp = (f32x4){v[0], v[1], v[2], v[3]} * sr[r] * g0; *(f32x4*)(yp + 4) = (f32x4){v[4], v[5], v[6], v[7]} * sr[r] * g1; } }
    }
    for (int m = MP + F.wave * F.G + F.vcu; m < MROWS; m += NGW) {
        const int ci = row_ci(m);
        f32x4 v[4]; float q = 0.f;
#pragma unroll
        for (int j = 0; j < 4; ++j) { v[j] = ld_row4(nullptr, XRB, (size_t)m, 64 * j + F.lane);
            f32x4 ps = {0.f, 0.f, 0.f, 0.f};
#pragma unroll
            for (int k = 0; k < 12; ++k) if (k < npart) ps += *(const f32x4*)(PART + ((size_t)k * (MROWS - MP) + (m - MP)) * DM + 256 * j + 4 * F.lane);
            v[j] += *(const f32x4*)(pgate + (size_t)ci * MODW + 256 * j + 4 * F.lane) * ps;
            q += (v[j].x * v[j].x + v[j].y * v[j].y) + (v[j].z * v[j].z + v[j].w * v[j].w); }
        const float rstd = 1.f / sqrtf(wave_sum(q) * (1.f / DM) + EPSN);
#pragma unroll
        for (int j = 0; j < 4; ++j) { const f32x4 gg = *(const f32x4*)(g + 256 * j + 4 * F.lane); ((GAS f32x4*)(y + (size_t)m * DM))[64 * j + F.lane] = v[j] * rstd * gg; }
    }
}


template <int MODE> __device__ __forceinline__ void rg_unit(const Frame& F, const Args& A, int l, bool sample, int s, int c, int h) {
    unsigned char* ws = A.ws;
    LAS float* TAB = (LAS float*)(F.lds + F.wave * 15360);
    LAS float* XC = TAB + 512;
    LAS float* AA = XC + 16 * 68;
    LAS float* BB = AA + 16 * 68;
    const int lane = F.lane, fr = lane & 15, fq = lane >> 4, ch0 = 64 * h;
    const bf16* RX = (const bf16*)(ws + WS_RX); bf16* RY = (bf16*)(ws + WS_RY);
    {
        const int chg = l * DM + ch0 + lane;
#pragma unroll
        for (int j = 0; j < 4; ++j) TAB[j * 64 + lane] = A.in[15][(size_t)(l * 4 + j) * DM + ch0 + lane];
        TAB[4 * 64 + lane] = A.in[16][chg]; TAB[5 * 64 + lane] = A.in[18][chg]; TAB[6 * 64 + lane] = A.in[20][chg];
        const float lam = A.in[21][chg]; TAB[7 * 64 + lane] = -8.f * 1.44269504f * log1pf(expf(-lam));
    }
    bf16x8 Wf[2][4][2];
    { const bf16* WG = (const bf16*)(ws + WS_SMALL + SM_WG);
#pragma unroll
      for (int g = 0; g < 2; ++g)
#pragma unroll
        for (int n = 0; n < 4; ++n)
#pragma unroll
            for (int k = 0; k < 2; ++k) Wf[g][n][k] = *(const bf16x8*)(WG + ((h * 2 + g) * 64 + 16 * n + fr) * 64 + 32 * k + 8 * fq); }
    LDS_WAIT(); asm volatile("" ::: "memory");
    const int rbase = sample ? MP + s * 32 : s * TP + c * TC;
    float hst = 0.f, aprod = 1.f;
    if (MODE == 1 && !sample) {
        const float* AG = (const float*)(ws + WS_AGGRG) + ((size_t)(s * NCH) * DM + ch0 + lane) * 2;
        for (int cc = 0; cc < c; ++cc) { const float a = AG[(size_t)cc * DM * 2], b = AG[(size_t)cc * DM * 2 + 1]; hst = a * hst + b; }
    }
    const int ntile = sample ? 2 : 8;
#pragma unroll 1
    for (int tile = 0; tile < ntile; ++tile) {
        const int row = rbase + 16 * tile + fr;
        const int t = sample ? (fr & 7) : c * TC + 16 * tile + fr;
        const int sq = sample ? s * 4 + tile * 2 + (fr >> 3) : s;
        bf16x8 X[2];
#pragma unroll
        for (int k = 0; k < 2; ++k) {
            const int cl = 32 * k + 8 * fq; float xc[8];
            { const f32x4 b0 = *(const LAS f32x4*)(TAB + 4 * 64 + cl), b1 = *(const LAS f32x4*)(TAB + 4 * 64 + cl + 4); xc[0] = b0.x; xc[1] = b0.y; xc[2] = b0.z; xc[3] = b0.w; xc[4] = b1.x; xc[5] = b1.y; xc[6] = b1.z; xc[7] = b1.w; }
#pragma unroll
            for (int d = 0; d < 4; ++d) {
                float v[8];
                if (t - d >= 0) { cvt8(*(const v4u*)(RX + (size_t)(row - d) * DM + ch0 + cl), v); }
                else if (sample) { const float* st = A.in[3] + ((size_t)(sq * 2 + l) * 3 + (3 + t - d)) * DM + ch0 + cl; const f32x4 a0 = *(const f32x4*)st, a1 = *(const f32x4*)(st + 4);
                    v[0] = a0.x; v[1] = a0.y; v[2] = a0.z; v[3] = a0.w; v[4] = a1.x; v[5] = a1.y; v[6] = a1.z; v[7] = a1.w; }
                else {
#pragma unroll
                    for (int q = 0; q < 8; ++q) v[q] = 0.f; }
                const f32x4 w0 = *(const LAS f32x4*)(TAB + (3 - d) * 64 + cl), w1 = *(const LAS f32x4*)(TAB + (3 - d) * 64 + cl + 4);
                xc[0] += w0.x * v[0]; xc[1] += w0.y * v[1]; xc[2] += w0.z * v[2]; xc[3] += w0.w * v[3]; xc[4] += w1.x * v[4]; xc[5] += w1.y * v[5]; xc[6] += w1.z * v[6]; xc[7] += w1.w * v[7];
            }
            *(LAS f32x4*)(XC + fr * 68 + cl) = (f32x4){xc[0], xc[1], xc[2], xc[3]}; *(LAS f32x4*)(XC + fr * 68 + cl + 4) = (f32x4){xc[4], xc[5], xc[6], xc[7]};
            v4u pk; pk.x = pk2(xc[0], xc[1]); pk.y = pk2(xc[2], xc[3]); pk.z = pk2(xc[4], xc[5]); pk.w = pk2(xc[6], xc[7]);
            X[k] = __builtin_bit_cast(bf16x8, pk);
        }
        f32x4 acc[2][4];
#pragma unroll
        for (int g = 0; g < 2; ++g)
#pragma unroll
            for (int n = 0; n < 4; ++n) { acc[g][n] = (f32x4){0.f, 0.f, 0.f, 0.f};
#pragma unroll
                for (int k = 0; k < 2; ++k) acc[g][n] = __builtin_amdgcn_mfma_f32_16x16x32_bf16(Wf[g][n][k], X[k], acc[g][n], 0, 0, 0); }
        LDS_WAIT(); asm volatile("" ::: "memory");
#pragma unroll
        for (int n = 0; n < 4; ++n) { const int cl = 16 * n + 4 * fq;
            const f32x4 xv = *(const LAS f32x4*)(XC + fr * 68 + cl), ba = *(const LAS f32x4*)(TAB + 5 * 64 + cl), bx = *(const LAS f32x4*)(TAB + 6 * 64 + cl), c8 = *(const LAS f32x4*)(TAB + 7 * 64 + cl);
            f32x4 av, bv;
#pragma unroll
            for (int j = 0; j < 4; ++j) { const float r = fsig(acc[0][n][j] + ba[j]), ig = fsig(acc[1][n][j] + bx[j]); const float a = __builtin_amdgcn_exp2f(r * c8[j]);
                av[j] = a; bv[j] = __builtin_amdgcn_sqrtf(fmaxf(1.f - a * a, 0.f)) * ig * xv[j]; }
            *(LAS f32x4*)(AA + fr * 68 + cl) = av; *(LAS f32x4*)(BB + fr * 68 + cl) = bv; }
        LDS_WAIT(); asm volatile("" ::: "memory");
#pragma unroll
        for (int tt = 0; tt < 16; ++tt) {
            if (sample && (tt & 7) == 0) hst = A.in[2][(size_t)((s * 4 + tile * 2 + (tt >> 3)) * 2 + l) * DM + ch0 + lane];
            const float a = AA[tt * 68 + lane], b = BB[tt * 68 + lane];
            hst = a * hst + b; if (MODE == 0) aprod *= a;
            if (MODE == 1) BB[tt * 68 + lane] = hst;
            if (MODE == 1 && sample && (tt & 7) == 7) A.out[O_SRGH + (size_t)((s * 4 + tile * 2 + (tt >> 3)) * 2 + l) * DM + ch0 + lane] = hst;
        }
        if (MODE == 1) {
            LDS_WAIT(); asm volatile("" ::: "memory");
#pragma unroll
            for (int n = 0; n < 4; ++n) { const int cl = 16 * n + 4 * fq; const f32x4 hv = *(const LAS f32x4*)(BB + fr * 68 + cl);
                bf16* p = RY + (size_t)row * DM + ch0 + cl; const u32x2 ry = *(const u32x2*)p;
                u32x2 o; o.x = pk2(hv.x * fgelu(bflo(ry.x)), hv.y * fgelu(bfhi(ry.x))); o.y = pk2(hv.z * fgelu(bflo(ry.y)), hv.w * fgelu(bfhi(ry.y)));
                *(u32x2*)p = o; }
            LDS_WAIT(); asm volatile("" ::: "memory");
        }
    }
    if (MODE == 0) { float* AG = (float*)(ws + WS_AGGRG) + ((size_t)(s * NCH + c) * DM + ch0 + lane) * 2; AG[0] = aprod; AG[1] = hst; }
    if (MODE == 1) {
        if (!sample && c == NCH - 1) {
            A.out[O_PRGH + (size_t)(s * 2 + l) * DM + ch0 + lane] = hst;
#pragma unroll
            for (int k = 0; k < 3; ++k) A.out[O_PRGC + (size_t)((s * 2 + l) * 3 + k) * DM + ch0 + lane] = bf2f(RX[(size_t)(s * TP + TP - 3 + k) * DM + ch0 + lane]);
        }
        if (sample) {
#pragma unroll 1
            for (int q = 0; q < 4; ++q) { const int n = s * 4 + q;
#pragma unroll
                for (int k = 0; k < 3; ++k) A.out[O_SRGC + (size_t)((n * 2 + l) * 3 + k) * DM + ch0 + lane] = bf2f(RX[(size_t)(MP + n * TS + 5 + k) * DM + ch0 + lane]); }
        }
    }
}

__device__ __forceinline__ void rg_unit_sp(const Frame& F, const Args& A, int l, int s, int c, int h) {
    constexpr int MODE = 0; constexpr bool sample = false;
    unsigned char* ws = A.ws;
    LAS float* TAB = (LAS float*)(F.lds + F.wave * 15360);
    LAS float* XC = TAB + 512;
    LAS float* AA = XC + 16 * 68;
    LAS float* BB = AA + 16 * 68;
    const int lane = F.lane, fr = lane & 15, fq = lane >> 4, ch0 = 64 * h;
    const bf16* RX = (const bf16*)(ws + WS_RX); bf16* RY = (bf16*)(ws + WS_RY);
    {
        const int chg = l * DM + ch0 + lane;
#pragma unroll
        for (int j = 0; j < 4; ++j) TAB[j * 64 + lane] = A.in[15][(size_t)(l * 4 + j) * DM + ch0 + lane];
        TAB[4 * 64 + lane] = A.in[16][chg]; TAB[5 * 64 + lane] = A.in[18][chg]; TAB[6 * 64 + lane] = A.in[20][chg];
        const float lam = A.in[21][chg]; TAB[7 * 64 + lane] = -8.f * 1.44269504f * log1pf(expf(-lam));
    }
    bf16x8 Wf[2][4][2];
    { const bf16* WG = (const bf16*)(ws + WS_SMALL + SM_WG);
#pragma unroll
      for (int g = 0; g < 2; ++g)
#pragma unroll
        for (int n = 0; n < 4; ++n)
#pragma unroll
            for (int k = 0; k < 2; ++k) Wf[g][n][k] = *(const bf16x8*)(WG + ((h * 2 + g) * 64 + 16 * n + fr) * 64 + 32 * k + 8 * fq); }
    LDS_WAIT(); asm volatile("" ::: "memory");
    const int rbase = s * TP + c * TC;
    bf16* XQ = (bf16*)(ws + WS_XN);
    float hst = 0.f, aprod = 1.f;
    if (MODE == 1 && !sample) {
        const float* AG = (const float*)(ws + WS_AGGRG) + ((size_t)(s * NCH) * DM + ch0 + lane) * 2;
        for (int cc = 0; cc < c; ++cc) { const float a = AG[(size_t)cc * DM * 2], b = AG[(size_t)cc * DM * 2 + 1]; hst = a * hst + b; }
    }
    v4u nx[2][4]; unsigned short nry[16];
#define RG_LOAD_RX(tl) do { const int row_ = rbase + 16 * (tl) + fr, t_ = c * TC + 16 * (tl) + fr; \
        _Pragma("unroll") for (int k = 0; k < 2; ++k) _Pragma("unroll") for (int d = 0; d < 4; ++d) nx[k][d] = *(const v4u*)(RX + (size_t)(t_ - d >= 0 ? row_ - d : row_) * DM + ch0 + 32 * k + 8 * fq); } while (0)
#define RG_LOAD_RY(tl) do { _Pragma("unroll") for (int tt = 0; tt < 16; ++tt) nry[tt] = RY[(size_t)(rbase + 16 * (tl) + tt) * DM + ch0 + lane]; } while (0)
    RG_LOAD_RX(0); RG_LOAD_RY(0);
#pragma unroll 1
    for (int tile = 0; tile < 8; ++tile) {
        const int row = rbase + 16 * tile + fr;
        const int t = c * TC + 16 * tile + fr;
        const int sq = sample ? s * 16 + tile * 2 + (fr >> 3) : s;
        bf16x8 X[2];
#pragma unroll
        for (int k = 0; k < 2; ++k) {
            const int cl = 32 * k + 8 * fq; float xc[8];
            { const f32x4 b0 = *(const LAS f32x4*)(TAB + 4 * 64 + cl), b1 = *(const LAS f32x4*)(TAB + 4 * 64 + cl + 4); xc[0] = b0.x; xc[1] = b0.y; xc[2] = b0.z; xc[3] = b0.w; xc[4] = b1.x; xc[5] = b1.y; xc[6] = b1.z; xc[7] = b1.w; }
#pragma unroll
            for (int d = 0; d < 4; ++d) {
                float v[8];
                { v4u w_ = nx[k][d]; if (t - d < 0) w_ = (v4u){0u, 0u, 0u, 0u}; cvt8(w_, v); }
                const f32x4 w0 = *(const LAS f32x4*)(TAB + (3 - d) * 64 + cl), w1 = *(const LAS f32x4*)(TAB + (3 - d) * 64 + cl + 4);
                xc[0] += w0.x * v[0]; xc[1] += w0.y * v[1]; xc[2] += w0.z * v[2]; xc[3] += w0.w * v[3]; xc[4] += w1.x * v[4]; xc[5] += w1.y * v[5]; xc[6] += w1.z * v[6]; xc[7] += w1.w * v[7];
            }
            *(LAS f32x4*)(XC + fr * 68 + cl) = (f32x4){xc[0], xc[1], xc[2], xc[3]}; *(LAS f32x4*)(XC + fr * 68 + cl + 4) = (f32x4){xc[4], xc[5], xc[6], xc[7]};
            v4u pk; pk.x = pk2(xc[0], xc[1]); pk.y = pk2(xc[2], xc[3]); pk.z = pk2(xc[4], xc[5]); pk.w = pk2(xc[6], xc[7]);
            X[k] = __builtin_bit_cast(bf16x8, pk);
        }
        if (tile < 7) RG_LOAD_RX(tile + 1);
        f32x4 acc[2][4];
#pragma unroll
        for (int g = 0; g < 2; ++g)
#pragma unroll
            for (int n = 0; n < 4; ++n) { acc[g][n] = (f32x4){0.f, 0.f, 0.f, 0.f};
#pragma unroll
                for (int k = 0; k < 2; ++k) acc[g][n] = __builtin_amdgcn_mfma_f32_16x16x32_bf16(Wf[g][n][k], X[k], acc[g][n], 0, 0, 0); }
        LDS_WAIT(); asm volatile("" ::: "memory");
#pragma unroll
        for (int n = 0; n < 4; ++n) { const int cl = 16 * n + 4 * fq;
            const f32x4 xv = *(const LAS f32x4*)(XC + fr * 68 + cl), ba = *(const LAS f32x4*)(TAB + 5 * 64 + cl), bx = *(const LAS f32x4*)(TAB + 6 * 64 + cl), c8 = *(const LAS f32x4*)(TAB + 7 * 64 + cl);
            f32x4 av, bv;
#pragma unroll
            for (int j = 0; j < 4; ++j) { const float r = fsig(acc[0][n][j] + ba[j]), ig = fsig(acc[1][n][j] + bx[j]); const float a = __builtin_amdgcn_exp2f(r * c8[j]);
                av[j] = a; bv[j] = __builtin_amdgcn_sqrtf(fmaxf(1.f - a * a, 0.f)) * ig * xv[j]; }
            *(LAS f32x4*)(AA + fr * 68 + cl) = av; *(LAS f32x4*)(BB + fr * 68 + cl) = bv; }
        LDS_WAIT(); asm volatile("" ::: "memory");
#pragma unroll
        for (int tt = 0; tt < 16; ++tt) {
            const float a = AA[tt * 68 + lane], b = BB[tt * 68 + lane];
            hst = a * hst + b; aprod *= a;
            const float g = fgelu(bf2f(nry[tt]));
            const size_t o = (size_t)(rbase + 16 * tile + tt) * DM + ch0 + lane; const unsigned pq = pk2(hst * g, aprod * g); RY[o] = (bf16)(pq & 0xffffu); XQ[o] = (bf16)(pq >> 16);
        }
        if (tile < 7) RG_LOAD_RY(tile + 1);
        LDS_WAIT(); asm volatile("" ::: "memory");
    }
    unsigned long long* AGT = (unsigned long long*)(ws + WS_AGT) + ((size_t)(l * 128 + s * 16 + h) * 16) * 64 + lane;
    __hip_atomic_store(AGT + (size_t)c * 64, ((unsigned long long)__float_as_uint(hst) << 32) | __float_as_uint(fmaxf(aprod, 1e-30f)), __ATOMIC_RELAXED, __HIP_MEMORY_SCOPE_AGENT);
}
__device__ __forceinline__ void rg_unit_sp2(const Frame& F, const Args& A, int l, int s, int c, int h) {
    unsigned char* ws = A.ws;
    const int lane = F.lane, ch0 = 64 * h;
    const bf16* RX = (const bf16*)(ws + WS_RX); bf16* RY = (bf16*)(ws + WS_RY); bf16* XQ = (bf16*)(ws + WS_XN);
    const int rbase = s * TP + c * TC;
    unsigned long long* AGT = (unsigned long long*)(ws + WS_AGT) + ((size_t)(l * 128 + s * 16 + h) * 16) * 64 + lane;
    float hst, aprod; { const unsigned long long v = __hip_atomic_load(AGT + (size_t)c * 64, __ATOMIC_RELAXED, __HIP_MEMORY_SCOPE_AGENT); aprod = __uint_as_float((unsigned)v); hst = __uint_as_float((unsigned)(v >> 32)); }
    float hin = 0.f;
    {   unsigned long long av[NCH - 1];
#pragma unroll
        for (int cc = 0; cc < NCH - 1; ++cc) av[cc] = (cc < c) ? __hip_atomic_load(AGT + (size_t)cc * 64, __ATOMIC_RELAXED, __HIP_MEMORY_SCOPE_AGENT) : 0ull;
#pragma unroll
        for (int cc = 0; cc < NCH - 1; ++cc) if (cc < c) {
            unsigned long long v = av[cc]; unsigned sp_ = 0;
            while (!(__uint_as_float((unsigned)v) > 0.f) && sp_ < (1u << 22)) { __builtin_amdgcn_s_sleep(2); v = __hip_atomic_load(AGT + (size_t)cc * 64, __ATOMIC_RELAXED, __HIP_MEMORY_SCOPE_AGENT); ++sp_; }
            hin = __uint_as_float((unsigned)v) * hin + __uint_as_float((unsigned)(v >> 32));
        } }
    if (c > 0) {
        asm volatile("s_waitcnt vmcnt(0)" ::: "memory");
#pragma unroll 1
        for (int tile = 0; tile < 8; ++tile) {
            unsigned short pv[16], qv[16];
#pragma unroll
            for (int tt = 0; tt < 16; ++tt) { const size_t o = (size_t)(rbase + 16 * tile + tt) * DM + ch0 + lane; pv[tt] = RY[o]; qv[tt] = XQ[o]; }
#pragma unroll
            for (int tt = 0; tt < 16; ++tt) RY[(size_t)(rbase + 16 * tile + tt) * DM + ch0 + lane] = (bf16)f2bf(bf2f(pv[tt]) + bf2f(qv[tt]) * hin);
        }
    }
    if (c == NCH - 1) {
        A.out[O_PRGH + (size_t)(s * 2 + l) * DM + ch0 + lane] = hst + aprod * hin;
#pragma unroll
        for (int k = 0; k < 3; ++k) A.out[O_PRGC + (size_t)((s * 2 + l) * 3 + k) * DM + ch0 + lane] = bf2f(RX[(size_t)(s * TP + TP - 3 + k) * DM + ch0 + lane]);
    }
}

template <int MODE> __device__ __forceinline__ void s5_unit(const Frame& F, const Args& A, int l, bool sample, int s, int c, int g) {
    unsigned char* ws = A.ws;
    LAS float* BU = (LAS float*)(F.lds + F.wave * 15360);
    LAS bf16* XS = (LAS bf16*)(F.lds + F.wave * 15360 + 16 * 132 * 4);
    const int lane = F.lane, fr = lane & 15, fq = lane >> 4;
    bf16* SX = (bf16*)(ws + WS_SX);
    bf16x8 Bf[8], Cf[4];
    { const bf16* BBm = (const bf16*)(ws + WS_SMALL + SM_BBAR) + (size_t)g * 128 * 16;
#pragma unroll
      for (int n = 0; n < 8; ++n) { v4u z = {0u, 0u, 0u, 0u}; if (fq < 2) z = *(const v4u*)(BBm + (16 * n + fr) * 16 + 8 * fq); Bf[n] = __builtin_bit_cast(bf16x8, z); }
      const bf16* CM = (const bf16*)(ws + WS_SMALL + SM_CMAT) + (size_t)g * 16 * 128;
#pragma unroll
      for (int kk = 0; kk < 4; ++kk) Cf[kk] = *(const bf16x8*)(CM + fr * 128 + 32 * kk + 8 * fq); }
    const float ar = ((const float*)(ws + WS_SMALL + SM_ABAR))[(g * 64 + lane) * 2], ai = ((const float*)(ws + WS_SMALL + SM_ABAR))[(g * 64 + lane) * 2 + 1];
    const f32x4 dv = *(const f32x4*)(A.in[28] + l * 512 + 16 * g + 4 * fq);
    const int rbase = sample ? MP + s * 32 : s * TP + c * TC;
    float xr = 0.f, xi = 0.f;
    if (MODE == 1 && !sample) {
        const float tr = ((const float*)(ws + WS_SMALL + SM_ABARTC))[(g * 64 + lane) * 2], ti = ((const float*)(ws + WS_SMALL + SM_ABARTC))[(g * 64 + lane) * 2 + 1];
        const float* AG = (const float*)(ws + WS_AGGS5) + ((size_t)(s * NCH) * 2048 + g * 64 + lane) * 2;
        f32x2 ag[NCH - 1];
#pragma unroll
        for (int cc = 0; cc < NCH - 1; ++cc) ag[cc] = (cc < c) ? *(const f32x2*)(AG + (size_t)cc * 4096) : (f32x2){0.f, 0.f};
#pragma unroll
        for (int cc = 0; cc < NCH - 1; ++cc) if (cc < c) { const float nr = tr * xr - ti * xi + ag[cc].x, ni = tr * xi + ti * xr + ag[cc].y; xr = nr; xi = ni; }
    }
    const int ntile = sample ? 2 : 8;
#define S5_BU(uz_) do { const bf16x8 U_ = __builtin_bit_cast(bf16x8, uz_); _Pragma("unroll") for (int n = 0; n < 8; ++n) { \
        f32x4 a_ = __builtin_amdgcn_mfma_f32_16x16x32_bf16(Bf[n], U_, (f32x4){0.f, 0.f, 0.f, 0.f}, 0, 0, 0); *(LAS f32x4*)(BU + fr * 132 + 16 * n + 4 * fq) = a_; } } while (0)
    v4u un = {0u, 0u, 0u, 0u}; u32x2 sxc = {0u, 0u};
    { v4u u0 = {0u, 0u, 0u, 0u}; if (fq < 2) u0 = *(const v4u*)(SX + (size_t)(rbase + fr) * 512 + 16 * g + 8 * fq);
      if (fq < 2) un = *(const v4u*)(SX + (size_t)(rbase + 16 + fr) * 512 + 16 * g + 8 * fq);
      if (MODE == 1) sxc = *(const u32x2*)(SX + (size_t)(rbase + fr) * 512 + 16 * g + 4 * fq);
      S5_BU(u0); }
#pragma unroll 1
    for (int tile = 0; tile < ntile; ++tile) {
        const int row = rbase + 16 * tile + fr;
        LDS_WAIT(); asm volatile("" ::: "memory");
        float br[16], bi[16];
#pragma unroll
        for (int tt = 0; tt < 16; ++tt) { br[tt] = BU[tt * 132 + lane]; bi[tt] = BU[tt * 132 + 64 + lane]; }
        u32x2 sxn = {0u, 0u};
        if (tile + 1 < ntile) {
            S5_BU(un);
            if (tile + 2 < ntile && fq < 2) un = *(const v4u*)(SX + (size_t)(row + 32) * 512 + 16 * g + 8 * fq);
            if (MODE == 1) sxn = *(const u32x2*)(SX + (size_t)(row + 16) * 512 + 16 * g + 4 * fq);
        }
#pragma unroll
        for (int tt = 0; tt < 16; ++tt) {
            if (sample && (tt & 7) == 0) { const size_t si = ((size_t)((s * 4 + tile * 2 + (tt >> 3)) * 2 + l) * 32 + g) * 64 + lane; xr = A.in[4][si]; xi = A.in[5][si]; }
            const float nr = ar * xr - ai * xi + br[tt], ni = ar * xi + ai * xr + bi[tt]; xr = nr; xi = ni;
            if (MODE == 1) { const unsigned xx = pk2(xr, xi); XS[tt * 136 + lane] = (bf16)(xx & 0xffffu); XS[tt * 136 + 64 + lane] = (bf16)(xx >> 16); }
            if (MODE == 1 && sample && (tt & 7) == 7) { const size_t si = ((size_t)((s * 4 + tile * 2 + (tt >> 3)) * 2 + l) * 32 + g) * 64 + lane; A.out[O_SS5R + si] = xr; A.out[O_SS5I + si] = xi; }
        }
        if (MODE == 1) {
            LDS_WAIT(); asm volatile("" ::: "memory");
            f32x4 y = {0.f, 0.f, 0.f, 0.f};
#pragma unroll
            for (int kk = 0; kk < 4; ++kk) { const bf16x8 xb = *(const LAS bf16x8*)(XS + fr * 136 + 32 * kk + 8 * fq); y = __builtin_amdgcn_mfma_f32_16x16x32_bf16(Cf[kk], xb, y, 0, 0, 0); }
            bf16* p = SX + (size_t)row * 512 + 16 * g + 4 * fq; const u32x2 sx = sxc;
            u32x2 o; o.x = pk2(fgelu(y.x + dv.x * bflo(sx.x)), fgelu(y.y + dv.y * bfhi(sx.x))); o.y = pk2(fgelu(y.z + dv.z * bflo(sx.y)), fgelu(y.w + dv.w * bfhi(sx.y)));
            *(u32x2*)p = o;
        }
        sxc = sxn;
    }
    LDS_WAIT(); asm volatile("" ::: "memory");
#undef S5_BU
    if (MODE == 0) { float* AG = (float*)(ws + WS_AGGS5) + ((size_t)(s * NCH + c) * 2048 + g * 64 + lane) * 2; AG[0] = xr; AG[1] = xi; }
    if (MODE == 1 && !sample && c == NCH - 1) { const size_t si = ((size_t)(s * 2 + l) * 32 + g) * 64 + lane; A.out[O_PS5R + si] = xr; A.out[O_PS5I + si] = xi; }
}

template <int MODE> __device__ __forceinline__ void mixer_phase(const Frame& F0, const Args& A, int l, int qi, int b0) {
    const Frame F = refresh(F0);
    int bx_ = blockIdx.x; asm volatile("" : "+s"(bx_)); if (bx_ < b0) return;
    gu32* q = F.ctl + CW_Q + 64 * qi;
    constexpr int N_A = MODE == 0 ? 2048 : NSP * NCH * 32, N_B = MODE == 0 ? 32 * 16 : 32 * 32, N_C = MODE == 0 ? NSP * (NCH - 1) * 32 : 0;
    constexpr int NTOT = N_A + N_B + N_C;
    (void)q;
    const int nb_ = F.G - b0, bl_ = bx_ - b0, vb_ = (nb_ % 8 == 0) ? (bl_ % 8) * (nb_ / 8) + bl_ / 8 : bl_, gw = F.wave * nb_ + vb_, NGW = nb_ * NWAVES;
    for (int u0 = gw; u0 < NTOT; u0 += NGW) {
        int u = u0;
        if (MODE == 0) {
            if (u < N_A) { const int c = u >> 7, sh = u & 127; rg_unit_sp(F, A, l, sh >> 4, c, sh & 15); continue; } u -= N_A;
            if (u < N_B) { rg_unit<1>(F, A, l, true, u >> 4, 0, u & 15); continue; } u -= N_B;
            { const int g = u & 31, r = u >> 5, c = r % (NCH - 1), s2 = r / (NCH - 1); s5_unit<0>(F, A, l, false, s2, c, g); }
        } else {
            if (u < N_A) { const int g = u & 31, r = u >> 5, c = r % NCH, s2 = r / NCH; s5_unit<1>(F, A, l, false, s2, c, g); continue; } u -= N_A;
            s5_unit<1>(F, A, l, true, u >> 5, 0, u & 31);
        }
    }
    if (MODE == 0 && gw < N_A) { const int c = gw >> 7, sh = gw & 127; rg_unit_sp2(F, A, l, sh >> 4, c, sh & 15); }
}

__device__ __forceinline__ void ffn_fixup_local(const Frame& F0, const Args& A, int l, int pm) {
    const Frame F = refresh(F0);
    if (pm < 64 && (pm & 7) != 0) {
        const float* HALO = (const float*)(A.ws + WS_HALO); bf16* HF = (bf16*)(A.ws + WS_HFF);
        const float* cw = A.in[34] + (size_t)l * 3 * FF2; const float* cb = A.in[35] + (size_t)l * FF2;
        for (int c = F.tid; c < FF; c += NWAVES * 64) {
            float uc0[2], uc1[2];
#pragma unroll
            for (int bj = 0; bj < 2; ++bj) {
                const float a254 = HALO[((size_t)((pm - 1) * 4 + 0) * 2 + bj) * FF + c], a255 = HALO[((size_t)((pm - 1) * 4 + 1) * 2 + bj) * FF + c];
                const float r0 = HALO[((size_t)(pm * 4 + 2) * 2 + bj) * FF + c], r1 = HALO[((size_t)(pm * 4 + 3) * 2 + bj) * FF + c];
                const float w0 = cw[bj * FF + c], w1 = cw[FF2 + bj * FF + c], w2 = cw[2 * FF2 + bj * FF + c], b = cb[bj * FF + c];
                uc0[bj] = b + w0 * a254 + w1 * a255 + w2 * r0; uc1[bj] = b + w0 * a255 + w1 * r0 + w2 * r1;
            }
            HF[(size_t)(pm * 256) * FF + c] = (bf16)f2bf(fgelu(uc0[0]) * uc0[1]); HF[(size_t)(pm * 256 + 1) * FF + c] = (bf16)f2bf(fgelu(uc1[0]) * uc1[1]);
        }
    }
    asm volatile("s_waitcnt vmcnt(0)" ::: "memory"); __syncthreads();
}

__global__ void __launch_bounds__(NWAVES * 64, 2) hawk_fwd(Args args) {
    extern __shared__ __attribute__((aligned(16))) unsigned char lds[];
    Frame F;
    F.lds = (LAS unsigned char*)lds;
    F.MISC = (volatile LAS unsigned*)(F.lds + MISC_OFF);
    F.tid = threadIdx.x; F.lane = F.tid & 63; F.wave = __builtin_amdgcn_readfirstlane(F.tid >> 6);
    F.G = gridDim.x; { const int bx = blockIdx.x; F.vcu = (F.G % 8 == 0) ? (bx % 8) * (F.G / 8) + bx / 8 : bx; }
    unsigned char* ws = args.ws;
    F.ctl = (gu32*)(ws + WS_CTL);
    for (int u = F.tid; u < (LDS_BYTES - LDSCTL_OFF) / 4; u += NWAVES * 64) ((LAS unsigned*)(F.lds + LDSCTL_OFF))[u] = 0u;
    __syncthreads();
    XcdBarrier bar = xcd_barrier_post((unsigned*)(F.ctl + CW_BAR), F.MISC + 8);
#define GRID_BAR() xcd_barrier(bar)

#pragma unroll 1
    for (int st = 0; st < NST_MAX; ++st) {
        unsigned char* ws = args.ws; float* outp = args.out; asm volatile("" : "+s"(ws), "+s"(outp));
        bf16* XRB = (bf16*)(ws + WS_XRB); float* MOD = (float*)(ws + WS_MOD); bf16* XN = (bf16*)(ws + WS_XN); int bid = (int)blockIdx.x; asm volatile("" : "+s"(bid));
        const int l = st < 2 ? 0 : (st - 2) / 10, sub = st < 2 ? st - 2 : (st == 22 ? 99 : (st - 2) % 10);
        const int ll = st == 22 ? 1 : l;
        const float* xin_p = ll == 0 ? args.in[0] : nullptr; const float* xin_s = ll == 0 ? args.in[1] - (size_t)MP * DM : nullptr;
        const float* modl = MOD + ll * 6144;
        bool is_gemm = false; pg8::Gemm g{nullptr, nullptr, 0, 0, 0, 0, 0}; pg8::EpiAny E{0, false, ws, nullptr, nullptr, nullptr, nullptr, 0, ll, (PG8_LAS float*)(F.lds + XCH_OFF)};
        switch (sub) {
            case -1: is_gemm = true; g = pg8::Gemm{(const pg8::bf16_t*)(ws + WS_SILUC), (const pg8::bf16_t*)(ws + WS_WADA), 256, MODW, DM, DM, DM}; E.mode = pg8::EM_ADA; E.perm = false; E.p0 = args.in[10]; E.out = MOD; break;
            case 1: is_gemm = true; g = pg8::Gemm{(const pg8::bf16_t*)XN, (const pg8::bf16_t*)(ws + WS_WIN), MROWS, INW, DM, DM, DM}; E.mode = pg8::EM_IN; E.perm = true; E.p0 = args.in[14] + l * INW; break;
            case 3: case 4: is_gemm = true; g = pg8::Gemm{(const pg8::bf16_t*)(ws + WS_RY), (const pg8::bf16_t*)(ws + WS_WRG), MROWS, DM, DM, DM, DM}; E.mode = pg8::EM_RGP; E.perm = true; break;
            case 5: is_gemm = true; g = pg8::Gemm{(const pg8::bf16_t*)(ws + WS_SX), (const pg8::bf16_t*)(ws + WS_WGLU), MROWS, 2048, 512, 512, 512}; E.mode = pg8::EM_GLU; E.perm = true; break;
            case 6: is_gemm = true; g = pg8::Gemm{(const pg8::bf16_t*)(ws + WS_GA), (const pg8::bf16_t*)(ws + WS_WOUT), MROWS, DM, DM, DM, DM}; E.mode = pg8::EM_RES; E.perm = true; E.p0 = xin_p; E.p2 = modl + 2048; E.row_off = 0; break;
            case 8: is_gemm = true; g = pg8::Gemm{(const pg8::bf16_t*)XN, (const pg8::bf16_t*)(ws + WS_WUP), MROWS, FF2, DM, DM, DM}; E.mode = pg8::EM_UPF; E.perm = true; E.p0 = args.in[34] + (size_t)l * 3 * FF2; E.p1 = args.in[35] + (size_t)l * FF2; E.p2 = args.in[6]; E.out = outp; break;
            case 9: is_gemm = true; g = pg8::Gemm{(const pg8::bf16_t*)(ws + WS_HFF), (const pg8::bf16_t*)(ws + WS_WDOWN), MROWS, DM, FF, FF, FF}; E.mode = pg8::EM_RES; E.perm = true; E.p0 = nullptr; E.p2 = modl + 5120; E.row_off = 1; break;
            default: break;
        }
#ifndef DUP
#define DUP 0
#endif
        const int nrep = (DUP == 1 && sub == 2) || (DUP == 2 && (st == 0 || (sub == 0 && l == 1))) || (DUP == 3 && sub == 8) || (DUP == 4 && (sub == 0 || sub == 7)) || (DUP == 5 && sub == 1) || (DUP == 6 && sub == 6 && l == 0) || (DUP == 7 && ((sub == 0 && l == 0 && st >= 2) || sub == 9)) ? 2 : 1;
#pragma unroll 1
        for (int rep = 0; rep < nrep; ++rep) {
        if (rep == 1) GRID_BAR();
        if (st < 2 || (sub == 0 && l == 1)) p0_weights(F, args, l, st == 0 ? 0 : 1, st == 1 ? 48 : 0, st == 1 ? F.G - 48 : F.G);
        if (sub == 0 || sub == 7) norm_rows(F, sub == 0 ? xin_p : nullptr, sub == 0 ? xin_s : nullptr, XRB, (sub == 0 ? args.in[11] : args.in[12]) + l * DM, modl + (sub == 0 ? 0 : 3072), modl + (sub == 0 ? 1024 : 4096), XN,
                                            sub == 7 ? 4 : (l == 1 ? 12 : 0), sub == 7 ? modl + 2048 : MOD + 5120, (const float*)(ws + (sub == 7 ? WS_PART_OUT : WS_PART_DOWN)));
        if (sub == 2) mixer_phase<0>(F, args, l, l * 2 + rep * 4, 0);
        if (sub == 3) mixer_phase<1>(F, args, l, l * 2 + 1, 16);
        if (is_gemm) { pg8::SplitOrder S; S.init(g.M, g.N, g.K, F.G, bid, (sub == 6 || sub == 9) ? 1 : (sub == 4 ? 2 : (sub == 3 ? 3 : 0)), 256);
            if (sub == 9) { pg8::Unit u0; ffn_fixup_local(F, args, l, S.next(0, u0) ? u0.pm : 64); } pg8::gemm_phase<pg8::EpiAny, pg8::SplitOrder, true, true>(F.lds, g, S, E); }
        }
        if (sub == 99) final_norm(F, XRB, outp + O_Y, args.in[37], 12, MOD + 6144 + 5120, (const float*)(ws + WS_PART_DOWN)); else GRID_BAR();
    }
}

extern "C" void kernel_launch(void* const* d_in, const int* in_sizes, int n_in, void* d_out, int out_size, void* d_ws, size_t ws_size, hipStream_t stream) {
    static int grid = 0;
    if (grid == 0) {
        if (n_in != 38 || out_size != 23396352 || ws_size < WS_END) { fprintf(stderr, "kernel_launch: unexpected shapes (n_in %d out %d ws %zu)\n", n_in, out_size, ws_size); grid = -1; return; }
        int dev = 0, cus = 0, per_cu = 0;
        if (hipGetDevice(&dev) != hipSuccess || hipDeviceGetAttribute(&cus, hipDeviceAttributeMultiprocessorCount, dev) != hipSuccess) { grid = -1; return; }
        if (hipFuncSetAttribute((const void*)hawk_fwd, hipFuncAttributeMaxDynamicSharedMemorySize, LDS_BYTES) != hipSuccess) { fprintf(stderr, "kernel_launch: hipFuncSetAttribute failed\n"); grid = -1; return; }
        if (hipOccupancyMaxActiveBlocksPerMultiprocessor(&per_cu, (const void*)hawk_fwd, NWAVES * 64, LDS_BYTES) != hipSuccess || per_cu < 1) { fprintf(stderr, "kernel_launch: occupancy query says %d\n", per_cu); per_cu = 1; }
        (void)hipGetLastError();
        grid = cus;
    }
    if (grid < 0) return;
    if (hipMemsetAsync((char*)d_ws + WS_CTL, 0, CTL_ZERO_BYTES, stream) != hipSuccess) { fprintf(stderr, "kernel_launch: memset failed\n"); return; }
    if (hipMemsetAsync((char*)d_ws + WS_AGT, 0, 2 * MiB, stream) != hipSuccess) { fprintf(stderr, "kernel_launch: memset 2 failed\n"); return; }
    Args a{};
    for (int i = 0; i < 38; ++i) a.in[i] = (const float*)d_in[i];
    a.out = (float*)d_out; a.ws = (unsigned char*)d_ws;
    hipLaunchKernelGGL(hawk_fwd, dim3(grid), dim3(NWAVES * 64), LDS_BYTES, stream, a);
}
```

```cpp
#include <hip/hip_runtime.h>
#include <cstdio>
#include <cstdint>
namespace pg8 {
#define PG8_LAS __attribute__((address_space(3)))
typedef unsigned short bf16_t;
typedef short bf16x8 __attribute__((ext_vector_type(8)));
typedef float f32x4 __attribute__((ext_vector_type(4)));
typedef unsigned u32x4 __attribute__((ext_vector_type(4)));
constexpr int BM = 256, BK = 64, HALF = 128, HTB = HALF * BK * 2  , STAGE_BYTES = 8 * HTB, NXCD = 8, WGM = 8;

__host__ __device__ __forceinline__ int lds_byte(int r, int c) { const int st = (r >> 4) * 2 + (c >> 5), rr = r & 15, cc = c & 31, ob = rr * 64 + cc * 2; return st * 1024 + (ob ^ (((ob >> 9) & 1) << 5)); }
__host__ __device__ __forceinline__ void stage_rc(int b, int& R, int& C) { const int st = b / 1024, sb = b % 1024, swz = sb ^ (((sb >> 9) & 1) << 5); R = (st >> 1) * 16 + swz / 64; C = (st & 1) * 32 + (swz % 64) / 2; }
__host__ __device__ __forceinline__ int perm32(int rho) { const int n = rho >> 4, i = rho & 15; return 8 * (i >> 2) + 4 * n + (i & 3); }

struct Unit { int pm, pn, koff, nt, mini, ksl; };
struct Gemm { const bf16_t* A; const bf16_t* Bt; int M, N, K, lda, ldb; };

struct StaticOrder {
    int nM, nN, nwg, G, c, ntK;
    __host__ __device__ void init(int M, int N, int G_, int c_, int K_ = 128) { nM = M / BM; nN = N / BM; nwg = nM * nN; G = G_; c = c_; ntK = K_ / BK; }
    __host__ __device__ bool next(int i, Unit& u) const {
        const long L = (long)i * G + c; if (L >= nwg) return false;
        int wgid = (int)L; { const int q = nwg / NXCD, r = nwg % NXCD, xcd = wgid % NXCD, off = wgid / NXCD; wgid = (xcd < r ? xcd * (q + 1) : r * (q + 1) + (xcd - r) * q) + off; }
        const int nig = WGM * nN, gid = wgid / nig, fm = gid * WGM, gsz = (nM - fm) < WGM ? (nM - fm) : WGM;
        u.pm = fm + ((wgid % nig) % gsz); u.pn = (wgid % nig) / gsz; u.koff = 0; u.nt = ntK; u.mini = 0; u.ksl = 256; return true;
    }
    __device__ __forceinline__ void a_ready(const Unit&) const {}
    __device__ __forceinline__ void done(const Unit&) const {}
};
struct SplitOrder {
    StaticOrder so; int nslice, nmini, rounds, smode, ksl;
    __device__ void init(int M, int N, int K, int G_, int c_, int smode_, int ksl_) { smode = smode_; ksl = ksl_; so.init(smode_ == 0 ? M : 16384, N, G_, c_, K); nslice = K / ksl_; nmini = smode_ == 1 ? 4 * (N / BM) * nslice : 0; rounds = (so.nwg + G_ - 1) / G_; }
    __device__ bool next(int i, Unit& u) const {
        const long L = (long)i * so.G + so.c;
        if (smode == 3) { if (L >= 4 * so.nN) return false; u.pm = 64 + (int)L / so.nN; u.pn = (int)L % so.nN; u.koff = 0; u.nt = so.ntK; u.mini = 0; u.ksl = 256; return true; }
        if (L < so.nwg) return so.next(i, u);
        const int mm = (int)(L - so.nwg);
        if (mm >= nmini) return false;
        const int kc = mm % nslice, t16 = mm / nslice; u.pm = 64 + t16 / so.nN; u.pn = t16 % so.nN; u.koff = kc * ksl; u.nt = ksl / BK; u.mini = 1; u.ksl = ksl; return true;
    }
    __device__ __forceinline__ void a_ready(const Unit&) const {}
    __device__ __forceinline__ void done(const Unit&) const {}
};


__device__ __forceinline__ unsigned cvt_pk_bf16(float lo, float hi) { unsigned r; asm volatile("v_cvt_pk_bf16_f32 %0, %1, %2" : "=v"(r) : "v"(lo), "v"(hi)); return r; }
typedef float f32x2 __attribute__((ext_vector_type(2)));
__device__ __forceinline__ f32x2 gelu_pk(f32x2 v) {
    const f32x2 av = __builtin_elementwise_abs(v), d = av * 0.2316418882f + 1.0f;
    f32x2 t; t.x = __builtin_amdgcn_rcpf(d.x); t.y = __builtin_amdgcn_rcpf(d.y);
    f32x2 q = t * 0.5307027145f + (-0.7265760135f); q = q * t + 0.7107068705f; q = q * t + (-0.142248368f); q = q * t + 0.127414796f; q = q * t;
    const f32x2 s = (v * v) * (-0.72134752044f);
    f32x2 e; e.x = __builtin_amdgcn_exp2f(s.x); e.y = __builtin_amdgcn_exp2f(s.y);
    const f32x2 m = v * (q * e), r = v - m;
    f32x2 o; o.x = v.x < 0.f ? m.x : r.x; o.y = v.y < 0.f ? m.y : r.y; return o;
}

template <int ACT  > struct EpiBf16 {
    static constexpr bool PERM = true, AFTER_DRAIN = false; static_assert(ACT == 0 || ACT == 1, "EpiBf16: ACT is 0 (none) or 1 (gelu_pk)");
    bf16_t* O; int ldc; const float* bias; int split_cols; size_t split_stride; float scale0;
    __device__ __forceinline__ void operator()(const f32x4 (&acc)[2][2][4][2], const Unit& u, int wr, int wc, int fr, int fq) const {
        const int row0 = u.pm * BM + wr * 64 + fr; int colt = u.pn * BM; bf16_t* base = O;
        float sc = 1.f; if (split_cols) { const int t = colt / split_cols; base += (size_t)t * split_stride; colt -= t * split_cols; if (t == 0) sc = scale0; }
        const int col0 = colt + wc * 32 + 8 * fq, bcol0 = u.pn * BM + wc * 32 + 8 * fq;
        f32x4 bv[2][2];
#pragma unroll
        for (int bj = 0; bj < 2; ++bj)
#pragma unroll
            for (int n = 0; n < 2; ++n) bv[bj][n] = bias ? *(const f32x4*)(bias + bcol0 + bj * HALF + 4 * n) : (f32x4){0.f, 0.f, 0.f, 0.f};
#pragma unroll
        for (int ai = 0; ai < 2; ++ai)
#pragma unroll
            for (int m = 0; m < 4; ++m) { bf16_t* rowp = base + (size_t)(row0 + ai * HALF + m * 16) * ldc + col0;
#pragma unroll
                for (int bj = 0; bj < 2; ++bj) { f32x4 v0 = acc[ai][bj][m][0] + bv[bj][0], v1 = acc[ai][bj][m][1] + bv[bj][1];
                    if (ACT == 1) { f32x2 a = gelu_pk((f32x2){v0[0], v0[1]}), b = gelu_pk((f32x2){v0[2], v0[3]}), c = gelu_pk((f32x2){v1[0], v1[1]}), d = gelu_pk((f32x2){v1[2], v1[3]});
                        v0 = (f32x4){a.x, a.y, b.x, b.y}; v1 = (f32x4){c.x, c.y, d.x, d.y}; }
                    v0 = v0 * sc; v1 = v1 * sc; u32x4 w; w.x = cvt_pk_bf16(v0[0], v0[1]); w.y = cvt_pk_bf16(v0[2], v0[3]); w.z = cvt_pk_bf16(v1[0], v1[1]); w.w = cvt_pk_bf16(v1[2], v1[3]);
                    *(u32x4*)(rowp + bj * HALF) = w; } }
    }
};

template <class Epi, class Sched, bool ALIGN_EPI, bool SP2>
__device__ __forceinline__ void gemm_phase(PG8_LAS unsigned char* lds, const Gemm g, const Sched& S, const Epi& E) {
    int tid_ = threadIdx.x; asm volatile("" : "+v"(tid_));
    const int tid = tid_, wid = __builtin_amdgcn_readfirstlane(tid >> 6), lane = tid & 63, wr = wid >> 2, wc = wid & 3, fr = lane & 15, fq = lane >> 4;
    const int lda = g.lda, ldb = g.ldb;
    unsigned voffA[2], voffB[2];
#pragma unroll
    for (int i = 0; i < 2; ++i) { int R, C; stage_rc(tid * 16 + i * 8192, R, C); const int Rb = E.perm ? ((R & ~31) + perm32(R & 31)) : R;
        voffA[i] = (unsigned)(R * lda + C) * 2u; voffB[i] = (unsigned)(Rb * ldb + C) * 2u; }
    const size_t kstep = (size_t)(BK * 2);
    const size_t hstepA = (size_t)HALF * lda * 2, hstepB = (size_t)HALF * ldb * 2;
    const size_t tstepA = 2 * hstepA, tstepB = 2 * hstepB;
    const unsigned ldsw = (unsigned)wid * 1024u;
    const int aoff = lds_byte(wr * 64 + fr, fq * 8), boff = lds_byte(wc * 32 + fr, fq * 8);
#define PG8_SA(b, h) (((b) * 2 + (h)) * HTB)
#define PG8_SB(b, h) ((4 + (b) * 2 + (h)) * HTB)
#define PG8_STAGE(bufoff, gbase, voff) do { _Pragma("unroll") for (int _i = 0; _i < 2; ++_i) \
        __builtin_amdgcn_global_load_lds((const unsigned*)((const char*)(gbase) + (voff)[_i]), (PG8_LAS unsigned*)(lds + (bufoff) + ldsw + _i * 8192), 16, 0, 0); } while (0)
#define PG8_LDA(dst, b, h) do { _Pragma("unroll") for (int m = 0; m < 4; ++m) _Pragma("unroll") for (int k = 0; k < 2; ++k) dst[m][k] = *(const PG8_LAS bf16x8*)(lds + PG8_SA(b, h) + aoff + m * 2048 + k * 1024); } while (0)
#define PG8_LDB(dst, b, h) do { _Pragma("unroll") for (int n = 0; n < 2; ++n) _Pragma("unroll") for (int k = 0; k < 2; ++k) dst[n][k] = *(const PG8_LAS bf16x8*)(lds + PG8_SB(b, h) + boff + n * 2048 + k * 1024); } while (0)
#define PG8_MMA(ai, bj, At, Bt) do { __builtin_amdgcn_s_setprio(1); _Pragma("unroll") for (int m = 0; m < 4; ++m) _Pragma("unroll") for (int n = 0; n < 2; ++n) _Pragma("unroll") for (int k = 0; k < 2; ++k) \
        acc[ai][bj][m][n] = __builtin_amdgcn_mfma_f32_16x16x32_bf16(Bt[n][k], At[m][k], acc[ai][bj][m][n], 0, 0, 0); __builtin_amdgcn_s_setprio(0); } while (0)
#define PG8_WAIT_V(n) asm volatile("s_waitcnt vmcnt(" #n ")" ::: "memory")
#define PG8_WAIT_L(n) asm volatile("s_waitcnt lgkmcnt(" #n ")" ::: "memory")
#define PG8_BAR __builtin_amdgcn_s_barrier()
#define PG8_SCHED __builtin_amdgcn_sched_barrier(0)
    Unit cur, nxt; int ui = 0;
    if (!S.next(0, cur)) return;
    f32x4 acc[2][2][4][2];
#pragma unroll
    for (int a = 0; a < 2; ++a)
#pragma unroll
        for (int b = 0; b < 2; ++b)
#pragma unroll
            for (int m = 0; m < 4; ++m)
#pragma unroll
                for (int n = 0; n < 2; ++n) acc[a][b][m][n] = (f32x4){0.f, 0.f, 0.f, 0.f};
    bf16x8 At[4][2], B0[2][2], B1[2][2];
    const char* cA = (const char*)g.A + (size_t)cur.pm * tstepA + (size_t)cur.koff * 2; const char* cB = (const char*)g.Bt + (size_t)cur.pn * tstepB + (size_t)cur.koff * 2;
    S.a_ready(cur);
    if constexpr (SP2) {
        PG8_STAGE(PG8_SB(0, 0), cB, voffB); PG8_STAGE(PG8_SB(0, 1), cB + hstepB, voffB); PG8_STAGE(PG8_SA(0, 0), cA, voffA); PG8_STAGE(PG8_SA(0, 1), cA + hstepA, voffA);
        if (wr == 1) PG8_BAR;
        PG8_WAIT_V(2); PG8_BAR;
        PG8_STAGE(PG8_SB(1, 0), cB + kstep, voffB); PG8_STAGE(PG8_SA(1, 0), cA + kstep, voffA); PG8_STAGE(PG8_SB(1, 1), cB + hstepB + kstep, voffB);
        PG8_WAIT_V(6); PG8_BAR;
    } else {
        PG8_STAGE(PG8_SB(0, 0), cB, voffB); PG8_STAGE(PG8_SA(0, 0), cA, voffA); PG8_STAGE(PG8_SB(0, 1), cB + hstepB, voffB); PG8_STAGE(PG8_SA(0, 1), cA + hstepA, voffA);
        if (wr == 1) PG8_BAR;
        PG8_WAIT_V(4); PG8_BAR;
        PG8_STAGE(PG8_SB(1, 0), cB + kstep, voffB); PG8_STAGE(PG8_SA(1, 0), cA + kstep, voffA); PG8_STAGE(PG8_SB(1, 1), cB + hstepB + kstep, voffB);
        PG8_WAIT_V(6); PG8_BAR;
    }
    for (;;) {
        const bool has_next = S.next(ui + 1, nxt);
        const char* nA = has_next ? (const char*)g.A + (size_t)nxt.pm * tstepA + (size_t)nxt.koff * 2 : cA; const char* nB = has_next ? (const char*)g.Bt + (size_t)nxt.pn * tstepB + (size_t)nxt.koff * 2 : cB;
        const int nt = cur.nt;
        for (int t = 0; t < nt; t += 2) {
            const bool last = (t == nt - 2);
            const char* a1 = cA + (size_t)(t + 1) * kstep;
            const char* a2 = last ? nA : cA + (size_t)(t + 2) * kstep; const char* b2 = last ? nB : cB + (size_t)(t + 2) * kstep;
            const char* a3 = a2 + kstep; const char* b3 = b2 + kstep;
            if (last && has_next) S.a_ready(nxt);
            if constexpr (SP2) {
            PG8_LDB(B0, 0, 0); PG8_LDB(B1, 0, 1); PG8_SCHED; PG8_LDA(At, 0, 0); PG8_STAGE(PG8_SA(1, 1), a1 + hstepA, voffA);
            PG8_WAIT_V(8); PG8_WAIT_L(0); PG8_BAR; PG8_MMA(0, 0, At, B0); PG8_MMA(0, 1, At, B1); PG8_BAR; PG8_SCHED;
            PG8_LDA(At, 0, 1); PG8_STAGE(PG8_SB(0, 0), b2, voffB); PG8_STAGE(PG8_SB(0, 1), b2 + hstepB, voffB); PG8_STAGE(PG8_SA(0, 0), a2, voffA);
            PG8_WAIT_V(8); PG8_WAIT_L(0); PG8_BAR; PG8_MMA(1, 0, At, B0); PG8_MMA(1, 1, At, B1); PG8_BAR; PG8_SCHED;
            PG8_LDB(B0, 1, 0); PG8_LDB(B1, 1, 1); PG8_SCHED; PG8_LDA(At, 1, 0); PG8_STAGE(PG8_SA(0, 1), a2 + hstepA, voffA);
            PG8_WAIT_V(8); PG8_WAIT_L(0); PG8_BAR; PG8_MMA(0, 0, At, B0); PG8_MMA(0, 1, At, B1); PG8_BAR; PG8_SCHED;
            PG8_LDA(At, 1, 1); PG8_STAGE(PG8_SB(1, 0), b3, voffB); PG8_STAGE(PG8_SB(1, 1), b3 + hstepB, voffB); PG8_STAGE(PG8_SA(1, 0), a3, voffA);
            PG8_WAIT_V(8); PG8_WAIT_L(0); PG8_BAR; PG8_MMA(1, 0, At, B0); PG8_MMA(1, 1, At, B1); PG8_BAR; PG8_SCHED;
            } else {
            PG8_LDB(B0, 0, 0); PG8_SCHED; PG8_LDA(At, 0, 0); PG8_STAGE(PG8_SA(1, 1), a1 + hstepA, voffA);
            PG8_WAIT_L(8); PG8_BAR; PG8_WAIT_L(0); PG8_MMA(0, 0, At, B0); PG8_BAR; PG8_SCHED;
            PG8_LDB(B1, 0, 1); PG8_STAGE(PG8_SB(0, 0), b2, voffB);
            PG8_BAR; PG8_WAIT_L(0); PG8_MMA(0, 1, At, B1); PG8_BAR;
            PG8_LDA(At, 0, 1); PG8_STAGE(PG8_SA(0, 0), a2, voffA);
            PG8_BAR; PG8_WAIT_L(0); PG8_MMA(1, 0, At, B0); PG8_BAR; PG8_SCHED;
            PG8_STAGE(PG8_SB(0, 1), b2 + hstepB, voffB);
            PG8_WAIT_V(6); PG8_BAR; PG8_MMA(1, 1, At, B1); PG8_BAR;
            PG8_LDB(B0, 1, 0); PG8_SCHED; PG8_LDA(At, 1, 0); PG8_STAGE(PG8_SA(0, 1), a2 + hstepA, voffA);
            PG8_WAIT_L(8); PG8_BAR; PG8_WAIT_L(0); PG8_MMA(0, 0, At, B0); PG8_BAR; PG8_SCHED;
            PG8_LDB(B1, 1, 1); PG8_STAGE(PG8_SB(1, 0), b3, voffB);
            PG8_BAR; PG8_WAIT_L(0); PG8_MMA(0, 1, At, B1); PG8_BAR;
            PG8_LDA(At, 1, 1); PG8_STAGE(PG8_SA(1, 0), a3, voffA);
            PG8_BAR; PG8_WAIT_L(0); PG8_MMA(1, 0, At, B0); PG8_BAR; PG8_SCHED;
            PG8_STAGE(PG8_SB(1, 1), b3 + hstepB, voffB);
            PG8_WAIT_V(6); PG8_BAR; PG8_MMA(1, 1, At, B1); PG8_BAR;
            }
        }
        if constexpr (ALIGN_EPI) { if (wr == 0) PG8_BAR; }
        if constexpr (!Epi::AFTER_DRAIN) { E(acc, cur, wr, wc, fr, fq); S.done(cur); }
        if (!has_next) break;
#pragma unroll
        for (int a = 0; a < 2; ++a)
#pragma unroll
            for (int b = 0; b < 2; ++b)
#pragma unroll
                for (int m = 0; m < 4; ++m)
#pragma unroll
                    for (int n = 0; n < 2; ++n) acc[a][b][m][n] = (f32x4){0.f, 0.f, 0.f, 0.f};
        cur = nxt; cA = nA; cB = nB; ++ui;
        if constexpr (ALIGN_EPI) { if (wr == 1) PG8_BAR; }
    }
    PG8_WAIT_V(0);
    if constexpr (!ALIGN_EPI) { if (wr == 0) PG8_BAR; }
    PG8_BAR;
    if constexpr (Epi::AFTER_DRAIN) { E.fused(acc, cur, wr, wc, fr, fq, lds, wid, lane); S.done(cur); }
#undef PG8_SA
#undef PG8_SB
#undef PG8_STAGE
#undef PG8_LDA
#undef PG8_LDB
#undef PG8_MMA
#undef PG8_WAIT_V
#undef PG8_WAIT_L
#undef PG8_BAR
#undef PG8_SCHED
}
}
#define GAS __attribute__((address_space(1)))
#define LAS __attribute__((address_space(3)))
typedef unsigned short bf16;
typedef unsigned v4u __attribute__((ext_vector_type(4)));
typedef float f32x4 __attribute__((ext_vector_type(4)));
typedef short bf16x8 __attribute__((ext_vector_type(8)));
typedef GAS unsigned gu32;
typedef GAS unsigned long long gu64;
#define RLX_AGENT __ATOMIC_RELAXED, __HIP_MEMORY_SCOPE_AGENT
#define LDS_WAIT() asm volatile("s_waitcnt lgkmcnt(0)" ::: "memory")
#define VM_WAIT() asm volatile("s_waitcnt vmcnt(0)" ::: "memory")
__device__ __forceinline__ unsigned long long rt() { return __builtin_amdgcn_s_memrealtime(); }
__device__ __forceinline__ unsigned pk2(float lo, float hi) { unsigned r; asm("v_cvt_pk_bf16_f32 %0, %1, %2" : "=v"(r) : "v"(lo), "v"(hi)); return r; }
__device__ __forceinline__ unsigned f2bf(float f) { return pk2(f, 0.f) & 0xffffu; }
#define XB_TMO      128
#define XB_XCNT(j)  (256  + 64 * (j))
#define XB_XSUB(j)  (1280 + 64 * (j))
#define XB_XGEN(j)  (2304 + 64 * (j))
#define XB_TOP      3328
#define XB_TOPGEN   3392
#define XCD_BAR_WORDS 3456
#define XB_SPIN_CAP (1u << 18)

__device__ __forceinline__ unsigned xb_ld(unsigned* p)              { return __hip_atomic_load(p, __ATOMIC_RELAXED, __HIP_MEMORY_SCOPE_AGENT); }
__device__ __forceinline__ unsigned xb_add(unsigned* p, unsigned v) { return __hip_atomic_fetch_add(p, v, __ATOMIC_RELAXED, __HIP_MEMORY_SCOPE_AGENT); }
__device__ __forceinline__ unsigned xb_xcc_id() { return (unsigned)__builtin_amdgcn_s_getreg((3 << 11) | 20) & 0xFu; }
#define XB_SPIN(cond, bar) do { unsigned _sp = 0; while (cond) { __builtin_amdgcn_s_sleep(1); \
    if ((++_sp & 255u) == 0u) { if (xb_ld(&(bar)[XB_TMO])) break; if (_sp > XB_SPIN_CAP) { atomicAdd(&(bar)[XB_TMO], 1u); break; } } } } while (0)

struct XcdBarrier {
    unsigned* bar; unsigned x;
    volatile LAS unsigned* st;
};

__device__ __forceinline__ XcdBarrier xcd_barrier_post(unsigned* bar, volatile LAS unsigned* st) {
    XcdBarrier b; b.bar = bar; b.x = xb_xcc_id(); b.st = st;
    if (threadIdx.x == 0) (void)xb_add(&bar[XB_XCNT(b.x)], 1u);
    return b;
}
__device__ __forceinline__ void xcd_barrier_complete(unsigned* bar, unsigned x, unsigned& nloc, unsigned& nx) {
    const unsigned G = gridDim.x * gridDim.y * gridDim.z;
    unsigned sum, cnt, mine, sp = 0u;
    for (;;) {
        sum = 0u; cnt = 0u; mine = 0u;
#pragma unroll
        for (unsigned j = 0; j < 16; ++j) { const unsigned c = xb_ld(&bar[XB_XCNT(j)]); sum += c; cnt += (c > 0u) ? 1u : 0u; mine = (j == x) ? c : mine; }
        if (sum == G) break;
        __builtin_amdgcn_s_sleep(1);
        if ((++sp & 255u) == 0u) { if (xb_ld(&bar[XB_TMO])) break; if (sp > XB_SPIN_CAP) { atomicAdd(&bar[XB_TMO], 1u); break; } }
    }
    nloc = mine > 0u ? mine : 1u; nx = cnt > 0u ? cnt : 1u;
}

__device__ __forceinline__ void xcd_barrier(const XcdBarrier& b) {
    asm volatile("s_waitcnt vmcnt(0)" ::: "memory");
    __syncthreads();
    if (threadIdx.x == 0) {
        unsigned* bar = b.bar;
        __builtin_amdgcn_s_waitcnt(0);
        unsigned nloc = b.st[0], nx = b.st[1];
        if (nloc == 0u) { xcd_barrier_complete(bar, b.x, nloc, nx); b.st[0] = nloc; b.st[1] = nx; }
        const unsigned old = xb_add(&bar[XB_XSUB(b.x)], 1u);
        const unsigned gen = old / nloc;
        if (old + 1u == (gen + 1u) * nloc) {
            __builtin_amdgcn_fence(__ATOMIC_RELEASE, "agent");
            asm volatile("s_waitcnt vmcnt(0)" ::: "memory");
            const unsigned og = xb_add(&bar[XB_TOP], 1u);
            const unsigned tg = og / nx;
            if (og + 1u == (tg + 1u) * nx) xb_add(&bar[XB_TOPGEN], 1u);
            else XB_SPIN(xb_ld(&bar[XB_TOPGEN]) == tg, bar);
            __builtin_amdgcn_fence(__ATOMIC_ACQUIRE, "agent");
            xb_add(&bar[XB_XGEN(b.x)], 1u);
            asm volatile("s_waitcnt vmcnt(0)" ::: "memory");
        } else {
            XB_SPIN(xb_ld(&bar[XB_XGEN(b.x)]) == gen, bar);
            __builtin_amdgcn_fence(__ATOMIC_ACQUIRE, "agent");
            asm volatile("s_waitcnt vmcnt(0)" ::: "memory");
        }
    }
    __syncthreads();
}

constexpr int NWAVES = 8;
#ifndef NST_MAX
#define NST_MAX 23
#endif
constexpr int DM = 1024, MROWS = 17408, MP = 16384, TP = 2048, NSP = 8, NSS = 128, TS = 8;
constexpr int INW = 4608, FF = 3072, FF2 = 6144, NCI = 136, MODW = 12288;
constexpr float EPSN = 1e-6f;
constexpr int TC = 128, NCH = TP / TC;

constexpr size_t MiB = 1u << 20;
constexpr size_t WS_CTL = 0, CTL_ZERO_BYTES = 1 * MiB;
constexpr size_t WS_MOD = 1 * MiB;
constexpr size_t WS_WIN = 8 * MiB, WS_WRG = 17 * MiB, WS_WGLU = 19 * MiB, WS_WOUT = 21 * MiB, WS_WUP = 23 * MiB, WS_WDOWN = 35 * MiB;
constexpr size_t WS_SMALL = 41 * MiB;
constexpr size_t SM_WG = 0, SM_BBAR = 256 * 1024, SM_CMAT = 384 * 1024, SM_ABAR = 512 * 1024, SM_ABARTC = 528 * 1024;
constexpr size_t WS_XN = 42 * MiB;
constexpr size_t WS_XRB = 76 * MiB;
constexpr size_t WS_RX = 110 * MiB, WS_RY = 144 * MiB, WS_SX = 178 * MiB, WS_GA = 195 * MiB, WS_GB = 229 * MiB;
constexpr size_t WS_UPH = 110 * MiB, WS_HFFH = 212 * MiB;
constexpr size_t WS_HFF = 110 * MiB, WS_HALO = 212 * MiB;
constexpr size_t WS_WADA = 110 * MiB, WS_SILUC = 135 * MiB;
constexpr size_t WS_AGGRG = 263 * MiB, WS_AGGS5 = 263 * MiB;
constexpr size_t WS_PART_OUT = 229 * MiB, WS_PART_DOWN = 219 * MiB;
constexpr size_t WS_AGT = 267 * MiB;
constexpr size_t WS_END = 269 * MiB;
constexpr int CW_BAR = 4096, CW_Q = 8192;

constexpr size_t O_Y = 0, O_PRGH = 17825792, O_PRGC = 17842176, O_PS5R = 17891328, O_PS5I = 17924096, O_PFFN = 17956864,
                 O_SRGH = 18153472, O_SRGC = 18415616, O_SS5R = 19202048, O_SS5I = 19726336, O_SFFN = 20250624;

constexpr int RING_BYTES = 131072, LDSCTL_OFF = RING_BYTES, MISC_OFF = LDSCTL_OFF + 320, LDS_BYTES = 147456;
constexpr int XCH_OFF = RING_BYTES + 1024;

typedef float f32x2 __attribute__((ext_vector_type(2)));
typedef unsigned u32x2 __attribute__((ext_vector_type(2)));

struct Args { const float* in[38]; float* out; unsigned char* ws; };

struct Frame { LAS unsigned char* lds; volatile LAS unsigned* MISC; gu32* ctl; int tid, lane, wave, vcu, G; };
__device__ __forceinline__ Frame refresh(const Frame& F0) {
    Frame F = F0; int t = threadIdx.x; asm volatile("" : "+v"(t)); int bx = blockIdx.x; asm volatile("" : "+s"(bx));
    F.tid = t; F.lane = t & 63; F.wave = __builtin_amdgcn_readfirstlane(t >> 6); F.G = gridDim.x; F.vcu = (F.G % 8 == 0) ? (bx % 8) * (F.G / 8) + bx / 8 : bx; return F;
}

__device__ __forceinline__ float bf2f(unsigned short b) { return __builtin_bit_cast(float, (unsigned)b << 16); }
__device__ __forceinline__ float bflo(unsigned w) { return __builtin_bit_cast(float, w << 16); }
__device__ __forceinline__ float bfhi(unsigned w) { return __builtin_bit_cast(float, w & 0xffff0000u); }
__device__ __forceinline__ float fsig(float x) { return __builtin_amdgcn_rcpf(1.f + __builtin_amdgcn_exp2f(-1.44269504f * x)); }
__device__ __forceinline__ float fgelu(float x) { const float u = x * (1.f + 0.044715f * x * x); return x * __builtin_amdgcn_rcpf(1.f + __builtin_amdgcn_exp2f(-2.302208198f * u)); }
__device__ __forceinline__ float wave_sum(float v) {
#pragma unroll
    for (int o = 1; o < 64; o <<= 1) v += __shfl_xor(v, o);
    return v;
}
__device__ __forceinline__ int row_ci(int row) { return row < MP ? (row >> 11) : 8 + ((row - MP) >> 3); }

namespace pg8 {
enum { EM_ADA = 0, EM_IN = 1, EM_GLU = 2, EM_RGP = 3, EM_RES = 4, EM_PLAIN = 5, EM_UPF = 6 };
struct EpiAny {
    static constexpr bool AFTER_DRAIN = false;
    int mode; bool perm; unsigned char* ws; const float* p0; const float* p1; const float* p2; float* out; int row_off; int lay; PG8_LAS float* xch;
    __device__ __forceinline__ void operator()(const f32x4 (&acc)[2][2][4][2], const Unit& u, int wr, int wc, int fr, int fq) const {
        asm volatile("" : "+v"(fr), "+v"(fq), "+s"(wr), "+s"(wc));
        if (mode == EM_IN || mode == EM_PLAIN) {
            const int pn = u.pn; int ldc = 1024, ct = pn; size_t wo = WS_UPH;
            if (mode == EM_IN) { if (pn < 4) { wo = WS_RX; ct = pn; } else if (pn < 8) { wo = WS_RY; ct = pn - 4; } else if (pn < 10) { wo = WS_SX; ct = pn - 8; ldc = 512; } else if (pn < 14) { wo = WS_GA; ct = pn - 10; } else { wo = WS_GB; ct = pn - 14; } }
            else ldc = FF2;
            bf16_t* base = (bf16_t*)(ws + wo);
            const int row0 = u.pm * BM + wr * 64 + fr, col0 = ct * BM + wc * 32 + 8 * fq, bcol0 = pn * BM + wc * 32 + 8 * fq;
#pragma unroll
            for (int bj = 0; bj < 2; ++bj) {
                f32x4 b0 = {0.f, 0.f, 0.f, 0.f}, b1 = {0.f, 0.f, 0.f, 0.f};
                if (mode == EM_IN) { b0 = *(const f32x4*)(p0 + bcol0 + bj * HALF); b1 = *(const f32x4*)(p0 + bcol0 + bj * HALF + 4); }
#pragma unroll
                for (int ai = 0; ai < 2; ++ai)
#pragma unroll
                    for (int m = 0; m < 4; ++m) { bf16_t* rowp = base + (size_t)(row0 + ai * HALF + m * 16) * ldc + col0;
                        const f32x4 v0 = acc[ai][bj][m][0] + b0, v1 = acc[ai][bj][m][1] + b1;
                        u32x4 w; w.x = cvt_pk_bf16(v0[0], v0[1]); w.y = cvt_pk_bf16(v0[2], v0[3]); w.z = cvt_pk_bf16(v1[0], v1[1]); w.w = cvt_pk_bf16(v1[2], v1[3]);
                        *(u32x4*)(rowp + bj * HALF) = w; } }
        } else if (mode == EM_UPF) {
            const int pm = u.pm, pn = u.pn; const bool smp = pm >= 64; const int lane = fq * 16 + fr;
            bf16_t* HF = (bf16_t*)(ws + WS_HFF); float* HALO = (float*)(ws + WS_HALO);
            const int cb = pn * HALF + wc * 32 + 8 * fq;
            if (fr >= 14) {
#pragma unroll
                for (int ai = 0; ai < 2; ++ai)
#pragma unroll
                    for (int bj = 0; bj < 2; ++bj)
#pragma unroll
                        for (int n = 0; n < 2; ++n) *(PG8_LAS f32x4*)(xch + ((((ai * 2 + wr) * 2 + (fr - 14)) * 4 + wc) * 4 + fq) * 16 + bj * 8 + n * 4) = acc[ai][bj][3][n];
            }
            if (!smp) {
                if (wr == 1 && fr >= 14) {
#pragma unroll
                    for (int bj = 0; bj < 2; ++bj)
#pragma unroll
                        for (int n = 0; n < 2; ++n) { *(f32x4*)(HALO + ((size_t)(pm * 4 + (fr - 14)) * 2 + bj) * FF + cb + 4 * n) = acc[1][bj][3][n];
                            if ((pm & 7) == 7) *(f32x4*)(out + O_PFFN + ((size_t)((pm >> 3) * 2 + lay) * 2 + (fr - 14)) * FF2 + bj * FF + cb + 4 * n) = acc[1][bj][3][n]; }
                }
                if (wr == 0 && fr < 2) {
#pragma unroll
                    for (int bj = 0; bj < 2; ++bj)
#pragma unroll
                        for (int n = 0; n < 2; ++n) *(f32x4*)(HALO + ((size_t)(pm * 4 + 2 + fr) * 2 + bj) * FF + cb + 4 * n) = acc[0][bj][0][n];
                }
            } else if ((fr & 7) >= 6) {
#pragma unroll
                for (int ai = 0; ai < 2; ++ai)
#pragma unroll
                    for (int m = 0; m < 4; ++m) { const int sq = ((pm - 64) * BM + ai * HALF + wr * 64 + m * 16 + fr) >> 3;
#pragma unroll
                        for (int bj = 0; bj < 2; ++bj)
#pragma unroll
                            for (int n = 0; n < 2; ++n) *(f32x4*)(out + O_SFFN + ((size_t)(sq * 2 + lay) * 2 + ((fr & 7) - 6)) * FF2 + bj * FF + cb + 4 * n) = acc[ai][bj][m][n]; }
            }
            asm volatile("s_waitcnt lgkmcnt(0)" ::: "memory"); __builtin_amdgcn_s_barrier(); asm volatile("" ::: "memory");
#pragma unroll
            for (int n = 0; n < 2; ++n) {
                const int c4 = cb + 4 * n;
                f32x4 w[2][3], bb[2];
#pragma unroll
                for (int bj = 0; bj < 2; ++bj) { bb[bj] = *(const f32x4*)(p1 + bj * FF + c4);
#pragma unroll
                    for (int k = 0; k < 3; ++k) w[bj][k] = *(const f32x4*)(p0 + k * FF2 + bj * FF + c4); }
#pragma unroll
                for (int ai = 0; ai < 2; ++ai) {
                    f32x4 pg[2] = {{0.f, 0.f, 0.f, 0.f}, {0.f, 0.f, 0.f, 0.f}};
                    const int blk = ai * 2 + wr;
                    if (!smp && blk > 0 && fr >= 14) {
#pragma unroll
                        for (int bj = 0; bj < 2; ++bj) pg[bj] = *(const PG8_LAS f32x4*)(xch + (((((blk - 1) * 2 + (fr - 14)) * 4 + wc) * 4 + fq) * 16 + bj * 8 + n * 4));
                    }
#pragma unroll
                    for (int m = 0; m < 4; ++m) {
                        const int trow = ai * HALF + wr * 64 + m * 16 + fr;
                        f32x4 uc[2];
#pragma unroll
                        for (int bj = 0; bj < 2; ++bj) {
                            const f32x4 cur = acc[ai][bj][m][n]; f32x4 p1v, p2v;
#pragma unroll
                            for (int j = 0; j < 4; ++j) { const float x1 = (fr == 15) ? pg[bj][j] : cur[j], x2 = (fr >= 14) ? pg[bj][j] : cur[j];
                                p1v[j] = __builtin_bit_cast(float, __builtin_amdgcn_update_dpp(0, __builtin_bit_cast(int, x1), 0x121, 0xF, 0xF, false));
                                p2v[j] = __builtin_bit_cast(float, __builtin_amdgcn_update_dpp(0, __builtin_bit_cast(int, x2), 0x122, 0xF, 0xF, false)); }
                            if (smp) { const int t = fr & 7;
                                if (t < 2) { const int sq = ((pm - 64) * BM + trow) >> 3; const float* st = p2 + ((size_t)(sq * 2 + lay) * 2) * FF2 + bj * FF + c4;
                                    const f32x4 s1 = *(const f32x4*)(st + FF2); p2v = s1; if (t == 0) { p1v = s1; p2v = *(const f32x4*)st; } } }
                            uc[bj] = bb[bj] + w[bj][0] * p2v + w[bj][1] * p1v + w[bj][2] * cur;
                            pg[bj] = cur;
                        }
                        u32x2 o; o.x = cvt_pk_bf16(fgelu(uc[0][0]) * uc[1][0], fgelu(uc[0][1]) * uc[1][1]); o.y = cvt_pk_bf16(fgelu(uc[0][2]) * uc[1][2], fgelu(uc[0][3]) * uc[1][3]);
                        *(u32x2*)(HF + (size_t)(pm * BM + trow) * FF + c4) = o;
                    }
                }
            }
        } else if (mode == EM_GLU) {
            bf16_t* GA = (bf16_t*)(ws + WS_GA); const bf16_t* GB = (const bf16_t*)(ws + WS_GB);
            const int row0 = u.pm * BM + wr * 64 + fr, col0 = u.pn * HALF + wc * 32 + 8 * fq;
#pragma unroll
            for (int ai = 0; ai < 2; ++ai) {
                u32x4 gq[4], aq[4];
#pragma unroll
                for (int m = 0; m < 4; ++m) { const size_t off = (size_t)(row0 + ai * HALF + m * 16) * 1024 + col0; gq[m] = *(const u32x4*)(GB + off); aq[m] = *(const u32x4*)(GA + off); }
#pragma unroll
                for (int m = 0; m < 4; ++m) { const size_t off = (size_t)(row0 + ai * HALF + m * 16) * 1024 + col0;
                    const u32x4 g = gq[m], a = aq[m];
                    float gv[8] = {bflo(g.x), bfhi(g.x), bflo(g.y), bfhi(g.y), bflo(g.z), bfhi(g.z), bflo(g.w), bfhi(g.w)};
                    float av[8] = {bflo(a.x), bfhi(a.x), bflo(a.y), bfhi(a.y), bflo(a.z), bfhi(a.z), bflo(a.w), bfhi(a.w)}; float o[8];
#pragma unroll
                    for (int n = 0; n < 2; ++n)
#pragma unroll
                        for (int j = 0; j < 4; ++j) o[4 * n + j] = av[4 * n + j] + fsig(gv[4 * n + j]) * acc[ai][0][m][n][j] * fsig(acc[ai][1][m][n][j]);
                    u32x4 w; w.x = cvt_pk_bf16(o[0], o[1]); w.y = cvt_pk_bf16(o[2], o[3]); w.z = cvt_pk_bf16(o[4], o[5]); w.w = cvt_pk_bf16(o[6], o[7]);
                    *(u32x4*)(GA + off) = w; } }
        } else if (mode == EM_RGP) {
            bf16_t* GA = (bf16_t*)(ws + WS_GA);
            const int row0 = u.pm * BM + wr * 64 + fr, col0 = u.pn * BM + wc * 32 + 8 * fq;
#pragma unroll
            for (int ai = 0; ai < 2; ++ai) {
                u32x4 gq[4][2];
#pragma unroll
                for (int m = 0; m < 4; ++m)
#pragma unroll
                    for (int bj = 0; bj < 2; ++bj) gq[m][bj] = *(const u32x4*)(GA + (size_t)(row0 + ai * HALF + m * 16) * 1024 + col0 + bj * HALF);
#pragma unroll
                for (int m = 0; m < 4; ++m)
#pragma unroll
                    for (int bj = 0; bj < 2; ++bj) { const size_t off = (size_t)(row0 + ai * HALF + m * 16) * 1024 + col0 + bj * HALF;
                        const u32x4 g = gq[m][bj];
                        float gv[8] = {bflo(g.x), bfhi(g.x), bflo(g.y), bfhi(g.y), bflo(g.z), bfhi(g.z), bflo(g.w), bfhi(g.w)}; float o[8];
#pragma unroll
                        for (int n = 0; n < 2; ++n)
#pragma unroll
                            for (int j = 0; j < 4; ++j) o[4 * n + j] = fsig(gv[4 * n + j]) * acc[ai][bj][m][n][j];
                        u32x4 w; w.x = cvt_pk_bf16(o[0], o[1]); w.y = cvt_pk_bf16(o[2], o[3]); w.z = cvt_pk_bf16(o[4], o[5]); w.w = cvt_pk_bf16(o[6], o[7]);
                        *(u32x4*)(GA + off) = w; } }
        } else if (mode == EM_RES) {
            bf16_t* XB = (bf16_t*)(ws + WS_XRB);
            const int col0 = u.pn * BM + wc * 32 + 8 * fq;
            if (u.mini) {
#pragma unroll
                for (int ai = 0; ai < 2; ++ai)
#pragma unroll
                    for (int m = 0; m < 4; ++m) { const int r = u.pm * BM + ai * HALF + wr * 64 + m * 16 + fr;
#pragma unroll
                        for (int bj = 0; bj < 2; ++bj) { float* P = (float*)(ws + (row_off ? WS_PART_DOWN : WS_PART_OUT)) + ((size_t)(u.koff / u.ksl) * (MROWS - MP) + (r - MP)) * DM + col0 + bj * HALF;
                            *(f32x4*)P = acc[ai][bj][m][0]; *(f32x4*)(P + 4) = acc[ai][bj][m][1]; } }
            } else {
                const float* gt = p2 + (size_t)(u.pm >> 3) * MODW;
                f32x4 gq[2][2];
#pragma unroll
                for (int bj = 0; bj < 2; ++bj) { gq[bj][0] = *(const f32x4*)(gt + col0 + bj * HALF); gq[bj][1] = *(const f32x4*)(gt + col0 + bj * HALF + 4); }
#pragma unroll
                for (int ai = 0; ai < 2; ++ai) {
                    f32x4 sq[4][2][2];
#pragma unroll
                    for (int m = 0; m < 4; ++m)
#pragma unroll
                        for (int bj = 0; bj < 2; ++bj) { const size_t off = (size_t)(u.pm * BM + ai * HALF + wr * 64 + m * 16 + fr) * DM + col0 + bj * HALF;
                            if (p0) { sq[m][bj][0] = *(const f32x4*)(p0 + off); sq[m][bj][1] = *(const f32x4*)(p0 + off + 4); }
                            else { const u32x4 b = *(const u32x4*)(XB + off); sq[m][bj][0] = (f32x4){bflo(b.x), bfhi(b.x), bflo(b.y), bfhi(b.y)}; sq[m][bj][1] = (f32x4){bflo(b.z), bfhi(b.z), bflo(b.w), bfhi(b.w)}; } }
#pragma unroll
                    for (int m = 0; m < 4; ++m)
#pragma unroll
                        for (int bj = 0; bj < 2; ++bj) { const size_t off = (size_t)(u.pm * BM + ai * HALF + wr * 64 + m * 16 + fr) * DM + col0 + bj * HALF;
                            const f32x4 o0 = sq[m][bj][0] + gq[bj][0] * acc[ai][bj][m][0], o1 = sq[m][bj][1] + gq[bj][1] * acc[ai][bj][m][1];
                            u32x4 w; w.x = cvt_pk_bf16(o0[0], o0[1]); w.y = cvt_pk_bf16(o0[2], o0[3]); w.z = cvt_pk_bf16(o1[0], o1[1]); w.w = cvt_pk_bf16(o1[2], o1[3]);
                            *(u32x4*)(XB + off) = w; } }
            }
        } else {
            const int col0 = u.pn * BM + wc * 32 + 4 * fq;
#pragma unroll
            for (int ai = 0; ai < 2; ++ai)
#pragma unroll
                for (int m = 0; m < 4; ++m) { const int r = ai * HALF + wr * 64 + m * 16 + fr;
                    if (r < NCI) {
#pragma unroll
                        for (int bj = 0; bj < 2; ++bj)
#pragma unroll
                            for (int n = 0; n < 2; ++n) { const int c = col0 + bj * HALF + n * 16; *(f32x4*)(out + (size_t)r * MODW + c) = acc[ai][bj][m][n] + *(const f32x4*)(p0 + c); } } }
        }
    }
};
}

template <int MAP> __device__ __forceinline__ int wt_row(int n) {
    if (MAP == 1) { return n < 1024 ? ((n >> 7) << 8) + (n & 127) : (((n - 1024) >> 7) << 8) + 128 + (n & 127); }
    if (MAP == 2) { return n < 3072 ? ((n >> 7) << 8) + (n & 127) : (((n - 3072) >> 7) << 8) + 128 + (n & 127); }
    return n;
}
template <int MAP> __device__ __forceinline__ void p0_transpose_item(const float* W, int K, int N, bf16* WT, int row_off, LAS float* scr, int item, int lane) {
    const int nblk = N / 32, kb = item / nblk, nb = item % nblk, k0 = 64 * kb, n0 = 32 * nb;
    { f32x4 v[8];
#pragma unroll
      for (int i = 0; i < 8; ++i) v[i] = __builtin_nontemporal_load((const f32x4*)(W + (size_t)(k0 + 8 * i + (lane >> 3)) * N + n0 + 4 * (lane & 7)));
#pragma unroll
      for (int i = 0; i < 8; ++i) { LAS float* d = scr + (8 * i + (lane >> 3)) * 33 + 4 * (lane & 7); d[0] = v[i].x; d[1] = v[i].y; d[2] = v[i].z; d[3] = v[i].w; } }
    LDS_WAIT(); asm volatile("" ::: "memory");
    const int c = lane & 7;
#pragma unroll
    for (int j = 0; j < 4; ++j) { const int n = (lane >> 3) + 8 * j; const LAS float* s = scr + (8 * c) * 33 + n;
        v4u o; o.x = pk2(s[0 * 33], s[1 * 33]); o.y = pk2(s[2 * 33], s[3 * 33]); o.z = pk2(s[4 * 33], s[5 * 33]); o.w = pk2(s[6 * 33], s[7 * 33]);
        *(GAS v4u*)(WT + (size_t)(row_off + wt_row<MAP>(n0 + n)) * K + k0 + 8 * c) = o; }
    LDS_WAIT(); asm volatile("" ::: "memory");
}

__device__ __forceinline__ void p0_weights(const Frame& F0, const Args& A, int l, int part, int b0, int nb) {
    const Frame F = refresh(F0);
    unsigned char* ws = A.ws;
    LAS float* scr = (LAS float*)(F.lds + F.wave * 16384);
    int bx = blockIdx.x; asm volatile("" : "+s"(bx));
    if (bx < b0) return;
    const bool first = part == 0;
    const int gw = (bx - b0) * NWAVES + F.wave, NGW = nb * NWAVES;
    constexpr int I_IN = (DM / 64) * (INW / 32), I_SQ = (DM / 64) * (DM / 32), I_GLU = (512 / 64) * (2048 / 32), I_UP = (DM / 64) * (FF2 / 32), I_DN = (FF / 64) * (DM / 32), I_ADA = (DM / 64) * (FF2 / 32);
    constexpr int NLAYER = I_IN + 2 * I_SQ + I_GLU + I_UP + I_DN;
    const int nitems = first ? 2 * I_ADA : NLAYER;
    const int per_ = (nitems + NGW - 1) / NGW, it_hi = (gw + 1) * per_ < nitems ? (gw + 1) * per_ : nitems;
    for (int it = gw * per_; it < it_hi; ++it) {
        int r = first ? it + NLAYER : it;
        if (r < I_IN) { p0_transpose_item<0>(A.in[13] + (size_t)l * DM * INW, DM, INW, (bf16*)(ws + WS_WIN), 0, scr, r, F.lane); continue; } r -= I_IN;
        if (r < I_SQ) { p0_transpose_item<0>(A.in[30] + (size_t)l * DM * DM, DM, DM, (bf16*)(ws + WS_WRG), 0, scr, r, F.lane); continue; } r -= I_SQ;
        if (r < I_SQ) { p0_transpose_item<0>(A.in[32] + (size_t)l * DM * DM, DM, DM, (bf16*)(ws + WS_WOUT), 0, scr, r, F.lane); continue; } r -= I_SQ;
        if (r < I_GLU) { p0_transpose_item<1>(A.in[31] + (size_t)l * 512 * 2048, 512, 2048, (bf16*)(ws + WS_WGLU), 0, scr, r, F.lane); continue; } r -= I_GLU;
        if (r < I_UP) { p0_transpose_item<2>(A.in[33] + (size_t)l * DM * FF2, DM, FF2, (bf16*)(ws + WS_WUP), 0, scr, r, F.lane); continue; } r -= I_UP;
        if (r < I_DN) { p0_transpose_item<0>(A.in[36] + (size_t)l * FF * DM, FF, DM, (bf16*)(ws + WS_WDOWN), 0, scr, r, F.lane); continue; } r -= I_DN;
        if (r < I_ADA) { p0_transpose_item<0>(A.in[9], DM, FF2, (bf16*)(ws + WS_WADA), 0, scr, r, F.lane); continue; } r -= I_ADA;
        p0_transpose_item<0>(A.in[9] + (size_t)DM * FF2, DM, FF2, (bf16*)(ws + WS_WADA), FF2, scr, r, F.lane);
    }
    const int gt = (bx - b0) * (NWAVES * 64) + F.tid, NGT = nb * NWAVES * 64;
    if (!first) {
    bf16* WG = (bf16*)(ws + WS_SMALL + SM_WG);
    for (int e = gt; e < 2 * 16 * 4096; e += NGT) { const int gate = e >> 16, rem = e & 65535, h = rem >> 12, j = (rem >> 6) & 63, i = rem & 63;
        const float* src = (gate ? A.in[19] : A.in[17]) + (size_t)l * 65536 + h * 4096 + i * 64 + j;
        WG[((h * 2 + gate) * 64 + j) * 64 + i] = (bf16)f2bf(*src); }
    for (int e = gt; e < 2048; e += NGT) { const int g = e >> 6, p = e & 63;
        const float dt = expf(A.in[29][l * 32 + g]);
        const float lr = A.in[22][l * 2048 + e], li = A.in[23][l * 2048 + e];
        const float mag = expf(lr * dt); float sn, cs; sincosf(li * dt, &sn, &cs);
        const float ar = mag * cs, ai = mag * sn, den = lr * lr + li * li;
        const float zr = ((ar - 1.f) * lr + ai * li) / den, zi = (ai * lr - (ar - 1.f) * li) / den;
        float* AB = (float*)(ws + WS_SMALL + SM_ABAR); AB[e * 2] = ar; AB[e * 2 + 1] = ai;
        float pr = ar, pi = ai;
#pragma unroll 1
        for (int s = 0; s < 7; ++s) { const float nr = pr * pr - pi * pi, ni = 2.f * pr * pi; pr = nr; pi = ni; }
        float* ABT = (float*)(ws + WS_SMALL + SM_ABARTC); ABT[e * 2] = pr; ABT[e * 2 + 1] = pi;
        bf16* BB = (bf16*)(ws + WS_SMALL + SM_BBAR) + (size_t)g * 128 * 16;
        const float* bre = A.in[24] + ((size_t)l * 2048 + e) * 16; const float* bim = A.in[25] + ((size_t)l * 2048 + e) * 16;
#pragma unroll 4
        for (int c = 0; c < 16; ++c) { const float br = bre[c], bi = bim[c]; BB[p * 16 + c] = (bf16)f2bf(zr * br - zi * bi); BB[(64 + p) * 16 + c] = (bf16)f2bf(zr * bi + zi * br); }
        bf16* CM = (bf16*)(ws + WS_SMALL + SM_CMAT) + (size_t)g * 16 * 128;
        const float* cre = A.in[26] + ((size_t)l * 32 + g) * 1024; const float* cim = A.in[27] + ((size_t)l * 32 + g) * 1024;
#pragma unroll 4
        for (int c = 0; c < 16; ++c) { CM[c * 128 + p] = (bf16)f2bf(cre[c * 64 + p]); CM[c * 128 + 64 + p] = (bf16)f2bf(-cim[c * 64 + p]); }
    }
    }
    if (first) {
        bf16* XRs = (bf16*)(ws + WS_XRB) + (size_t)MP * DM;
        for (int e = gt; e < (MROWS - MP) * DM / 4; e += NGT) { const f32x4 v = ((const f32x4*)A.in[1])[e]; ((unsigned long long*)XRs)[e] = (unsigned long long)pk2(v.x, v.y) | ((unsigned long long)pk2(v.z, v.w) << 32); }
    }
    if (first) {
        bf16* SC = (bf16*)(ws + WS_SILUC);
        for (int e = gt; e < 256 * DM; e += NGT) { const int r = e >> 10, c = e & 1023; float v = 0.f;
            if (r < NSP) v = A.in[7][r * DM + c]; else if (r < NCI) v = A.in[8][(r - NSP) * DM + c];
            SC[e] = (bf16)f2bf(v * fsig(v)); }
    }
}

__device__ __forceinline__ void cvt8(const v4u w, float (&o)[8]) { o[0] = bflo(w.x); o[1] = bfhi(w.x); o[2] = bflo(w.y); o[3] = bfhi(w.y); o[4] = bflo(w.z); o[5] = bfhi(w.z); o[6] = bflo(w.w); o[7] = bfhi(w.w); }
__device__ __forceinline__ f32x4 ld_row4(const float* xf, const bf16* xb, size_t row, int idx) {
    if (xf) return __builtin_nontemporal_load((const GAS f32x4*)(xf + row * DM) + idx);
    const u32x2 b = ((const GAS u32x2*)(xb + row * DM))[idx]; return (f32x4){bflo(b.x), bfhi(b.x), bflo(b.y), bfhi(b.y)};
}
__device__ __forceinline__ void norm_rows(const Frame& F0, const float* xp, const float* xs_adj, bf16* XRB, const float* g, const float* mod_sh, const float* mod_sc, bf16* XN, int npart, const float* pgate, const float* PART) {
    const Frame F = refresh(F0);
    const int gw = F.vcu * NWAVES + F.wave, NGW = F.G * NWAVES;
    if (!xp) {
        for (int m0 = 8 * gw; m0 < MP; m0 += 8 * NGW) {
            const int ci = m0 >> 11;
            v4u w[8][2]; float sr[8];
#pragma unroll
            for (int r = 0; r < 8; ++r)
#pragma unroll
                for (int j = 0; j < 2; ++j) w[r][j] = ((const GAS v4u*)(XRB + (size_t)(m0 + r) * DM))[64 * j + F.lane];
#pragma unroll
            for (int r = 0; r < 8; ++r) { float q = 0.f;
#pragma unroll
                for (int j = 0; j < 2; ++j) { float v[8]; cvt8(w[r][j], v);
#pragma unroll
                    for (int e = 0; e < 8; ++e) q += v[e] * v[e]; }
                sr[r] = __builtin_amdgcn_rsqf(wave_sum(q) * (1.f / DM) + EPSN); }
#pragma unroll
            for (int j = 0; j < 2; ++j) { const int c = 512 * j + 8 * F.lane; float gs[8], sh[8];
#pragma unroll
                for (int h2 = 0; h2 < 2; ++h2) { const f32x4 gg = *(const f32x4*)(g + c + 4 * h2), s4 = *(const f32x4*)(mod_sh + (size_t)ci * MODW + c + 4 * h2), c4 = *(const f32x4*)(mod_sc + (size_t)ci * MODW + c + 4 * h2);
#pragma unroll
                    for (int e = 0; e < 4; ++e) { gs[4 * h2 + e] = gg[e] * (c4[e] + 1.f); sh[4 * h2 + e] = s4[e]; } }
#pragma unroll
                for (int r = 0; r < 8; ++r) { float v[8]; cvt8(w[r][j], v); v4u o;
                    o.x = pk2(v[0] * sr[r] * gs[0] + sh[0], v[1] * sr[r] * gs[1] + sh[1]); o.y = pk2(v[2] * sr[r] * gs[2] + sh[2], v[3] * sr[r] * gs[3] + sh[3]);
                    o.z = pk2(v[4] * sr[r] * gs[4] + sh[4], v[5] * sr[r] * gs[5] + sh[5]); o.w = pk2(v[6] * sr[r] * gs[6] + sh[6], v[7] * sr[r] * gs[7] + sh[7]);
                    ((GAS v4u*)(XN + (size_t)(m0 + r) * DM))[64 * j + F.lane] = o; } }
        }
    } else
    for (int m0 = 4 * gw; m0 < MP; m0 += 4 * NGW) {
        const int ci = m0 >> 11;
        f32x4 v[4][4]; float s[4];
#pragma unroll
        for (int r = 0; r < 4; ++r)
#pragma unroll
            for (int j = 0; j < 4; ++j) v[r][j] = ld_row4(xp, XRB, (size_t)(m0 + r), 64 * j + F.lane);
#pragma unroll
        for (int r = 0; r < 4; ++r) { float q = 0.f;
#pragma unroll
            for (int j = 0; j < 4; ++j) q += (v[r][j].x * v[r][j].x + v[r][j].y * v[r][j].y) + (v[r][j].z * v[r][j].z + v[r][j].w * v[r][j].w);
            s[r] = 1.f / sqrtf(wave_sum(q) * (1.f / DM) + EPSN); }
#pragma unroll
        for (int j = 0; j < 4; ++j) { const int c = 256 * j + 4 * F.lane;
            const f32x4 gg = *(const f32x4*)(g + c), sh = *(const f32x4*)(mod_sh + (size_t)ci * MODW + c), sc = *(const f32x4*)(mod_sc + (size_t)ci * MODW + c);
            const f32x4 gs = gg * (sc + 1.f);
#pragma unroll
            for (int r = 0; r < 4; ++r) { const f32x4 y = v[r][j] * s[r] * gs + sh;
                ((GAS unsigned long long*)(XN + (size_t)(m0 + r) * DM))[64 * j + F.lane] = (unsigned long long)pk2(y.x, y.y) | ((unsigned long long)pk2(y.z, y.w) << 32); } }
    }
    for (int m = MP + F.wave * F.G + F.vcu; m < MROWS; m += NGW) {
        const int ci = row_ci(m);
        f32x4 v[4]; float q = 0.f;
#pragma unroll
        for (int j = 0; j < 4; ++j) { v[j] = ld_row4(xs_adj, XRB, (size_t)m, 64 * j + F.lane);
            if (npart > 0) {
                f32x4 ps = {0.f, 0.f, 0.f, 0.f};
#pragma unroll
                for (int k = 0; k < 12; ++k) if (k < npart) ps += *(const f32x4*)(PART + ((size_t)k * (MROWS - MP) + (m - MP)) * DM + 256 * j + 4 * F.lane);
                v[j] += *(const f32x4*)(pgate + (size_t)ci * MODW + 256 * j + 4 * F.lane) * ps;
                ((GAS unsigned long long*)(XRB + (size_t)m * DM))[64 * j + F.lane] = (unsigned long long)pk2(v[j].x, v[j].y) | ((unsigned long long)pk2(v[j].z, v[j].w) << 32);
            }
            q += (v[j].x * v[j].x + v[j].y * v[j].y) + (v[j].z * v[j].z + v[j].w * v[j].w); }
        const float rstd = 1.f / sqrtf(wave_sum(q) * (1.f / DM) + EPSN);
#pragma unroll
        for (int j = 0; j < 4; ++j) { const int c = 256 * j + 4 * F.lane;
            const f32x4 gg = *(const f32x4*)(g + c), sh = *(const f32x4*)(mod_sh + (size_t)ci * MODW + c), sc = *(const f32x4*)(mod_sc + (size_t)ci * MODW + c);
            const f32x4 y = v[j] * rstd * gg * (sc + 1.f) + sh;
            ((GAS unsigned long long*)(XN + (size_t)m * DM))[64 * j + F.lane] = (unsigned long long)pk2(y.x, y.y) | ((unsigned long long)pk2(y.z, y.w) << 32); }
    }
}
__device__ __forceinline__ void final_norm(const Frame& F0, const bf16* XRB, float* y, const float* g, int npart, const float* pgate, const float* PART) {
    const Frame F = refresh(F0);
    const int gw = F.vcu * NWAVES + F.wave, NGW = F.G * NWAVES;
    for (int m0 = 8 * gw; m0 < MP; m0 += 8 * NGW) {
        v4u w[8][2]; float sr[8];
#pragma unroll
        for (int r = 0; r < 8; ++r)
#pragma unroll
            for (int j = 0; j < 2; ++j) w[r][j] = ((const GAS v4u*)(XRB + (size_t)(m0 + r) * DM))[64 * j + F.lane];
#pragma unroll
        for (int r = 0; r < 8; ++r) { float q = 0.f;
#pragma unroll
            for (int j = 0; j < 2; ++j) { float v[8]; cvt8(w[r][j], v);
#pragma unroll
                for (int e = 0; e < 8; ++e) q += v[e] * v[e]; }
            sr[r] = __builtin_amdgcn_rsqf(wave_sum(q) * (1.f / DM) + EPSN); }
#pragma unroll
        for (int j = 0; j < 2; ++j) { const int c = 512 * j + 8 * F.lane; const f32x4 g0 = *(const f32x4*)(g + c), g1 = *(const f32x4*)(g + c + 4);
#pragma unroll
            for (int r = 0; r < 8; ++r) { float v[8]; cvt8(w[r][j], v); float* yp = y + (size_t)(m0 + r) * DM + c;
                *(f32x4*)yp = (f32x4){v[0], v[1], v[2], v[3]} * sr[r] * g0; *(f32x4*)(yp + 4) = (f32x4){v[4], v[5], v[6], v[7]} * sr[r] * g1; } }
    }
    for (int m = MP + F.wave * F.G + F.vcu; m < MROWS; m += NGW) {
        const int ci = row_ci(m);
        f32x4 v[4]; float q = 0.f;
#pragma unroll
        for (int j = 0; j < 4; ++j) { v[j] = ld_row4(nullptr, XRB, (size_t)m, 64 * j + F.lane);
            f32x4 ps = {0.f, 0.f, 0.f, 0.f};
#pragma unroll
            for (int k = 0; k < 12; ++k) if (k < npart) ps += *(const f32x4*)(PART + ((size_t)k * (MROWS - MP) + (m - MP)) * DM + 256 * j + 4 * F.lane);
            v[j] += *(const f32x4*)(pgate + (size_t)ci * MODW + 256 * j + 4 * F.lane) * ps;
            q += (v[j].x * v[j].x + v[j].y * v[j].y) + (v[j].z * v[j].z + v[j].w * v[j].w); }
        const float rstd = 1.f / sqrtf(wave_sum(q) * (1.f / DM) + EPSN);
#pragma unroll
        for (int j = 0; j < 4; ++j) { const f32x4 gg = *(const f32x4*)(g + 256 * j + 4 * F.lane); ((GAS f32x4*)(y + (size_t)m * DM))[64 * j + F.lane] = v[j] * rstd * gg; }
    }
}


template <int MODE> __device__ __forceinline__ void rg_unit(const Frame& F, const Args& A, int l, bool sample, int s, int c, int h) {
    unsigned char* ws = A.ws;
    LAS float* TAB = (LAS float*)(F.lds + F.wave * 15360);
    LAS float* XC = TAB + 512;
    LAS float* AA = XC + 16 * 68;
    LAS float* BB = AA + 16 * 68;
    const int lane = F.lane, fr = lane & 15, fq = lane >> 4, ch0 = 64 * h;
    const bf16* RX = (const bf16*)(ws + WS_RX); bf16* RY = (bf16*)(ws + WS_RY);
    {
        const int chg = l * DM + ch0 + lane;
#pragma unroll
        for (int j = 0; j < 4; ++j) TAB[j * 64 + lane] = A.in[15][(size_t)(l * 4 + j) * DM + ch0 + lane];
        TAB[4 * 64 + lane] = A.in[16][chg]; TAB[5 * 64 + lane] = A.in[18][chg]; TAB[6 * 64 + lane] = A.in[20][chg];
        const float lam = A.in[21][chg]; TAB[7 * 64 + lane] = -8.f * 1.44269504f * log1pf(expf(-lam));
    }
    bf16x8 Wf[2][4][2];
    { const bf16* WG = (const bf16*)(ws + WS_SMALL + SM_WG);
#pragma unroll
      for (int g = 0; g < 2; ++g)
#pragma unroll
        for (int n = 0; n < 4; ++n)
#pragma unroll
            for (int k = 0; k < 2; ++k) Wf[g][n][k] = *(const bf16x8*)(WG + ((h * 2 + g) * 64 + 16 * n + fr) * 64 + 32 * k + 8 * fq); }
    LDS_WAIT(); asm volatile("" ::: "memory");
    const int rbase = sample ? MP + s * 32 : s * TP + c * TC;
    float hst = 0.f, aprod = 1.f;
    if (MODE == 1 && !sample) {
        const float* AG = (const float*)(ws + WS_AGGRG) + ((size_t)(s * NCH) * DM + ch0 + lane) * 2;
        for (int cc = 0; cc < c; ++cc) { const float a = AG[(size_t)cc * DM * 2], b = AG[(size_t)cc * DM * 2 + 1]; hst = a * hst + b; }
    }
    const int ntile = sample ? 2 : 8;
#pragma unroll 1
    for (int tile = 0; tile < ntile; ++tile) {
        const int row = rbase + 16 * tile + fr;
        const int t = sample ? (fr & 7) : c * TC + 16 * tile + fr;
        const int sq = sample ? s * 4 + tile * 2 + (fr >> 3) : s;
        bf16x8 X[2];
#pragma unroll
        for (int k = 0; k < 2; ++k) {
            const int cl = 32 * k + 8 * fq; float xc[8];
            { const f32x4 b0 = *(const LAS f32x4*)(TAB + 4 * 64 + cl), b1 = *(const LAS f32x4*)(TAB + 4 * 64 + cl + 4); xc[0] = b0.x; xc[1] = b0.y; xc[2] = b0.z; xc[3] = b0.w; xc[4] = b1.x; xc[5] = b1.y; xc[6] = b1.z; xc[7] = b1.w; }
#pragma unroll
            for (int d = 0; d < 4; ++d) {
                float v[8];
                if (t - d >= 0) { cvt8(*(const v4u*)(RX + (size_t)(row - d) * DM + ch0 + cl), v); }
                else if (sample) { const float* st = A.in[3] + ((size_t)(sq * 2 + l) * 3 + (3 + t - d)) * DM + ch0 + cl; const f32x4 a0 = *(const f32x4*)st, a1 = *(const f32x4*)(st + 4);
                    v[0] = a0.x; v[1] = a0.y; v[2] = a0.z; v[3] = a0.w; v[4] = a1.x; v[5] = a1.y; v[6] = a1.z; v[7] = a1.w; }
                else {
#pragma unroll
                    for (int q = 0; q < 8; ++q) v[q] = 0.f; }
                const f32x4 w0 = *(const LAS f32x4*)(TAB + (3 - d) * 64 + cl), w1 = *(const LAS f32x4*)(TAB + (3 - d) * 64 + cl + 4);
                xc[0] += w0.x * v[0]; xc[1] += w0.y * v[1]; xc[2] += w0.z * v[2]; xc[3] += w0.w * v[3]; xc[4] += w1.x * v[4]; xc[5] += w1.y * v[5]; xc[6] += w1.z * v[6]; xc[7] += w1.w * v[7];
            }
            *(LAS f32x4*)(XC + fr * 68 + cl) = (f32x4){xc[0], xc[1], xc[2], xc[3]}; *(LAS f32x4*)(XC + fr * 68 + cl + 4) = (f32x4){xc[4], xc[5], xc[6], xc[7]};
            v4u pk; pk.x = pk2(xc[0], xc[1]); pk.y = pk2(xc[2], xc[3]); pk.z = pk2(xc[4], xc[5]); pk.w = pk2(xc[6], xc[7]);
            X[k] = __builtin_bit_cast(bf16x8, pk);
        }
        f32x4 acc[2][4];
#pragma unroll
        for (int g = 0; g < 2; ++g)
#pragma unroll
            for (int n = 0; n < 4; ++n) { acc[g][n] = (f32x4){0.f, 0.f, 0.f, 0.f};
#pragma unroll
                for (int k = 0; k < 2; ++k) acc[g][n] = __builtin_amdgcn_mfma_f32_16x16x32_bf16(Wf[g][n][k], X[k], acc[g][n], 0, 0, 0); }
        LDS_WAIT(); asm volatile("" ::: "memory");
#pragma unroll
        for (int n = 0; n < 4; ++n) { const int cl = 16 * n + 4 * fq;
            const f32x4 xv = *(const LAS f32x4*)(XC + fr * 68 + cl), ba = *(const LAS f32x4*)(TAB + 5 * 64 + cl), bx = *(const LAS f32x4*)(TAB + 6 * 64 + cl), c8 = *(const LAS f32x4*)(TAB + 7 * 64 + cl);
            f32x4 av, bv;
#pragma unroll
            for (int j = 0; j < 4; ++j) { const float r = fsig(acc[0][n][j] + ba[j]), ig = fsig(acc[1][n][j] + bx[j]); const float a = __builtin_amdgcn_exp2f(r * c8[j]);
                av[j] = a; bv[j] = __builtin_amdgcn_sqrtf(fmaxf(1.f - a * a, 0.f)) * ig * xv[j]; }
            *(LAS f32x4*)(AA + fr * 68 + cl) = av; *(LAS f32x4*)(BB + fr * 68 + cl) = bv; }
        LDS_WAIT(); asm volatile("" ::: "memory");
#pragma unroll
        for (int tt = 0; tt < 16; ++tt) {
            if (sample && (tt & 7) == 0) hst = A.in[2][(size_t)((s * 4 + tile * 2 + (tt >> 3)) * 2 + l) * DM + ch0 + lane];
            const float a = AA[tt * 68 + lane], b = BB[tt * 68 + lane];
            hst = a * hst + b; if (MODE == 0) aprod *= a;
            if (MODE == 1) BB[tt * 68 + lane] = hst;
            if (MODE == 1 && sample && (tt & 7) == 7) A.out[O_SRGH + (size_t)((s * 4 + tile * 2 + (tt >> 3)) * 2 + l) * DM + ch0 + lane] = hst;
        }
        if (MODE == 1) {
            LDS_WAIT(); asm volatile("" ::: "memory");
#pragma unroll
            for (int n = 0; n < 4; ++n) { const int cl = 16 * n + 4 * fq; const f32x4 hv = *(const LAS f32x4*)(BB + fr * 68 + cl);
                bf16* p = RY + (size_t)row * DM + ch0 + cl; const u32x2 ry = *(const u32x2*)p;
                u32x2 o; o.x = pk2(hv.x * fgelu(bflo(ry.x)), hv.y * fgelu(bfhi(ry.x))); o.y = pk2(hv.z * fgelu(bflo(ry.y)), hv.w * fgelu(bfhi(ry.y)));
                *(u32x2*)p = o; }
            LDS_WAIT(); asm volatile("" ::: "memory");
        }
    }
    if (MODE == 0) { float* AG = (float*)(ws + WS_AGGRG) + ((size_t)(s * NCH + c) * DM + ch0 + lane) * 2; AG[0] = aprod; AG[1] = hst; }
    if (MODE == 1) {
        if (!sample && c == NCH - 1) {
            A.out[O_PRGH + (size_t)(s * 2 + l) * DM + ch0 + lane] = hst;
#pragma unroll
            for (int k = 0; k < 3; ++k) A.out[O_PRGC + (size_t)((s * 2 + l) * 3 + k) * DM + ch0 + lane] = bf2f(RX[(size_t)(s * TP + TP - 3 + k) * DM + ch0 + lane]);
        }
        if (sample) {
#pragma unroll 1
            for (int q = 0; q < 4; ++q) { const int n = s * 4 + q;
#pragma unroll
                for (int k = 0; k < 3; ++k) A.out[O_SRGC + (size_t)((n * 2 + l) * 3 + k) * DM + ch0 + lane] = bf2f(RX[(size_t)(MP + n * TS + 5 + k) * DM + ch0 + lane]); }
        }
    }
}

__device__ __forceinline__ void rg_unit_sp(const Frame& F, const Args& A, int l, int s, int c, int h) {
    constexpr int MODE = 0; constexpr bool sample = false;
    unsigned char* ws = A.ws;
    LAS float* TAB = (LAS float*)(F.lds + F.wave * 15360);
    LAS float* XC = TAB + 512;
    LAS float* AA = XC + 16 * 68;
    LAS float* BB = AA + 16 * 68;
    const int lane = F.lane, fr = lane & 15, fq = lane >> 4, ch0 = 64 * h;
    const bf16* RX = (const bf16*)(ws + WS_RX); bf16* RY = (bf16*)(ws + WS_RY);
    {
        const int chg = l * DM + ch0 + lane;
#pragma unroll
        for (int j = 0; j < 4; ++j) TAB[j * 64 + lane] = A.in[15][(size_t)(l * 4 + j) * DM + ch0 + lane];
        TAB[4 * 64 + lane] = A.in[16][chg]; TAB[5 * 64 + lane] = A.in[18][chg]; TAB[6 * 64 + lane] = A.in[20][chg];
        const float lam = A.in[21][chg]; TAB[7 * 64 + lane] = -8.f * 1.44269504f * log1pf(expf(-lam));
    }
    bf16x8 Wf[2][4][2];
    { const bf16* WG = (const bf16*)(ws + WS_SMALL + SM_WG);
#pragma unroll
      for (int g = 0; g < 2; ++g)
#pragma unroll
        for (int n = 0; n < 4; ++n)
#pragma unroll
            for (int k = 0; k < 2; ++k) Wf[g][n][k] = *(const bf16x8*)(WG + ((h * 2 + g) * 64 + 16 * n + fr) * 64 + 32 * k + 8 * fq); }
    LDS_WAIT(); asm volatile("" ::: "memory");
    const int rbase = s * TP + c * TC;
    bf16* XQ = (bf16*)(ws + WS_XN);
    float hst = 0.f, aprod = 1.f;
    if (MODE == 1 && !sample) {
        const float* AG = (const float*)(ws + WS_AGGRG) + ((size_t)(s * NCH) * DM + ch0 + lane) * 2;
        for (int cc = 0; cc < c; ++cc) { const float a = AG[(size_t)cc * DM * 2], b = AG[(size_t)cc * DM * 2 + 1]; hst = a * hst + b; }
    }
    v4u nx[2][4]; unsigned short nry[16];
#define RG_LOAD_RX(tl) do { const int row_ = rbase + 16 * (tl) + fr, t_ = c * TC + 16 * (tl) + fr; \
        _Pragma("unroll") for (int k = 0; k < 2; ++k) _Pragma("unroll") for (int d = 0; d < 4; ++d) nx[k][d] = *(const v4u*)(RX + (size_t)(t_ - d >= 0 ? row_ - d : row_) * DM + ch0 + 32 * k + 8 * fq); } while (0)
#define RG_LOAD_RY(tl) do { _Pragma("unroll") for (int tt = 0; tt < 16; ++tt) nry[tt] = RY[(size_t)(rbase + 16 * (tl) + tt) * DM + ch0 + lane]; } while (0)
    RG_LOAD_RX(0); RG_LOAD_RY(0);
#pragma unroll 1
    for (int tile = 0; tile < 8; ++tile) {
        const int row = rbase + 16 * tile + fr;
        const int t = c * TC + 16 * tile + fr;
        const int sq = sample ? s * 16 + tile * 2 + (fr >> 3) : s;
        bf16x8 X[2];
#pragma unroll
        for (int k = 0; k < 2; ++k) {
            const int cl = 32 * k + 8 * fq; float xc[8];
            { const f32x4 b0 = *(const LAS f32x4*)(TAB + 4 * 64 + cl), b1 = *(const LAS f32x4*)(TAB + 4 * 64 + cl + 4); xc[0] = b0.x; xc[1] = b0.y; xc[2] = b0.z; xc[3] = b0.w; xc[4] = b1.x; xc[5] = b1.y; xc[6] = b1.z; xc[7] = b1.w; }
#pragma unroll
            for (int d = 0; d < 4; ++d) {
                float v[8];
                { v4u w_ = nx[k][d]; if (t - d < 0) w_ = (v4u){0u, 0u, 0u, 0u}; cvt8(w_, v); }
                const f32x4 w0 = *(const LAS f32x4*)(TAB + (3 - d) * 64 + cl), w1 = *(const LAS f32x4*)(TAB + (3 - d) * 64 + cl + 4);
                xc[0] += w0.x * v[0]; xc[1] += w0.y * v[1]; xc[2] += w0.z * v[2]; xc[3] += w0.w * v[3]; xc[4] += w1.x * v[4]; xc[5] += w1.y * v[5]; xc[6] += w1.z * v[6]; xc[7] += w1.w * v[7];
            }
            *(LAS f32x4*)(XC + fr * 68 + cl) = (f32x4){xc[0], xc[1], xc[2], xc[3]}; *(LAS f32x4*)(XC + fr * 68 + cl + 4) = (f32x4){xc[4], xc[5], xc[6], xc[7]};
            v4u pk; pk.x = pk2(xc[0], xc[1]); pk.y = pk2(xc[2], xc[3]); pk.z = pk2(xc[4], xc[5]); pk.w = pk2(xc[6], xc[7]);
            X[k] = __builtin_bit_cast(bf16x8, pk);
        }
        if (tile < 7) RG_LOAD_RX(tile + 1);
        f32x4 acc[2][4];
#pragma unroll
        for (int g = 0; g < 2; ++g)
#pragma unroll
            for (int n = 0; n < 4; ++n) { acc[g][n] = (f32x4){0.f, 0.f, 0.f, 0.f};
#pragma unroll
                for (int k = 0; k < 2; ++k) acc[g][n] = __builtin_amdgcn_mfma_f32_16x16x32_bf16(Wf[g][n][k], X[k], acc[g][n], 0, 0, 0); }
        LDS_WAIT(); asm volatile("" ::: "memory");
#pragma unroll
        for (int n = 0; n < 4; ++n) { const int cl = 16 * n + 4 * fq;
            const f32x4 xv = *(const LAS f32x4*)(XC + fr * 68 + cl), ba = *(const LAS f32x4*)(TAB + 5 * 64 + cl), bx = *(const LAS f32x4*)(TAB + 6 * 64 + cl), c8 = *(const LAS f32x4*)(TAB + 7 * 64 + cl);
            f32x4 av, bv;
#pragma unroll
            for (int j = 0; j < 4; ++j) { const float r = fsig(acc[0][n][j] + ba[j]), ig = fsig(acc[1][n][j] + bx[j]); const float a = __builtin_amdgcn_exp2f(r * c8[j]);
                av[j] = a; bv[j] = __builtin_amdgcn_sqrtf(fmaxf(1.f - a * a, 0.f)) * ig * xv[j]; }
            *(LAS f32x4*)(AA + fr * 68 + cl) = av; *(LAS f32x4*)(BB + fr * 68 + cl) = bv; }
        LDS_WAIT(); asm volatile("" ::: "memory");
#pragma unroll
        for (int tt = 0; tt < 16; ++tt) {
            const float a = AA[tt * 68 + lane], b = BB[tt * 68 + lane];
            hst = a * hst + b; aprod *= a;
            const float g = fgelu(bf2f(nry[tt]));
            const size_t o = (size_t)(rbase + 16 * tile + tt) * DM + ch0 + lane; const unsigned pq = pk2(hst * g, aprod * g); RY[o] = (bf16)(pq & 0xffffu); XQ[o] = (bf16)(pq >> 16);
        }
        if (tile < 7) RG_LOAD_RY(tile + 1);
        LDS_WAIT(); asm volatile("" ::: "memory");
    }
    unsigned long long* AGT = (unsigned long long*)(ws + WS_AGT) + ((size_t)(l * 128 + s * 16 + h) * 16) * 64 + lane;
    __hip_atomic_store(AGT + (size_t)c * 64, ((unsigned long long)__float_as_uint(hst) << 32) | __float_as_uint(fmaxf(aprod, 1e-30f)), __ATOMIC_RELAXED, __HIP_MEMORY_SCOPE_AGENT);
}
__device__ __forceinline__ void rg_unit_sp2(const Frame& F, const Args& A, int l, int s, int c, int h) {
    unsigned char* ws = A.ws;
    const int lane = F.lane, ch0 = 64 * h;
    const bf16* RX = (const bf16*)(ws + WS_RX); bf16* RY = (bf16*)(ws + WS_RY); bf16* XQ = (bf16*)(ws + WS_XN);
    const int rbase = s * TP + c * TC;
    unsigned long long* AGT = (unsigned long long*)(ws + WS_AGT) + ((size_t)(l * 128 + s * 16 + h) * 16) * 64 + lane;
    float hst, aprod; { const unsigned long long v = __hip_atomic_load(AGT + (size_t)c * 64, __ATOMIC_RELAXED, __HIP_MEMORY_SCOPE_AGENT); aprod = __uint_as_float((unsigned)v); hst = __uint_as_float((unsigned)(v >> 32)); }
    float hin = 0.f;
    {   unsigned long long av[NCH - 1];
#pragma unroll
        for (int cc = 0; cc < NCH - 1; ++cc) av[cc] = (cc < c) ? __hip_atomic_load(AGT + (size_t)cc * 64, __ATOMIC_RELAXED, __HIP_MEMORY_SCOPE_AGENT) : 0ull;
#pragma unroll
        for (int cc = 0; cc < NCH - 1; ++cc) if (cc < c) {
            unsigned long long v = av[cc]; unsigned sp_ = 0;
            while (!(__uint_as_float((unsigned)v) > 0.f) && sp_ < (1u << 22)) { __builtin_amdgcn_s_sleep(2); v = __hip_atomic_load(AGT + (size_t)cc * 64, __ATOMIC_RELAXED, __HIP_MEMORY_SCOPE_AGENT); ++sp_; }
            hin = __uint_as_float((unsigned)v) * hin + __uint_as_float((unsigned)(v >> 32));
        } }
    if (c > 0) {
        asm volatile("s_waitcnt vmcnt(0)" ::: "memory");
#pragma unroll 1
        for (int tile = 0; tile < 8; ++tile) {
            unsigned short pv[16], qv[16];
#pragma unroll
            for (int tt = 0; tt < 16; ++tt) { const size_t o = (size_t)(rbase + 16 * tile + tt) * DM + ch0 + lane; pv[tt] = RY[o]; qv[tt] = XQ[o]; }
#pragma unroll
            for (int tt = 0; tt < 16; ++tt) RY[(size_t)(rbase + 16 * tile + tt) * DM + ch0 + lane] = (bf16)f2bf(bf2f(pv[tt]) + bf2f(qv[tt]) * hin);
        }
    }
    if (c == NCH - 1) {
        A.out[O_PRGH + (size_t)(s * 2 + l) * DM + ch0 + lane] = hst + aprod * hin;
#pragma unroll
        for (int k = 0; k < 3; ++k) A.out[O_PRGC + (size_t)((s * 2 + l) * 3 + k) * DM + ch0 + lane] = bf2f(RX[(size_t)(s * TP + TP - 3 + k) * DM + ch0 + lane]);
    }
}

template <int MODE> __device__ __forceinline__ void s5_unit(const Frame& F, const Args& A, int l, bool sample, int s, int c, int g) {
    unsigned char* ws = A.ws;
    LAS float* BU = (LAS float*)(F.lds + F.wave * 15360);
    LAS bf16* XS = (LAS bf16*)(F.lds + F.wave * 15360 + 16 * 132 * 4);
    const int lane = F.lane, fr = lane & 15, fq = lane >> 4;
    bf16* SX = (bf16*)(ws + WS_SX);
    bf16x8 Bf[8], Cf[4];
    { const bf16* BBm = (const bf16*)(ws + WS_SMALL + SM_BBAR) + (size_t)g * 128 * 16;
#pragma unroll
      for (int n = 0; n < 8; ++n) { v4u z = {0u, 0u, 0u, 0u}; if (fq < 2) z = *(const v4u*)(BBm + (16 * n + fr) * 16 + 8 * fq); Bf[n] = __builtin_bit_cast(bf16x8, z); }
      const bf16* CM = (const bf16*)(ws + WS_SMALL + SM_CMAT) + (size_t)g * 16 * 128;
#pragma unroll
      for (int kk = 0; kk < 4; ++kk) Cf[kk] = *(const bf16x8*)(CM + fr * 128 + 32 * kk + 8 * fq); }
    const float ar = ((const float*)(ws + WS_SMALL + SM_ABAR))[(g * 64 + lane) * 2], ai = ((const float*)(ws + WS_SMALL + SM_ABAR))[(g * 64 + lane) * 2 + 1];
    const f32x4 dv = *(const f32x4*)(A.in[28] + l * 512 + 16 * g + 4 * fq);
    const int rbase = sample ? MP + s * 32 : s * TP + c * TC;
    float xr = 0.f, xi = 0.f;
    if (MODE == 1 && !sample) {
        const float tr = ((const float*)(ws + WS_SMALL + SM_ABARTC))[(g * 64 + lane) * 2], ti = ((const float*)(ws + WS_SMALL + SM_ABARTC))[(g * 64 + lane) * 2 + 1];
        const float* AG = (const float*)(ws + WS_AGGS5) + ((size_t)(s * NCH) * 2048 + g * 64 + lane) * 2;
        f32x2 ag[NCH - 1];
#pragma unroll
        for (int cc = 0; cc < NCH - 1; ++cc) ag[cc] = (cc < c) ? *(const f32x2*)(AG + (size_t)cc * 4096) : (f32x2){0.f, 0.f};
#pragma unroll
        for (int cc = 0; cc < NCH - 1; ++cc) if (cc < c) { const float nr = tr * xr - ti * xi + ag[cc].x, ni = tr * xi + ti * xr + ag[cc].y; xr = nr; xi = ni; }
    }
    const int ntile = sample ? 2 : 8;
#define S5_BU(uz_) do { const bf16x8 U_ = __builtin_bit_cast(bf16x8, uz_); _Pragma("unroll") for (int n = 0; n < 8; ++n) { \
        f32x4 a_ = __builtin_amdgcn_mfma_f32_16x16x32_bf16(Bf[n], U_, (f32x4){0.f, 0.f, 0.f, 0.f}, 0, 0, 0); *(LAS f32x4*)(BU + fr * 132 + 16 * n + 4 * fq) = a_; } } while (0)
    v4u un = {0u, 0u, 0u, 0u}; u32x2 sxc = {0u, 0u};
    { v4u u0 = {0u, 0u, 0u, 0u}; if (fq < 2) u0 = *(const v4u*)(SX + (size_t)(rbase + fr) * 512 + 16 * g + 8 * fq);
      if (fq < 2) un = *(const v4u*)(SX + (size_t)(rbase + 16 + fr) * 512 + 16 * g + 8 * fq);
      if (MODE == 1) sxc = *(const u32x2*)(SX + (size_t)(rbase + fr) * 512 + 16 * g + 4 * fq);
      S5_BU(u0); }
#pragma unroll 1
    for (int tile = 0; tile < ntile; ++tile) {
        const int row = rbase + 16 * tile + fr;
        LDS_WAIT(); asm volatile("" ::: "memory");
        float br[16], bi[16];
#pragma unroll
        for (int tt = 0; tt < 16; ++tt) { br[tt] = BU[tt * 132 + lane]; bi[tt] = BU[tt * 132 + 64 + lane]; }
        u32x2 sxn = {0u, 0u};
        if (tile + 1 < ntile) {
            S5_BU(un);
            if (tile + 2 < ntile && fq < 2) un = *(const v4u*)(SX + (size_t)(row + 32) * 512 + 16 * g + 8 * fq);
            if (MODE == 1) sxn = *(const u32x2*)(SX + (size_t)(row + 16) * 512 + 16 * g + 4 * fq);
        }
#pragma unroll
        for (int tt = 0; tt < 16; ++tt) {
            if (sample && (tt & 7) == 0) { const size_t si = ((size_t)((s * 4 + tile * 2 + (tt >> 3)) * 2 + l) * 32 + g) * 64 + lane; xr = A.in[4][si]; xi = A.in[5][si]; }
            const float nr = ar * xr - ai * xi + br[tt], ni = ar * xi + ai * xr + bi[tt]; xr = nr; xi = ni;
            if (MODE == 1) { const unsigned xx = pk2(xr, xi); XS[tt * 136 + lane] = (bf16)(xx & 0xffffu); XS[tt * 136 + 64 + lane] = (bf16)(xx >> 16); }
            if (MODE == 1 && sample && (tt & 7) == 7) { const size_t si = ((size_t)((s * 4 + tile * 2 + (tt >> 3)) * 2 + l) * 32 + g) * 64 + lane; A.out[O_SS5R + si] = xr; A.out[O_SS5I + si] = xi; }
        }
        if (MODE == 1) {
            LDS_WAIT(); asm volatile("" ::: "memory");
            f32x4 y = {0.f, 0.f, 0.f, 0.f};
#pragma unroll
            for (int kk = 0; kk < 4; ++kk) { const bf16x8 xb = *(const LAS bf16x8*)(XS + fr * 136 + 32 * kk + 8 * fq); y = __builtin_amdgcn_mfma_f32_16x16x32_bf16(Cf[kk], xb, y, 0, 0, 0); }
            bf16* p = SX + (size_t)row * 512 + 16 * g + 4 * fq; const u32x2 sx = sxc;
            u32x2 o; o.x = pk2(fgelu(y.x + dv.x * bflo(sx.x)), fgelu(y.y + dv.y * bfhi(sx.x))); o.y = pk2(fgelu(y.z + dv.z * bflo(sx.y)), fgelu(y.w + dv.w * bfhi(sx.y)));
            *(u32x2*)p = o;
        }
        sxc = sxn;
    }
    LDS_WAIT(); asm volatile("" ::: "memory");
#undef S5_BU
    if (MODE == 0) { float* AG = (float*)(ws + WS_AGGS5) + ((size_t)(s * NCH + c) * 2048 + g * 64 + lane) * 2; AG[0] = xr; AG[1] = xi; }
    if (MODE == 1 && !sample && c == NCH - 1) { const size_t si = ((size_t)(s * 2 + l) * 32 + g) * 64 + lane; A.out[O_PS5R + si] = xr; A.out[O_PS5I + si] = xi; }
}

template <int MODE> __device__ __forceinline__ void mixer_phase(const Frame& F0, const Args& A, int l, int qi, int b0) {
    const Frame F = refresh(F0);
    int bx_ = blockIdx.x; asm volatile("" : "+s"(bx_)); if (bx_ < b0) return;
    gu32* q = F.ctl + CW_Q + 64 * qi;
    constexpr int N_A = MODE == 0 ? 2048 : NSP * NCH * 32, N_B = MODE == 0 ? 32 * 16 : 32 * 32, N_C = MODE == 0 ? NSP * (NCH - 1) * 32 : 0;
    constexpr int NTOT = N_A + N_B + N_C;
    (void)q;
    const int nb_ = F.G - b0, bl_ = bx_ - b0, vb_ = (nb_ % 8 == 0) ? (bl_ % 8) * (nb_ / 8) + bl_ / 8 : bl_, gw = F.wave * nb_ + vb_, NGW = nb_ * NWAVES;
    for (int u0 = gw; u0 < NTOT; u0 += NGW) {
        int u = u0;
        if (MODE == 0) {
            if (u < N_A) { const int c = u >> 7, sh = u & 127; rg_unit_sp(F, A, l, sh >> 4, c, sh & 15); continue; } u -= N_A;
            if (u < N_B) { rg_unit<1>(F, A, l, true, u >> 4, 0, u & 15); continue; } u -= N_B;
            { const int g = u & 31, r = u >> 5, c = r % (NCH - 1), s2 = r / (NCH - 1); s5_unit<0>(F, A, l, false, s2, c, g); }
        } else {
            if (u < N_A) { const int g = u & 31, r = u >> 5, c = r % NCH, s2 = r / NCH; s5_unit<1>(F, A, l, false, s2, c, g); continue; } u -= N_A;
            s5_unit<1>(F, A, l, true, u >> 5, 0, u & 31);
        }
    }
    if (MODE == 0 && gw < N_A) { const int c = gw >> 7, sh = gw & 127; rg_unit_sp2(F, A, l, sh >> 4, c, sh & 15); }
}

__device__ __forceinline__ void ffn_fixup_local(const Frame& F0, const Args& A, int l, int pm) {
    const Frame F = refresh(F0);
    if (pm < 64 && (pm & 7) != 0) {
        const float* HALO = (const float*)(A.ws + WS_HALO); bf16* HF = (bf16*)(A.ws + WS_HFF);
        const float* cw = A.in[34] + (size_t)l * 3 * FF2; const float* cb = A.in[35] + (size_t)l * FF2;
        for (int c = F.tid; c < FF; c += NWAVES * 64) {
            float uc0[2], uc1[2];
#pragma unroll
            for (int bj = 0; bj < 2; ++bj) {
                const float a254 = HALO[((size_t)((pm - 1) * 4 + 0) * 2 + bj) * FF + c], a255 = HALO[((size_t)((pm - 1) * 4 + 1) * 2 + bj) * FF + c];
                const float r0 = HALO[((size_t)(pm * 4 + 2) * 2 + bj) * FF + c], r1 = HALO[((size_t)(pm * 4 + 3) * 2 + bj) * FF + c];
                const float w0 = cw[bj * FF + c], w1 = cw[FF2 + bj * FF + c], w2 = cw[2 * FF2 + bj * FF + c], b = cb[bj * FF + c];
                uc0[bj] = b + w0 * a254 + w1 * a255 + w2 * r0; uc1[bj] = b + w0 * a255 + w1 * r0 + w2 * r1;
            }
            HF[(size_t)(pm * 256) * FF + c] = (bf16)f2bf(fgelu(uc0[0]) * uc0[1]); HF[(size_t)(pm * 256 + 1) * FF + c] = (bf16)f2bf(fgelu(uc1[0]) * uc1[1]);
        }
    }
    asm volatile("s_waitcnt vmcnt(0)" ::: "memory"); __syncthreads();
}

__global__ void __launch_bounds__(NWAVES * 64, 2) hawk_fwd(Args args) {
    extern __shared__ __attribute__((aligned(16))) unsigned char lds[];
    Frame F;
    F.lds = (LAS unsigned char*)lds;
    F.MISC = (volatile LAS unsigned*)(F.lds + MISC_OFF);
    F.tid = threadIdx.x; F.lane = F.tid & 63; F.wave = __builtin_amdgcn_readfirstlane(F.tid >> 6);
    F.G = gridDim.x; { const int bx = blockIdx.x; F.vcu = (F.G % 8 == 0) ? (bx % 8) * (F.G / 8) + bx / 8 : bx; }
    unsigned char* ws = args.ws;
    F.ctl = (gu32*)(ws + WS_CTL);
    for (int u = F.tid; u < (LDS_BYTES - LDSCTL_OFF) / 4; u += NWAVES * 64) ((LAS unsigned*)(F.lds + LDSCTL_OFF))[u] = 0u;
    __syncthreads();
    XcdBarrier bar = xcd_barrier_post((unsigned*)(F.ctl + CW_BAR), F.MISC + 8);
#define GRID_BAR() xcd_barrier(bar)

#pragma unroll 1
    for (int st = 0; st < NST_MAX; ++st) {
        unsigned char* ws = args.ws; float* outp = args.out; asm volatile("" : "+s"(ws), "+s"(outp));
        bf16* XRB = (bf16*)(ws + WS_XRB); float* MOD = (float*)(ws + WS_MOD); bf16* XN = (bf16*)(ws + WS_XN); int bid = (int)blockIdx.x; asm volatile("" : "+s"(bid));
        const int l = st < 2 ? 0 : (st - 2) / 10, sub = st < 2 ? st - 2 : (st == 22 ? 99 : (st - 2) % 10);
        const int ll = st == 22 ? 1 : l;
        const float* xin_p = ll == 0 ? args.in[0] : nullptr; const float* xin_s = ll == 0 ? args.in[1] - (size_t)MP * DM : nullptr;
        const float* modl = MOD + ll * 6144;
        bool is_gemm = false; pg8::Gemm g{nullptr, nullptr, 0, 0, 0, 0, 0}; pg8::EpiAny E{0, false, ws, nullptr, nullptr, nullptr, nullptr, 0, ll, (PG8_LAS float*)(F.lds + XCH_OFF)};
        switch (sub) {
            case -1: is_gemm = true; g = pg8::Gemm{(const pg8::bf16_t*)(ws + WS_SILUC), (const pg8::bf16_t*)(ws + WS_WADA), 256, MODW, DM, DM, DM}; E.mode = pg8::EM_ADA; E.perm = false; E.p0 = args.in[10]; E.out = MOD; break;
            case 1: is_gemm = true; g = pg8::Gemm{(const pg8::bf16_t*)XN, (const pg8::bf16_t*)(ws + WS_WIN), MROWS, INW, DM, DM, DM}; E.mode = pg8::EM_IN; E.perm = true; E.p0 = args.in[14] + l * INW; break;
            case 3: case 4: is_gemm = true; g = pg8::Gemm{(const pg8::bf16_t*)(ws + WS_RY), (const pg8::bf16_t*)(ws + WS_WRG), MROWS, DM, DM, DM, DM}; E.mode = pg8::EM_RGP; E.perm = true; break;
            case 5: is_gemm = true; g = pg8::Gemm{(const pg8::bf16_t*)(ws + WS_SX), (const pg8::bf16_t*)(ws + WS_WGLU), MROWS, 2048, 512, 512, 512}; E.mode = pg8::EM_GLU; E.perm = true; break;
            case 6: is_gemm = true; g = pg8::Gemm{(const pg8::bf16_t*)(ws + WS_GA), (const pg8::bf16_t*)(ws + WS_WOUT), MROWS, DM, DM, DM, DM}; E.mode = pg8::EM_RES; E.perm = true; E.p0 = xin_p; E.p2 = modl + 2048; E.row_off = 0; break;
            case 8: is_gemm = true; g = pg8::Gemm{(const pg8::bf16_t*)XN, (const pg8::bf16_t*)(ws + WS_WUP), MROWS, FF2, DM, DM, DM}; E.mode = pg8::EM_UPF; E.perm = true; E.p0 = args.in[34] + (size_t)l * 3 * FF2; E.p1 = args.in[35] + (size_t)l * FF2; E.p2 = args.in[6]; E.out = outp; break;
            case 9: is_gemm = true; g = pg8::Gemm{(const pg8::bf16_t*)(ws + WS_HFF), (const pg8::bf16_t*)(ws + WS_WDOWN), MROWS, DM, FF, FF, FF}; E.mode = pg8::EM_RES; E.perm = true; E.p0 = nullptr; E.p2 = modl + 5120; E.row_off = 1; break;
            default: break;
        }
#ifndef DUP
#define DUP 0
#endif
        const int nrep = (DUP == 1 && sub == 2) || (DUP == 2 && (st == 0 || (sub == 0 && l == 1))) || (DUP == 3 && sub == 8) || (DUP == 4 && (sub == 0 || sub == 7)) || (DUP == 5 && sub == 1) || (DUP == 6 && sub == 6 && l == 0) || (DUP == 7 && ((sub == 0 && l == 0 && st >= 2) || sub == 9)) ? 2 : 1;
#pragma unroll 1
        for (int rep = 0; rep < nrep; ++rep) {
        if (rep == 1) GRID_BAR();
        if (st < 2 || (sub == 0 && l == 1)) p0_weights(F, args, l, st == 0 ? 0 : 1, st == 1 ? 48 : 0, st == 1 ? F.G - 48 : F.G);
        if (sub == 0 || sub == 7) norm_rows(F, sub == 0 ? xin_p : nullptr, sub == 0 ? xin_s : nullptr, XRB, (sub == 0 ? args.in[11] : args.in[12]) + l * DM, modl + (sub == 0 ? 0 : 3072), modl + (sub == 0 ? 1024 : 4096), XN,
                                            sub == 7 ? 4 : (l == 1 ? 12 : 0), sub == 7 ? modl + 2048 : MOD + 5120, (const float*)(ws + (sub == 7 ? WS_PART_OUT : WS_PART_DOWN)));
        if (sub == 2) mixer_phase<0>(F, args, l, l * 2 + rep * 4, 0);
        if (sub == 3) mixer_phase<1>(F, args, l, l * 2 + 1, 16);
        if (is_gemm) { pg8::SplitOrder S; S.init(g.M, g.N, g.K, F.G, bid, (sub == 6 || sub == 9) ? 1 : (sub == 4 ? 2 : (sub == 3 ? 3 : 0)), 256);
            if (sub == 9) { pg8::Unit u0; ffn_fixup_local(F, args, l, S.next(0, u0) ? u0.pm : 64); } pg8::gemm_phase<pg8::EpiAny, pg8::SplitOrder, true, true>(F.lds, g, S, E); }
        }
        if (sub == 99) final_norm(F, XRB, outp + O_Y, args.in[37], 12, MOD + 6144 + 5120, (const float*)(ws + WS_PART_DOWN)); else GRID_BAR();
    }
}

extern "C" void kernel_launch(void* const* d_in, const int* in_sizes, int n_in, void* d_out, int out_size, void* d_ws, size_t ws_size, hipStream_t stream) {
    static int grid = 0;
    if (grid == 0) {
        if (n_in != 38 || out_size != 23396352 || ws_size < WS_END) { fprintf(stderr, "kernel_launch: unexpected shapes (n_in %d out %d ws %zu)\n", n_in, out_size, ws_size); grid = -1; return; }
        int dev = 0, cus = 0, per_cu = 0;
        if (hipGetDevice(&dev) != hipSuccess || hipDeviceGetAttribute(&cus, hipDeviceAttributeMultiprocessorCount, dev) != hipSuccess) { grid = -1; return; }
        if (hipFuncSetAttribute((const void*)hawk_fwd, hipFuncAttributeMaxDynamicSharedMemorySize, LDS_BYTES) != hipSuccess) { fprintf(stderr, "kernel_launch: hipFuncSetAttribute failed\n"); grid = -1; return; }
        if (hipOccupancyMaxActiveBlocksPerMultiprocessor(&per_cu, (const void*)hawk_fwd, NWAVES * 64, LDS_BYTES) != hipSuccess || per_cu < 1) { fprintf(stderr, "kernel_launch: occupancy query says %d\n", per_cu); per_cu = 1; }
        (void)hipGetLastError();
        grid = cus;
    }
    if (grid < 0) return;
    if (hipMemsetAsync((char*)d_ws + WS_CTL, 0, CTL_ZERO_BYTES, stream) != hipSuccess) { fprintf(stderr, "kernel_launch: memset failed\n"); return; }
    if (hipMemsetAsync((char*)d_ws + WS_AGT, 0, 2 * MiB, stream) != hipSuccess) { fprintf(stderr, "kernel_launch: memset 2 failed\n"); return; }
    Args a{};
    for (int i = 0; i < 38; ++i) a.in[i] = (const float*)d_in[i];
    a.out = (float*)d_out; a.ws = (unsigned char*)d_ws;
    hipLaunchKernelGGL(hawk_fwd, dim3(grid), dim3(NWAVES * 64), LDS_BYTES, stream, a);
}
```

```cpp
#include <hip/hip_runtime.h>
#include <cstdio>
#include <cstdint>
namespace pg8 {
#define PG8_LAS __attribute__((address_space(3)))
typedef unsigned short bf16_t;
typedef short bf16x8 __attribute__((ext_vector_type(8)));
typedef float f32x4 __attribute__((ext_vector_type(4)));
typedef unsigned u32x4 __attribute__((ext_vector_type(4)));
constexpr int BM = 256, BK = 64, HALF = 128, HTB = HALF * BK * 2  , STAGE_BYTES = 8 * HTB, NXCD = 8, WGM = 8;

__host__ __device__ __forceinline__ int lds_byte(int r, int c) { const int st = (r >> 4) * 2 + (c >> 5), rr = r & 15, cc = c & 31, ob = rr * 64 + cc * 2; return st * 1024 + (ob ^ (((ob >> 9) & 1) << 5)); }
__host__ __device__ __forceinline__ void stage_rc(int b, int& R, int& C) { const int st = b / 1024, sb = b % 1024, swz = sb ^ (((sb >> 9) & 1) << 5); R = (st >> 1) * 16 + swz / 64; C = (st & 1) * 32 + (swz % 64) / 2; }
__host__ __device__ __forceinline__ int perm32(int rho) { const int n = rho >> 4, i = rho & 15; return 8 * (i >> 2) + 4 * n + (i & 3); }

struct Unit { int pm, pn, koff, nt, mini, ksl; };
struct Gemm { const bf16_t* A; const bf16_t* Bt; int M, N, K, lda, ldb; };

struct StaticOrder {
    int nM, nN, nwg, G, c, ntK;
    __host__ __device__ void init(int M, int N, int G_, int c_, int K_ = 128) { nM = M / BM; nN = N / BM; nwg = nM * nN; G = G_; c = c_; ntK = K_ / BK; }
    __host__ __device__ bool next(int i, Unit& u) const {
        const long L = (long)i * G + c; if (L >= nwg) return false;
        int wgid = (int)L; { const int q = nwg / NXCD, r = nwg % NXCD, xcd = wgid % NXCD, off = wgid / NXCD; wgid = (xcd < r ? xcd * (q + 1) : r * (q + 1) + (xcd - r) * q) + off; }
        const int nig = WGM * nN, gid = wgid / nig, fm = gid * WGM, gsz = (nM - fm) < WGM ? (nM - fm) : WGM;
        u.pm = fm + ((wgid % nig) % gsz); u.pn = (wgid % nig) / gsz; u.koff = 0; u.nt = ntK; u.mini = 0; u.ksl = 256; return true;
    }
    __device__ __forceinline__ void a_ready(const Unit&) const {}
    __device__ __forceinline__ void done(const Unit&) const {}
};
struct SplitOrder {
    StaticOrder so; int nslice, nmini, rounds, smode, ksl;
    __device__ void init(int M, int N, int K, int G_, int c_, int smode_, int ksl_) { smode = smode_; ksl = ksl_; so.init(smode_ == 0 ? M : 16384, N, G_, c_, K); nslice = K / ksl_; nmini = smode_ == 1 ? 4 * (N / BM) * nslice : 0; rounds = (so.nwg + G_ - 1) / G_; }
    __device__ bool next(int i, Unit& u) const {
        const long L = (long)i * so.G + so.c;
        if (smode == 3) { if (L >= 4 * so.nN) return false; u.pm = 64 + (int)L / so.nN; u.pn = (int)L % so.nN; u.koff = 0; u.nt = so.ntK; u.mini = 0; u.ksl = 256; return true; }
        if (L < so.nwg) return so.next(i, u);
        const int mm = (int)(L - so.nwg);
        if (mm >= nmini) return false;
        const int kc = mm % nslice, t16 = mm / nslice; u.pm = 64 + t16 / so.nN; u.pn = t16 % so.nN; u.koff = kc * ksl; u.nt = ksl / BK; u.mini = 1; u.ksl = ksl; return true;
    }
    __device__ __forceinline__ void a_ready(const Unit&) const {}
    __device__ __forceinline__ void done(const Unit&) const {}
};


__device__ __forceinline__ unsigned cvt_pk_bf16(float lo, float hi) { unsigned r; asm volatile("v_cvt_pk_bf16_f32 %0, %1, %2" : "=v"(r) : "v"(lo), "v"(hi)); return r; }
typedef float f32x2 __attribute__((ext_vector_type(2)));
__device__ __forceinline__ f32x2 gelu_pk(f32x2 v) {
    const f32x2 av = __builtin_elementwise_abs(v), d = av * 0.2316418882f + 1.0f;
    f32x2 t; t.x = __builtin_amdgcn_rcpf(d.x); t.y = __builtin_amdgcn_rcpf(d.y);
    f32x2 q = t * 0.5307027145f + (-0.7265760135f); q = q * t + 0.7107068705f; q = q * t + (-0.142248368f); q = q * t + 0.127414796f; q = q * t;
    const f32x2 s = (v * v) * (-0.72134752044f);
    f32x2 e; e.x = __builtin_amdgcn_exp2f(s.x); e.y = __builtin_amdgcn_exp2f(s.y);
    const f32x2 m = v * (q * e), r = v - m;
    f32x2 o; o.x = v.x < 0.f ? m.x : r.x; o.y = v.y < 0.f ? m.y : r.y; return o;
}

template <int ACT  > struct EpiBf16 {
    static constexpr bool PERM = true, AFTER_DRAIN = false; static_assert(ACT == 0 || ACT == 1, "EpiBf16: ACT is 0 (none) or 1 (gelu_pk)");
    bf16_t* O; int ldc; const float* bias; int split_cols; size_t split_stride; float scale0;
    __device__ __forceinline__ void operator()(const f32x4 (&acc)[2][2][4][2], const Unit& u, int wr, int wc, int fr, int fq) const {
        const int row0 = u.pm * BM + wr * 64 + fr; int colt = u.pn * BM; bf16_t* base = O;
        float sc = 1.f; if (split_cols) { const int t = colt / split_cols; base += (size_t)t * split_stride; colt -= t * split_cols; if (t == 0) sc = scale0; }
        const int col0 = colt + wc * 32 + 8 * fq, bcol0 = u.pn * BM + wc * 32 + 8 * fq;
        f32x4 bv[2][2];
#pragma unroll
        for (int bj = 0; bj < 2; ++bj)
#pragma unroll
            for (int n = 0; n < 2; ++n) bv[bj][n] = bias ? *(const f32x4*)(bias + bcol0 + bj * HALF + 4 * n) : (f32x4){0.f, 0.f, 0.f, 0.f};
#pragma unroll
        for (int ai = 0; ai < 2; ++ai)
#pragma unroll
            for (int m = 0; m < 4; ++m) { bf16_t* rowp = base + (size_t)(row0 + ai * HALF + m * 16) * ldc + col0;
#pragma unroll
                for (int bj = 0; bj < 2; ++bj) { f32x4 v0 = acc[ai][bj][m][0] + bv[bj][0], v1 = acc[ai][bj][m][1] + bv[bj][1];
                    if (ACT == 1) { f32x2 a = gelu_pk((f32x2){v0[0], v0[1]}), b = gelu_pk((f32x2){v0[2], v0[3]}), c = gelu_pk((f32x2){v1[0], v1[1]}), d = gelu_pk((f32x2){v1[2], v1[3]});
                        v0 = (f32x4){a.x, a.y, b.x, b.y}; v1 = (f32x4){c.x, c.y, d.x, d.y}; }
                    v0 = v0 * sc; v1 = v1 * sc; u32x4 w; w.x = cvt_pk_bf16(v0[0], v0[1]); w.y = cvt_pk_bf16(v0[2], v0[3]); w.z = cvt_pk_bf16(v1[0], v1[1]); w.w = cvt_pk_bf16(v1[2], v1[3]);
                    *(u32x4*)(rowp + bj * HALF) = w; } }
    }
};

template <class Epi, class Sched, bool ALIGN_EPI, bool SP2>
__device__ __forceinline__ void gemm_phase(PG8_LAS unsigned char* lds, const Gemm g, const Sched& S, const Epi& E) {
    int tid_ = threadIdx.x; asm volatile("" : "+v"(tid_));
    const int tid = tid_, wid = __builtin_amdgcn_readfirstlane(tid >> 6), lane = tid & 63, wr = wid >> 2, wc = wid & 3, fr = lane & 15, fq = lane >> 4;
    const int lda = g.lda, ldb = g.ldb;
    unsigned voffA[2], voffB[2];
#pragma unroll
    for (int i = 0; i < 2; ++i) { int R, C; stage_rc(tid * 16 + i * 8192, R, C); const int Rb = E.perm ? ((R & ~31) + perm32(R & 31)) : R;
        voffA[i] = (unsigned)(R * lda + C) * 2u; voffB[i] = (unsigned)(Rb * ldb + C) * 2u; }
    const size_t kstep = (size_t)(BK * 2);
    const size_t hstepA = (size_t)HALF * lda * 2, hstepB = (size_t)HALF * ldb * 2;
    const size_t tstepA = 2 * hstepA, tstepB = 2 * hstepB;
    const unsigned ldsw = (unsigned)wid * 1024u;
    const int aoff = lds_byte(wr * 64 + fr, fq * 8), boff = lds_byte(wc * 32 + fr, fq * 8);
#define PG8_SA(b, h) (((b) * 2 + (h)) * HTB)
#define PG8_SB(b, h) ((4 + (b) * 2 + (h)) * HTB)
#define PG8_STAGE(bufoff, gbase, voff) do { _Pragma("unroll") for (int _i = 0; _i < 2; ++_i) \
        __builtin_amdgcn_global_load_lds((const unsigned*)((const char*)(gbase) + (voff)[_i]), (PG8_LAS unsigned*)(lds + (bufoff) + ldsw + _i * 8192), 16, 0, 0); } while (0)
#define PG8_LDA(dst, b, h) do { _Pragma("unroll") for (int m = 0; m < 4; ++m) _Pragma("unroll") for (int k = 0; k < 2; ++k) dst[m][k] = *(const PG8_LAS bf16x8*)(lds + PG8_SA(b, h) + aoff + m * 2048 + k * 1024); } while (0)
#define PG8_LDB(dst, b, h) do { _Pragma("unroll") for (int n = 0; n < 2; ++n) _Pragma("unroll") for (int k = 0; k < 2; ++k) dst[n][k] = *(const PG8_LAS bf16x8*)(lds + PG8_SB(b, h) + boff + n * 2048 + k * 1024); } while (0)
#define PG8_MMA(ai, bj, At, Bt) do { __builtin_amdgcn_s_setprio(1); _Pragma("unroll") for (int m = 0; m < 4; ++m) _Pragma("unroll") for (int n = 0; n < 2; ++n) _Pragma("unroll") for (int k = 0; k < 2; ++k) \
        acc[ai][bj][m][n] = __builtin_amdgcn_mfma_f32_16x16x32_bf16(Bt[n][k], At[m][k], acc[ai][bj][m][n], 0, 0, 0); __builtin_amdgcn_s_setprio(0); } while (0)
#define PG8_WAIT_V(n) asm volatile("s_waitcnt vmcnt(" #n ")" ::: "memory")
#define PG8_WAIT_L(n) asm volatile("s_waitcnt lgkmcnt(" #n ")" ::: "memory")
#define PG8_BAR __builtin_amdgcn_s_barrier()
#define PG8_SCHED __builtin_amdgcn_sched_barrier(0)
    Unit cur, nxt; int ui = 0;
    if (!S.next(0, cur)) return;
    f32x4 acc[2][2][4][2];
#pragma unroll
    for (int a = 0; a < 2; ++a)
#pragma unroll
        for (int b = 0; b < 2; ++b)
#pragma unroll
            for (int m = 0; m < 4; ++m)
#pragma unroll
                for (int n = 0; n < 2; ++n) acc[a][b][m][n] = (f32x4){0.f, 0.f, 0.f, 0.f};
    bf16x8 At[4][2], B0[2][2], B1[2][2];
    const char* cA = (const char*)g.A + (size_t)cur.pm * tstepA + (size_t)cur.koff * 2; const char* cB = (const char*)g.Bt + (size_t)cur.pn * tstepB + (size_t)cur.koff * 2;
    S.a_ready(cur);
    if constexpr (SP2) {
        PG8_STAGE(PG8_SB(0, 0), cB, voffB); PG8_STAGE(PG8_SB(0, 1), cB + hstepB, voffB); PG8_STAGE(PG8_SA(0, 0), cA, voffA); PG8_STAGE(PG8_SA(0, 1), cA + hstepA, voffA);
        if (wr == 1) PG8_BAR;
        PG8_WAIT_V(2); PG8_BAR;
        PG8_STAGE(PG8_SB(1, 0), cB + kstep, voffB); PG8_STAGE(PG8_SA(1, 0), cA + kstep, voffA); PG8_STAGE(PG8_SB(1, 1), cB + hstepB + kstep, voffB);
        PG8_WAIT_V(6); PG8_BAR;
    } else {
        PG8_STAGE(PG8_SB(0, 0), cB, voffB); PG8_STAGE(PG8_SA(0, 0), cA, voffA); PG8_STAGE(PG8_SB(0, 1), cB + hstepB, voffB); PG8_STAGE(PG8_SA(0, 1), cA + hstepA, voffA);
        if (wr == 1) PG8_BAR;
        PG8_WAIT_V(4); PG8_BAR;
        PG8_STAGE(PG8_SB(1, 0), cB + kstep, voffB); PG8_STAGE(PG8_SA(1, 0), cA + kstep, voffA); PG8_STAGE(PG8_SB(1, 1), cB + hstepB + kstep, voffB);
        PG8_WAIT_V(6); PG8_BAR;
    }
    for (;;) {
        const bool has_next = S.next(ui + 1, nxt);
        const char* nA = has_next ? (const char*)g.A + (size_t)nxt.pm * tstepA + (size_t)nxt.koff * 2 : cA; const char* nB = has_next ? (const char*)g.Bt + (size_t)nxt.pn * tstepB + (size_t)nxt.koff * 2 : cB;
        const int nt = cur.nt;
        for (int t = 0; t < nt; t += 2) {
            const bool last = (t == nt - 2);
            const char* a1 = cA + (size_t)(t + 1) * kstep;
            const char* a2 = last ? nA : cA + (size_t)(t + 2) * kstep; const char* b2 = last ? nB : cB + (size_t)(t + 2) * kstep;
            const char* a3 = a2 + kstep; const char* b3 = b2 + kstep;
            if (last && has_next) S.a_ready(nxt);
            if constexpr (SP2) {
            PG8_LDB(B0, 0, 0); PG8_LDB(B1, 0, 1); PG8_SCHED; PG8_LDA(At, 0, 0); PG8_STAGE(PG8_SA(1, 1), a1 + hstepA, voffA);
            PG8_WAIT_V(8); PG8_WAIT_L(0); PG8_BAR; PG8_MMA(0, 0, At, B0); PG8_MMA(0, 1, At, B1); PG8_BAR; PG8_SCHED;
            PG8_LDA(At, 0, 1); PG8_STAGE(PG8_SB(0, 0), b2, voffB); PG8_STAGE(PG8_SB(0, 1), b2 + hstepB, voffB); PG8_STAGE(PG8_SA(0, 0), a2, voffA);
            PG8_WAIT_V(8); PG8_WAIT_L(0); PG8_BAR; PG8_MMA(1, 0, At, B0); PG8_MMA(1, 1, At, B1); PG8_BAR; PG8_SCHED;
            PG8_LDB(B0, 1, 0); PG8_LDB(B1, 1, 1); PG8_SCHED; PG8_LDA(At, 1, 0); PG8_STAGE(PG8_SA(0, 1), a2 + hstepA, voffA);
            PG8_WAIT_V(8); PG8_WAIT_L(0); PG8_BAR; PG8_MMA(0, 0, At, B0); PG8_MMA(0, 1, At, B1); PG8_BAR; PG8_SCHED;
            PG8_LDA(At, 1, 1); PG8_STAGE(PG8_SB(1, 0), b3, voffB); PG8_STAGE(PG8_SB(1, 1), b3 + hstepB, voffB); PG8_STAGE(PG8_SA(1, 0), a3, voffA);
            PG8_WAIT_V(8); PG8_WAIT_L(0); PG8_BAR; PG8_MMA(1, 0, At, B0); PG8_MMA(1, 1, At, B1); PG8_BAR; PG8_SCHED;
            } else {
            PG8_LDB(B0, 0, 0); PG8_SCHED; PG8_LDA(At, 0, 0); PG8_STAGE(PG8_SA(1, 1), a1 + hstepA, voffA);
            PG8_WAIT_L(8); PG8_BAR; PG8_WAIT_L(0); PG8_MMA(0, 0, At, B0); PG8_BAR; PG8_SCHED;
            PG8_LDB(B1, 0, 1); PG8_STAGE(PG8_SB(0, 0), b2, voffB);
            PG8_BAR; PG8_WAIT_L(0); PG8_MMA(0, 1, At, B1); PG8_BAR;
            PG8_LDA(At, 0, 1); PG8_STAGE(PG8_SA(0, 0), a2, voffA);
            PG8_BAR; PG8_WAIT_L(0); PG8_MMA(1, 0, At, B0); PG8_BAR; PG8_SCHED;
            PG8_STAGE(PG8_SB(0, 1), b2 + hstepB, voffB);
            PG8_WAIT_V(6); PG8_BAR; PG8_MMA(1, 1, At, B1); PG8_BAR;
            PG8_LDB(B0, 1, 0); PG8_SCHED; PG8_LDA(At, 1, 0); PG8_STAGE(PG8_SA(0, 1), a2 + hstepA, voffA);
            PG8_WAIT_L(8); PG8_BAR; PG8_WAIT_L(0); PG8_MMA(0, 0, At, B0); PG8_BAR; PG8_SCHED;
            PG8_LDB(B1, 1, 1); PG8_STAGE(PG8_SB(1, 0), b3, voffB);
            PG8_BAR; PG8_WAIT_L(0); PG8_MMA(0, 1, At, B1); PG8_BAR;
            PG8_LDA(At, 1, 1); PG8_STAGE(PG8_SA(1, 0), a3, voffA);
            PG8_BAR; PG8_WAIT_L(0); PG8_MMA(1, 0, At, B0); PG8_BAR; PG8_SCHED;
            PG8_STAGE(PG8_SB(1, 1), b3 + hstepB, voffB);
            PG8_WAIT_V(6); PG8_BAR; PG8_MMA(1, 1, At, B1); PG8_BAR;
            }
        }
        if constexpr (ALIGN_EPI) { if (wr == 0) PG8_BAR; }
        if constexpr (!Epi::AFTER_DRAIN) { E(acc, cur, wr, wc, fr, fq); S.done(cur); }
        if (!has_next) break;
#pragma unroll
        for (int a = 0; a < 2; ++a)
#pragma unroll
            for (int b = 0; b < 2; ++b)
#pragma unroll
                for (int m = 0; m < 4; ++m)
#pragma unroll
                    for (int n = 0; n < 2; ++n) acc[a][b][m][n] = (f32x4){0.f, 0.f, 0.f, 0.f};
        cur = nxt; cA = nA; cB = nB; ++ui;
        if constexpr (ALIGN_EPI) { if (wr == 1) PG8_BAR; }
    }
    PG8_WAIT_V(0);
    if constexpr (!ALIGN_EPI) { if (wr == 0) PG8_BAR; }
    PG8_BAR;
    if constexpr (Epi::AFTER_DRAIN) { E.fused(acc, cur, wr, wc, fr, fq, lds, wid, lane); S.done(cur); }
#undef PG8_SA
#undef PG8_SB
#undef PG8_STAGE
#undef PG8_LDA
#undef PG8_LDB
#undef PG8_MMA
#undef PG8_WAIT_V
#undef PG8_WAIT_L
#undef PG8_BAR
#undef PG8_SCHED
}
}
#define GAS __attribute__((address_space(1)))
#define LAS __attribute__((address_space(3)))
typedef unsigned short bf16;
typedef unsigned v4u __attribute__((ext_vector_type(4)));
typedef float f32x4 __attribute__((ext_vector_type(4)));
typedef short bf16x8 __attribute__((ext_vector_type(8)));
typedef GAS unsigned gu32;
typedef GAS unsigned long long gu64;
#define RLX_AGENT __ATOMIC_RELAXED, __HIP_MEMORY_SCOPE_AGENT
#define LDS_WAIT() asm volatile("s_waitcnt lgkmcnt(0)" ::: "memory")
#define VM_WAIT() asm volatile("s_waitcnt vmcnt(0)" ::: "memory")
__device__ __forceinline__ unsigned long long rt() { return __builtin_amdgcn_s_memrealtime(); }
__device__ __forceinline__ unsigned pk2(float lo, float hi) { unsigned r; asm("v_cvt_pk_bf16_f32 %0, %1, %2" : "=v"(r) : "v"(lo), "v"(hi)); return r; }
__device__ __forceinline__ unsigned f2bf(float f) { return pk2(f, 0.f) & 0xffffu; }
#define XB_TMO      128
#define XB_XCNT(j)  (256  + 64 * (j))
#define XB_XSUB(j)  (1280 + 64 * (j))
#define XB_XGEN(j)  (2304 + 64 * (j))
#define XB_TOP      3328
#define XB_TOPGEN   3392
#define XCD_BAR_WORDS 3456
#define XB_SPIN_CAP (1u << 18)

__device__ __forceinline__ unsigned xb_ld(unsigned* p)              { return __hip_atomic_load(p, __ATOMIC_RELAXED, __HIP_MEMORY_SCOPE_AGENT); }
__device__ __forceinline__ unsigned xb_add(unsigned* p, unsigned v) { return __hip_atomic_fetch_add(p, v, __ATOMIC_RELAXED, __HIP_MEMORY_SCOPE_AGENT); }
__device__ __forceinline__ unsigned xb_xcc_id() { return (unsigned)__builtin_amdgcn_s_getreg((3 << 11) | 20) & 0xFu; }
#define XB_SPIN(cond, bar) do { unsigned _sp = 0; while (cond) { __builtin_amdgcn_s_sleep(1); \
    if ((++_sp & 255u) == 0u) { if (xb_ld(&(bar)[XB_TMO])) break; if (_sp > XB_SPIN_CAP) { atomicAdd(&(bar)[XB_TMO], 1u); break; } } } } while (0)

struct XcdBarrier {
    unsigned* bar; unsigned x;
    volatile LAS unsigned* st;
};

__device__ __forceinline__ XcdBarrier xcd_barrier_post(unsigned* bar, volatile LAS unsigned* st) {
    XcdBarrier b; b.bar = bar; b.x = xb_xcc_id(); b.st = st;
    if (threadIdx.x == 0) (void)xb_add(&bar[XB_XCNT(b.x)], 1u);
    return b;
}
__device__ __forceinline__ void xcd_barrier_complete(unsigned* bar, unsigned x, unsigned& nloc, unsigned& nx) {
    const unsigned G = gridDim.x * gridDim.y * gridDim.z;
    unsigned sum, cnt, mine, sp = 0u;
    for (;;) {
        sum = 0u; cnt = 0u; mine = 0u;
#pragma unroll
        for (unsigned j = 0; j < 16; ++j) { const unsigned c = xb_ld(&bar[XB_XCNT(j)]); sum += c; cnt += (c > 0u) ? 1u : 0u; mine = (j == x) ? c : mine; }
        if (sum == G) break;
        __builtin_amdgcn_s_sleep(1);
        if ((++sp & 255u) == 0u) { if (xb_ld(&bar[XB_TMO])) break; if (sp > XB_SPIN_CAP) { atomicAdd(&bar[XB_TMO], 1u); break; } }
    }
    nloc = mine > 0u ? mine : 1u; nx = cnt > 0u ? cnt : 1u;
}

__device__ __forceinline__ void xcd_barrier(const XcdBarrier& b) {
    asm volatile("s_waitcnt vmcnt(0)" ::: "memory");
    __syncthreads();
    if (threadIdx.x == 0) {
        unsigned* bar = b.bar;
        __builtin_amdgcn_s_waitcnt(0);
        unsigned nloc = b.st[0], nx = b.st[1];
        if (nloc == 0u) { xcd_barrier_complete(bar, b.x, nloc, nx); b.st[0] = nloc; b.st[1] = nx; }
        const unsigned old = xb_add(&bar[XB_XSUB(b.x)], 1u);
        const unsigned gen = old / nloc;
        if (old + 1u == (gen + 1u) * nloc) {
            __builtin_amdgcn_fence(__ATOMIC_RELEASE, "agent");
            asm volatile("s_waitcnt vmcnt(0)" ::: "memory");
            const unsigned og = xb_add(&bar[XB_TOP], 1u);
            const unsigned tg = og / nx;
            if (og + 1u == (tg + 1u) * nx) xb_add(&bar[XB_TOPGEN], 1u);
            else XB_SPIN(xb_ld(&bar[XB_TOPGEN]) == tg, bar);
            __builtin_amdgcn_fence(__ATOMIC_ACQUIRE, "agent");
            xb_add(&bar[XB_XGEN(b.x)], 1u);
            asm volatile("s_waitcnt vmcnt(0)" ::: "memory");
        } else {
            XB_SPIN(xb_ld(&bar[XB_XGEN(b.x)]) == gen, bar);
            __builtin_amdgcn_fence(__ATOMIC_ACQUIRE, "agent");
            asm volatile("s_waitcnt vmcnt(0)" ::: "memory");
        }
    }
    __syncthreads();
}

constexpr int NWAVES = 8;
#ifndef NST_MAX
#define NST_MAX 23
#endif
constexpr int DM = 1024, MROWS = 17408, MP = 16384, TP = 2048, NSP = 8, NSS = 128, TS = 8;
constexpr int INW = 4608, FF = 3072, FF2 = 6144, NCI = 136, MODW = 12288;
constexpr float EPSN = 1e-6f;
constexpr int TC = 128, NCH = TP / TC;

constexpr size_t MiB = 1u << 20;
constexpr size_t WS_CTL = 0, CTL_ZERO_BYTES = 1 * MiB;
constexpr size_t WS_MOD = 1 * MiB;
constexpr size_t WS_WIN = 8 * MiB, WS_WRG = 17 * MiB, WS_WGLU = 19 * MiB, WS_WOUT = 21 * MiB, WS_WUP = 23 * MiB, WS_WDOWN = 35 * MiB;
constexpr size_t WS_SMALL = 41 * MiB;
constexpr size_t SM_WG = 0, SM_BBAR = 256 * 1024, SM_CMAT = 384 * 1024, SM_ABAR = 512 * 1024, SM_ABARTC = 528 * 1024;
constexpr size_t WS_XN = 42 * MiB;
constexpr size_t WS_XRB = 76 * MiB;
constexpr size_t WS_RX = 110 * MiB, WS_RY = 144 * MiB, WS_SX = 178 * MiB, WS_GA = 195 * MiB, WS_GB = 229 * MiB;
constexpr size_t WS_UPH = 110 * MiB, WS_HFFH = 212 * MiB;
constexpr size_t WS_HFF = 110 * MiB, WS_HALO = 212 * MiB;
constexpr size_t WS_WADA = 110 * MiB, WS_SILUC = 135 * MiB;
constexpr size_t WS_AGGRG = 263 * MiB, WS_AGGS5 = 263 * MiB;
constexpr size_t WS_PART_OUT = 229 * MiB, WS_PART_DOWN = 219 * MiB;
constexpr size_t WS_AGT = 267 * MiB;
constexpr size_t WS_END = 269 * MiB;
constexpr int CW_BAR = 4096, CW_Q = 8192;

constexpr size_t O_Y = 0, O_PRGH = 17825792, O_PRGC = 17842176, O_PS5R = 17891328, O_PS5I = 17924096, O_PFFN = 17956864,
                 O_SRGH = 18153472, O_SRGC = 18415616, O_SS5R = 19202048, O_SS5I = 19726336, O_SFFN = 20250624;

constexpr int RING_BYTES = 131072, LDSCTL_OFF = RING_BYTES, MISC_OFF = LDSCTL_OFF + 320, LDS_BYTES = 147456;
constexpr int XCH_OFF = RING_BYTES + 1024;

typedef float f32x2 __attribute__((ext_vector_type(2)));
typedef unsigned u32x2 __attribute__((ext_vector_type(2)));

struct Args { const float* in[38]; float* out; unsigned char* ws; };

struct Frame { LAS unsigned char* lds; volatile LAS unsigned* MISC; gu32* ctl; int tid, lane, wave, vcu, G; };
__device__ __forceinline__ Frame refresh(const Frame& F0) {
    Frame F = F0; int t = threadIdx.x; asm volatile("" : "+v"(t)); int bx = blockIdx.x; asm volatile("" : "+s"(bx));
    F.tid = t; F.lane = t & 63; F.wave = __builtin_amdgcn_readfirstlane(t >> 6); F.G = gridDim.x; F.vcu = (F.G % 8 == 0) ? (bx % 8) * (F.G / 8) + bx / 8 : bx; return F;
}

__device__ __forceinline__ float bf2f(unsigned short b) { return __builtin_bit_cast(float, (unsigned)b << 16); }
__device__ __forceinline__ float bflo(unsigned w) { return __builtin_bit_cast(float, w << 16); }
__device__ __forceinline__ float bfhi(unsigned w) { return __builtin_bit_cast(float, w & 0xffff0000u); }
__device__ __forceinline__ float fsig(float x) { return __builtin_amdgcn_rcpf(1.f + __builtin_amdgcn_exp2f(-1.44269504f * x)); }
__device__ __forceinline__ float fgelu(float x) { const float u = x * (1.f + 0.044715f * x * x); return x * __builtin_amdgcn_rcpf(1.f + __builtin_amdgcn_exp2f(-2.302208198f * u)); }
__device__ __forceinline__ float wave_sum(float v) {
#pragma unroll
    for (int o = 1; o < 64; o <<= 1) v += __shfl_xor(v, o);
    return v;
}
__device__ __forceinline__ int row_ci(int row) { return row < MP ? (row >> 11) : 8 + ((row - MP) >> 3); }

namespace pg8 {
enum { EM_ADA = 0, EM_IN = 1, EM_GLU = 2, EM_RGP = 3, EM_RES = 4, EM_PLAIN = 5, EM_UPF = 6 };
struct EpiAny {
    static constexpr bool AFTER_DRAIN = false;
    int mode; bool perm; unsigned char* ws; const float* p0; const float* p1; const float* p2; float* out; int row_off; int lay; PG8_LAS float* xch;
    __device__ __forceinline__ void operator()(const f32x4 (&acc)[2][2][4][2], const Unit& u, int wr, int wc, int fr, int fq) const {
        asm volatile("" : "+v"(fr), "+v"(fq), "+s"(wr), "+s"(wc));
        if (mode == EM_IN || mode == EM_PLAIN) {
            const int pn = u.pn; int ldc = 1024, ct = pn; size_t wo = WS_UPH;
            if (mode == EM_IN) { if (pn < 4) { wo = WS_RX; ct = pn; } else if (pn < 8) { wo = WS_RY; ct = pn - 4; } else if (pn < 10) { wo = WS_SX; ct = pn - 8; ldc = 512; } else if (pn < 14) { wo = WS_GA; ct = pn - 10; } else { wo = WS_GB; ct = pn - 14; } }
            else ldc = FF2;
            bf16_t* base = (bf16_t*)(ws + wo);
            const int row0 = u.pm * BM + wr * 64 + fr, col0 = ct * BM + wc * 32 + 8 * fq, bcol0 = pn * BM + wc * 32 + 8 * fq;
#pragma unroll
            for (int bj = 0; bj < 2; ++bj) {
                f32x4 b0 = {0.f, 0.f, 0.f, 0.f}, b1 = {0.f, 0.f, 0.f, 0.f};
                if (mode == EM_IN) { b0 = *(const f32x4*)(p0 + bcol0 + bj * HALF); b1 = *(const f32x4*)(p0 + bcol0 + bj * HALF + 4); }
#pragma unroll
                for (int ai = 0; ai < 2; ++ai)
#pragma unroll
                    for (int m = 0; m < 4; ++m) { bf16_t* rowp = base + (size_t)(row0 + ai * HALF + m * 16) * ldc + col0;
                        const f32x4 v0 = acc[ai][bj][m][0] + b0, v1 = acc[ai][bj][m][1] + b1;
                        u32x4 w; w.x = cvt_pk_bf16(v0[0], v0[1]); w.y = cvt_pk_bf16(v0[2], v0[3]); w.z = cvt_pk_bf16(v1[0], v1[1]); w.w = cvt_pk_bf16(v1[2], v1[3]);
                        *(u32x4*)(rowp + bj * HALF) = w; } }
        } else if (mode == EM_UPF) {
            const int pm = u.pm, pn = u.pn; const bool smp = pm >= 64; const int lane = fq * 16 + fr;
            bf16_t* HF = (bf16_t*)(ws + WS_HFF); float* HALO = (float*)(ws + WS_HALO);
            const int cb = pn * HALF + wc * 32 + 8 * fq;
            if (fr >= 14) {
#pragma unroll
                for (int ai = 0; ai < 2; ++ai)
#pragma unroll
                    for (int bj = 0; bj < 2; ++bj)
#pragma unroll
                        for (int n = 0; n < 2; ++n) *(PG8_LAS f32x4*)(xch + ((((ai * 2 + wr) * 2 + (fr - 14)) * 4 + wc) * 4 + fq) * 16 + bj * 8 + n * 4) = acc[ai][bj][3][n];
            }
            if (!smp) {
                if (wr == 1 && fr >= 14) {
#pragma unroll
                    for (int bj = 0; bj < 2; ++bj)
#pragma unroll
                        for (int n = 0; n < 2; ++n) { *(f32x4*)(HALO + ((size_t)(pm * 4 + (fr - 14)) * 2 + bj) * FF + cb + 4 * n) = acc[1][bj][3][n];
                            if ((pm & 7) == 7) *(f32x4*)(out + O_PFFN + ((size_t)((pm >> 3) * 2 + lay) * 2 + (fr - 14)) * FF2 + bj * FF + cb + 4 * n) = acc[1][bj][3][n]; }
                }
                if (wr == 0 && fr < 2) {
#pragma unroll
                    for (int bj = 0; bj < 2; ++bj)
#pragma unroll
                        for (int n = 0; n < 2; ++n) *(f32x4*)(HALO + ((size_t)(pm * 4 + 2 + fr) * 2 + bj) * FF + cb + 4 * n) = acc[0][bj][0][n];
                }
            } else if ((fr & 7) >= 6) {
#pragma unroll
                for (int ai = 0; ai < 2; ++ai)
#pragma unroll
                    for (int m = 0; m < 4; ++m) { const int sq = ((pm - 64) * BM + ai * HALF + wr * 64 + m * 16 + fr) >> 3;
#pragma unroll
                        for (int bj = 0; bj < 2; ++bj)
#pragma unroll
                            for (int n = 0; n < 2; ++n) *(f32x4*)(out + O_SFFN + ((size_t)(sq * 2 + lay) * 2 + ((fr & 7) - 6)) * FF2 + bj * FF + cb + 4 * n) = acc[ai][bj][m][n]; }
            }
            asm volatile("s_waitcnt lgkmcnt(0)" ::: "memory"); __builtin_amdgcn_s_barrier(); asm volatile("" ::: "memory");
#pragma unroll
            for (int n = 0; n < 2; ++n) {
                const int c4 = cb + 4 * n;
                f32x4 w[2][3], bb[2];
#pragma unroll
                for (int bj = 0; bj < 2; ++bj) { bb[bj] = *(const f32x4*)(p1 + bj * FF + c4);
#pragma unroll
                    for (int k = 0; k < 3; ++k) w[bj][k] = *(const f32x4*)(p0 + k * FF2 + bj * FF + c4); }
#pragma unroll
                for (int ai = 0; ai < 2; ++ai) {
                    f32x4 pg[2] = {{0.f, 0.f, 0.f, 0.f}, {0.f, 0.f, 0.f, 0.f}};
                    const int blk = ai * 2 + wr;
                    if (!smp && blk > 0 && fr >= 14) {
#pragma unroll
                        for (int bj = 0; bj < 2; ++bj) pg[bj] = *(const PG8_LAS f32x4*)(xch + (((((blk - 1) * 2 + (fr - 14)) * 4 + wc) * 4 + fq) * 16 + bj * 8 + n * 4));
                    }
#pragma unroll
                    for (int m = 0; m < 4; ++m) {
                        const int trow = ai * HALF + wr * 64 + m * 16 + fr;
                        f32x4 uc[2];
#pragma unroll
                        for (int bj = 0; bj < 2; ++bj) {
                            const f32x4 cur = acc[ai][bj][m][n]; f32x4 p1v, p2v;
#pragma unroll
                            for (int j = 0; j < 4; ++j) { const float x1 = (fr == 15) ? pg[bj][j] : cur[j], x2 = (fr >= 14) ? pg[bj][j] : cur[j];
                                p1v[j] = __builtin_bit_cast(float, __builtin_amdgcn_update_dpp(0, __builtin_bit_cast(int, x1), 0x121, 0xF, 0xF, false));
                                p2v[j] = __builtin_bit_cast(float, __builtin_amdgcn_update_dpp(0, __builtin_bit_cast(int, x2), 0x122, 0xF, 0xF, false)); }
                            if (smp) { const int t = fr & 7;
                                if (t < 2) { const int sq = ((pm - 64) * BM + trow) >> 3; const float* st = p2 + ((size_t)(sq * 2 + lay) * 2) * FF2 + bj * FF + c4;
                                    const f32x4 s1 = *(const f32x4*)(st + FF2); p2v = s1; if (t == 0) { p1v = s1; p2v = *(const f32x4*)st; } } }
                            uc[bj] = bb[bj] + w[bj][0] * p2v + w[bj][1] * p1v + w[bj][2] * cur;
                            pg[bj] = cur;
                        }
                        u32x2 o; o.x = cvt_pk_bf16(fgelu(uc[0][0]) * uc[1][0], fgelu(uc[0][1]) * uc[1][1]); o.y = cvt_pk_bf16(fgelu(uc[0][2]) * uc[1][2], fgelu(uc[0][3]) * uc[1][3]);
                        *(u32x2*)(HF + (size_t)(pm * BM + trow) * FF + c4) = o;
                    }
                }
            }
        } else if (mode == EM_GLU) {
            bf16_t* GA = (bf16_t*)(ws + WS_GA); const bf16_t* GB = (const bf16_t*)(ws + WS_GB);
            const int row0 = u.pm * BM + wr * 64 + fr, col0 = u.pn * HALF + wc * 32 + 8 * fq;
#pragma unroll
            for (int ai = 0; ai < 2; ++ai) {
                u32x4 gq[4], aq[4];
#pragma unroll
                for (int m = 0; m < 4; ++m) { const size_t off = (size_t)(row0 + ai * HALF + m * 16) * 1024 + col0; gq[m] = *(const u32x4*)(GB + off); aq[m] = *(const u32x4*)(GA + off); }
#pragma unroll
                for (int m = 0; m < 4; ++m) { const size_t off = (size_t)(row0 + ai * HALF + m * 16) * 1024 + col0;
                    const u32x4 g = gq[m], a = aq[m];
                    float gv[8] = {bflo(g.x), bfhi(g.x), bflo(g.y), bfhi(g.y), bflo(g.z), bfhi(g.z), bflo(g.w), bfhi(g.w)};
                    float av[8] = {bflo(a.x), bfhi(a.x), bflo(a.y), bfhi(a.y), bflo(a.z), bfhi(a.z), bflo(a.w), bfhi(a.w)}; float o[8];
#pragma unroll
                    for (int n = 0; n < 2; ++n)
#pragma unroll
                        for (int j = 0; j < 4; ++j) o[4 * n + j] = av[4 * n + j] + fsig(gv[4 * n + j]) * acc[ai][0][m][n][j] * fsig(acc[ai][1][m][n][j]);
                    u32x4 w; w.x = cvt_pk_bf16(o[0], o[1]); w.y = cvt_pk_bf16(o[2], o[3]); w.z = cvt_pk_bf16(o[4], o[5]); w.w = cvt_pk_bf16(o[6], o[7]);
                    *(u32x4*)(GA + off) = w; } }
        } else if (mode == EM_RGP) {
            bf16_t* GA = (bf16_t*)(ws + WS_GA);
            const int row0 = u.pm * BM + wr * 64 + fr, col0 = u.pn * BM + wc * 32 + 8 * fq;
#pragma unroll
            for (int ai = 0; ai < 2; ++ai) {
                u32x4 gq[4][2];
#pragma unroll
                for (int m = 0; m < 4; ++m)
#pragma unroll
                    for (int bj = 0; bj < 2; ++bj) gq[m][bj] = *(const u32x4*)(GA + (size_t)(row0 + ai * HALF + m * 16) * 1024 + col0 + bj * HALF);
#pragma unroll
                for (int m = 0; m < 4; ++m)
#pragma unroll
                    for (int bj = 0; bj < 2; ++bj) { const size_t off = (size_t)(row0 + ai * HALF + m * 16) * 1024 + col0 + bj * HALF;
                        const u32x4 g = gq[m][bj];
                        float gv[8] = {bflo(g.x), bfhi(g.x), bflo(g.y), bfhi(g.y), bflo(g.z), bfhi(g.z), bflo(g.w), bfhi(g.w)}; float o[8];
#pragma unroll
                        for (int n = 0; n < 2; ++n)
#pragma unroll
                            for (int j = 0; j < 4; ++j) o[4 * n + j] = fsig(gv[4 * n + j]) * acc[ai][bj][m][n][j];
                        u32x4 w; w.x = cvt_pk_bf16(o[0], o[1]); w.y = cvt_pk_bf16(o[2], o[3]); w.z = cvt_pk_bf16(o[4], o[5]); w.w = cvt_pk_bf16(o[6], o[7]);
                        *(u32x4*)(GA + off) = w; } }
        } else if (mode == EM_RES) {
            bf16_t* XB = (bf16_t*)(ws + WS_XRB);
            const int col0 = u.pn * BM + wc * 32 + 8 * fq;
            if (u.mini) {
#pragma unroll
                for (int ai = 0; ai < 2; ++ai)
#pragma unroll
                    for (int m = 0; m < 4; ++m) { const int r = u.pm * BM + ai * HALF + wr * 64 + m * 16 + fr;
#pragma unroll
                        for (int bj = 0; bj < 2; ++bj) { float* P = (float*)(ws + (row_off ? WS_PART_DOWN : WS_PART_OUT)) + ((size_t)(u.koff / u.ksl) * (MROWS - MP) + (r - MP)) * DM + col0 + bj * HALF;
                            *(f32x4*)P = acc[ai][bj][m][0]; *(f32x4*)(P + 4) = acc[ai][bj][m][1]; } }
            } else {
                const float* gt = p2 + (size_t)(u.pm >> 3) * MODW;
                f32x4 gq[2][2];
#pragma unroll
                for (int bj = 0; bj < 2; ++bj) { gq[bj][0] = *(const f32x4*)(gt + col0 + bj * HALF); gq[bj][1] = *(const f32x4*)(gt + col0 + bj * HALF + 4); }
#pragma unroll
                for (int ai = 0; ai < 2; ++ai) {
                    f32x4 sq[4][2][2];
#pragma unroll
                    for (int m = 0; m < 4; ++m)
#pragma unroll
                        for (int bj = 0; bj < 2; ++bj) { const size_t off = (size_t)(u.pm * BM + ai * HALF + wr * 64 + m * 16 + fr) * DM + col0 + bj * HALF;
                            if (p0) { sq[m][bj][0] = *(const f32x4*)(p0 + off); sq[m][bj][1] = *(const f32x4*)(p0 + off + 4); }
                            else { const u32x4 b = *(const u32x4*)(XB + off); sq[m][bj][0] = (f32x4){bflo(b.x), bfhi(b.x), bflo(b.y), bfhi(b.y)}; sq[m][bj][1] = (f32x4){bflo(b.z), bfhi(b.z), bflo(b.w), bfhi(b.w)}; } }
#pragma unroll
                    for (int m = 0; m < 4; ++m)
#pragma unroll
                        for (int bj = 0; bj < 2; ++bj) { const size_t off = (size_t)(u.pm * BM + ai * HALF + wr * 64 + m * 16 + fr) * DM + col0 + bj * HALF;
                            const f32x4 o0 = sq[m][bj][0] + gq[bj][0] * acc[ai][bj][m][0], o1 = sq[m][bj][1] + gq[bj][1] * acc[ai][bj][m][1];
                            u32x4 w; w.x = cvt_pk_bf16(o0[0], o0[1]); w.y = cvt_pk_bf16(o0[2], o0[3]); w.z = cvt_pk_bf16(o1[0], o1[1]); w.w = cvt_pk_bf16(o1[2], o1[3]);
                            *(u32x4*)(XB + off) = w; } }
            }
        } else {
            const int col0 = u.pn * BM + wc * 32 + 4 * fq;
#pragma unroll
            for (int ai = 0; ai < 2; ++ai)
#pragma unroll
                for (int m = 0; m < 4; ++m) { const int r = ai * HALF + wr * 64 + m * 16 + fr;
                    if (r < NCI) {
#pragma unroll
                        for (int bj = 0; bj < 2; ++bj)
#pragma unroll
                            for (int n = 0; n < 2; ++n) { const int c = col0 + bj * HALF + n * 16; *(f32x4*)(out + (size_t)r * MODW + c) = acc[ai][bj][m][n] + *(const f32x4*)(p0 + c); } } }
        }
    }
};
}

template <int MAP> __device__ __forceinline__ int wt_row(int n) {
    if (MAP == 1) { return n < 1024 ? ((n >> 7) << 8) + (n & 127) : (((n - 1024) >> 7) << 8) + 128 + (n & 127); }
    if (MAP == 2) { return n < 3072 ? ((n >> 7) << 8) + (n & 127) : (((n - 3072) >> 7) << 8) + 128 + (n & 127); }
    return n;
}
template <int MAP> __device__ __forceinline__ void p0_transpose_item(const float* W, int K, int N, bf16* WT, int row_off, LAS float* scr, int item, int lane, int npair) {
    const int nblk = N / 32;
    f32x4 v[2][8];
#pragma unroll
    for (int p = 0; p < 2; ++p) if (p < npair) { const int kb = (item + p) / nblk, nb = (item + p) % nblk, k0 = 64 * kb, n0 = 32 * nb;
#pragma unroll
        for (int i = 0; i < 8; ++i) v[p][i] = __builtin_nontemporal_load((const f32x4*)(W + (size_t)(k0 + 8 * i + (lane >> 3)) * N + n0 + 4 * (lane & 7))); }
#pragma unroll
    for (int p = 0; p < 2; ++p) if (p < npair) { const int kb = (item + p) / nblk, nb = (item + p) % nblk, k0 = 64 * kb, n0 = 32 * nb;
#pragma unroll
        for (int i = 0; i < 8; ++i) { LAS float* d = scr + (8 * i + (lane >> 3)) * 33 + 4 * (lane & 7); d[0] = v[p][i].x; d[1] = v[p][i].y; d[2] = v[p][i].z; d[3] = v[p][i].w; }
        LDS_WAIT(); asm volatile("" ::: "memory");
        const int c = lane & 7;
#pragma unroll
        for (int j = 0; j < 4; ++j) { const int n = (lane >> 3) + 8 * j; const LAS float* s = scr + (8 * c) * 33 + n;
            v4u o; o.x = pk2(s[0 * 33], s[1 * 33]); o.y = pk2(s[2 * 33], s[3 * 33]); o.z = pk2(s[4 * 33], s[5 * 33]); o.w = pk2(s[6 * 33], s[7 * 33]);
            *(GAS v4u*)(WT + (size_t)(row_off + wt_row<MAP>(n0 + n)) * K + k0 + 8 * c) = o; }
        LDS_WAIT(); asm volatile("" ::: "memory"); }
}

__device__ __forceinline__ void p0_weights(const Frame& F0, const Args& A, int l, int part, int b0, int nb) {
    const Frame F = refresh(F0);
    unsigned char* ws = A.ws;
    LAS float* scr = (LAS float*)(F.lds + F.wave * 16384);
    int bx = blockIdx.x; asm volatile("" : "+s"(bx));
    if (bx < b0) return;
    const bool first = part == 0;
    const int gw = (bx - b0) * NWAVES + F.wave, NGW = nb * NWAVES;
    constexpr int I_IN = (DM / 64) * (INW / 32), I_SQ = (DM / 64) * (DM / 32), I_GLU = (512 / 64) * (2048 / 32), I_UP = (DM / 64) * (FF2 / 32), I_DN = (FF / 64) * (DM / 32), I_ADA = (DM / 64) * (FF2 / 32);
    constexpr int NLAYER = I_IN + 2 * I_SQ + I_GLU + I_UP + I_DN;
    const int nitems = first ? 2 * I_ADA : NLAYER;
    const int per_ = (nitems + NGW - 1) / NGW, it_hi = (gw + 1) * per_ < nitems ? (gw + 1) * per_ : nitems;
    for (int it = gw * per_; it < it_hi; it += 2) {
        int r = first ? it + NLAYER : it; const bool more = it + 1 < it_hi;
        if (r < I_IN) { p0_transpose_item<0>(A.in[13] + (size_t)l * DM * INW, DM, INW, (bf16*)(ws + WS_WIN), 0, scr, r, F.lane, (more && r + 1 < I_IN) ? 2 : 1); if (more && !(r + 1 < I_IN)) --it; continue; } r -= I_IN;
        if (r < I_SQ) { p0_transpose_item<0>(A.in[30] + (size_t)l * DM * DM, DM, DM, (bf16*)(ws + WS_WRG), 0, scr, r, F.lane, (more && r + 1 < I_SQ) ? 2 : 1); if (more && !(r + 1 < I_SQ)) --it; continue; } r -= I_SQ;
        if (r < I_SQ) { p0_transpose_item<0>(A.in[32] + (size_t)l * DM * DM, DM, DM, (bf16*)(ws + WS_WOUT), 0, scr, r, F.lane, (more && r + 1 < I_SQ) ? 2 : 1); if (more && !(r + 1 < I_SQ)) --it; continue; } r -= I_SQ;
        if (r < I_GLU) { p0_transpose_item<1>(A.in[31] + (size_t)l * 512 * 2048, 512, 2048, (bf16*)(ws + WS_WGLU), 0, scr, r, F.lane, (more && r + 1 < I_GLU) ? 2 : 1); if (more && !(r + 1 < I_GLU)) --it; continue; } r -= I_GLU;
        if (r < I_UP) { p0_transpose_item<2>(A.in[33] + (size_t)l * DM * FF2, DM, FF2, (bf16*)(ws + WS_WUP), 0, scr, r, F.lane, (more && r + 1 < I_UP) ? 2 : 1); if (more && !(r + 1 < I_UP)) --it; continue; } r -= I_UP;
        if (r < I_DN) { p0_transpose_item<0>(A.in[36] + (size_t)l * FF * DM, FF, DM, (bf16*)(ws + WS_WDOWN), 0, scr, r, F.lane, (more && r + 1 < I_DN) ? 2 : 1); if (more && !(r + 1 < I_DN)) --it; continue; } r -= I_DN;
        if (r < I_ADA) { p0_transpose_item<0>(A.in[9], DM, FF2, (bf16*)(ws + WS_WADA), 0, scr, r, F.lane, (more && r + 1 < I_ADA) ? 2 : 1); if (more && !(r + 1 < I_ADA)) --it; continue; } r -= I_ADA;
        p0_transpose_item<0>(A.in[9] + (size_t)DM * FF2, DM, FF2, (bf16*)(ws + WS_WADA), FF2, scr, r, F.lane, (more && r + 1 < I_ADA) ? 2 : 1); if (more && !(r + 1 < I_ADA)) --it;
    }
    const int gt = (bx - b0) * (NWAVES * 64) + F.tid, NGT = nb * NWAVES * 64;
    if (!first) {
    bf16* WG = (bf16*)(ws + WS_SMALL + SM_WG);
    for (int e = gt; e < 2 * 16 * 4096; e += NGT) { const int gate = e >> 16, rem = e & 65535, h = rem >> 12, j = (rem >> 6) & 63, i = rem & 63;
        const float* src = (gate ? A.in[19] : A.in[17]) + (size_t)l * 65536 + h * 4096 + i * 64 + j;
        WG[((h * 2 + gate) * 64 + j) * 64 + i] = (bf16)f2bf(*src); }
    for (int e = gt; e < 2048; e += NGT) { const int g = e >> 6, p = e & 63;
        const float dt = expf(A.in[29][l * 32 + g]);
        const float lr = A.in[22][l * 2048 + e], li = A.in[23][l * 2048 + e];
        const float mag = expf(lr * dt); float sn, cs; sincosf(li * dt, &sn, &cs);
        const float ar = mag * cs, ai = mag * sn, den = lr * lr + li * li;
        const float zr = ((ar - 1.f) * lr + ai * li) / den, zi = (ai * lr - (ar - 1.f) * li) / den;
        float* AB = (float*)(ws + WS_SMALL + SM_ABAR); AB[e * 2] = ar; AB[e * 2 + 1] = ai;
        float pr = ar, pi = ai;
#pragma unroll 1
        for (int s = 0; s < 7; ++s) { const float nr = pr * pr - pi * pi, ni = 2.f * pr * pi; pr = nr; pi = ni; }
        float* ABT = (float*)(ws + WS_SMALL + SM_ABARTC); ABT[e * 2] = pr; ABT[e * 2 + 1] = pi;
        bf16* BB = (bf16*)(ws + WS_SMALL + SM_BBAR) + (size_t)g * 128 * 16;
        const float* bre = A.in[24] + ((size_t)l * 2048 + e) * 16; const float* bim = A.in[25] + ((size_t)l * 2048 + e) * 16;
#pragma unroll 4
        for (int c = 0; c < 16; ++c) { const float br = bre[c], bi = bim[c]; BB[p * 16 + c] = (bf16)f2bf(zr * br - zi * bi); BB[(64 + p) * 16 + c] = (bf16)f2bf(zr * bi + zi * br); }
        bf16* CM = (bf16*)(ws + WS_SMALL + SM_CMAT) + (size_t)g * 16 * 128;
        const float* cre = A.in[26] + ((size_t)l * 32 + g) * 1024; const float* cim = A.in[27] + ((size_t)l * 32 + g) * 1024;
#pragma unroll 4
        for (int c = 0; c < 16; ++c) { CM[c * 128 + p] = (bf16)f2bf(cre[c * 64 + p]); CM[c * 128 + 64 + p] = (bf16)f2bf(-cim[c * 64 + p]); }
    }
    }
    if (first) {
        bf16* XRs = (bf16*)(ws + WS_XRB) + (size_t)MP * DM;
        for (int e = gt; e < (MROWS - MP) * DM / 4; e += NGT) { const f32x4 v = ((const f32x4*)A.in[1])[e]; ((unsigned long long*)XRs)[e] = (unsigned long long)pk2(v.x, v.y) | ((unsigned long long)pk2(v.z, v.w) << 32); }
    }
    if (first) {
        bf16* SC = (bf16*)(ws + WS_SILUC);
        for (int e = gt; e < 256 * DM; e += NGT) { const int r = e >> 10, c = e & 1023; float v = 0.f;
            if (r < NSP) v = A.in[7][r * DM + c]; else if (r < NCI) v = A.in[8][(r - NSP) * DM + c];
            SC[e] = (bf16)f2bf(v * fsig(v)); }
    }
}

__device__ __forceinline__ void cvt8(const v4u w, float (&o)[8]) { o[0] = bflo(w.x); o[1] = bfhi(w.x); o[2] = bflo(w.y); o[3] = bfhi(w.y); o[4] = bflo(w.z); o[5] = bfhi(w.z); o[6] = bflo(w.w); o[7] = bfhi(w.w); }
__device__ __forceinline__ f32x4 ld_row4(const float* xf, const bf16* xb, size_t row, int idx) {
    if (xf) return __builtin_nontemporal_load((const GAS f32x4*)(xf + row * DM) + idx);
    const u32x2 b = ((const GAS u32x2*)(xb + row * DM))[idx]; return (f32x4){bflo(b.x), bfhi(b.x), bflo(b.y), bfhi(b.y)};
}
__device__ __forceinline__ void norm_rows(const Frame& F0, const float* xp, const float* xs_adj, bf16* XRB, const float* g, const float* mod_sh, const float* mod_sc, bf16* XN, int npart, const float* pgate, const float* PART) {
    const Frame F = refresh(F0);
    const int gw = F.vcu * NWAVES + F.wave, NGW = F.G * NWAVES;
    if (!xp) {
        for (int m0 = 8 * gw; m0 < MP; m0 += 8 * NGW) {
            const int ci = m0 >> 11;
            v4u w[8][2]; float sr[8];
#pragma unroll
            for (int r = 0; r < 8; ++r)
#pragma unroll
                for (int j = 0; j < 2; ++j) w[r][j] = ((const GAS v4u*)(XRB + (size_t)(m0 + r) * DM))[64 * j + F.lane];
#pragma unroll
            for (int r = 0; r < 8; ++r) { float q = 0.f;
#pragma unroll
                for (int j = 0; j < 2; ++j) { float v[8]; cvt8(w[r][j], v);
#pragma unroll
                    for (int e = 0; e < 8; ++e) q += v[e] * v[e]; }
                sr[r] = __builtin_amdgcn_rsqf(wave_sum(q) * (1.f / DM) + EPSN); }
#pragma unroll
            for (int j = 0; j < 2; ++j) { const int c = 512 * j + 8 * F.lane; float gs[8], sh[8];
#pragma unroll
                for (int h2 = 0; h2 < 2; ++h2) { const f32x4 gg = *(const f32x4*)(g + c + 4 * h2), s4 = *(const f32x4*)(mod_sh + (size_t)ci * MODW + c + 4 * h2), c4 = *(const f32x4*)(mod_sc + (size_t)ci * MODW + c + 4 * h2);
#pragma unroll
                    for (int e = 0; e < 4; ++e) { gs[4 * h2 + e] = gg[e] * (c4[e] + 1.f); sh[4 * h2 + e] = s4[e]; } }
#pragma unroll
                for (int r = 0; r < 8; ++r) { float v[8]; cvt8(w[r][j], v); v4u o;
                    o.x = pk2(v[0] * sr[r] * gs[0] + sh[0], v[1] * sr[r] * gs[1] + sh[1]); o.y = pk2(v[2] * sr[r] * gs[2] + sh[2], v[3] * sr[r] * gs[3] + sh[3]);
                    o.z = pk2(v[4] * sr[r] * gs[4] + sh[4], v[5] * sr[r] * gs[5] + sh[5]); o.w = pk2(v[6] * sr[r] * gs[6] + sh[6], v[7] * sr[r] * gs[7] + sh[7]);
                    ((GAS v4u*)(XN + (size_t)(m0 + r) * DM))[64 * j + F.lane] = o; } }
        }
    } else
    for (int m0 = 4 * gw; m0 < MP; m0 += 4 * NGW) {
        const int ci = m0 >> 11;
        f32x4 v[4][4]; float s[4];
#pragma unroll
        for (int r = 0; r < 4; ++r)
#pragma unroll
            for (int j = 0; j < 4; ++j) v[r][j] = ld_row4(xp, XRB, (size_t)(m0 + r), 64 * j + F.lane);
#pragma unroll
        for (int r = 0; r < 4; ++r) { float q = 0.f;
#pragma unroll
            for (int j = 0; j < 4; ++j) q += (v[r][j].x * v[r][j].x + v[r][j].y * v[r][j].y) + (v[r][j].z * v[r][j].z + v[r][j].w * v[r][j].w);
            s[r] = 1.f / sqrtf(wave_sum(q) * (1.f / DM) + EPSN); }
#pragma unroll
        for (int j = 0; j < 4; ++j) { const int c = 256 * j + 4 * F.lane;
            const f32x4 gg = *(const f32x4*)(g + c), sh = *(const f32x4*)(mod_sh + (size_t)ci * MODW + c), sc = *(const f32x4*)(mod_sc + (size_t)ci * MODW + c);
            const f32x4 gs = gg * (sc + 1.f);
#pragma unroll
            for (int r = 0; r < 4; ++r) { const f32x4 y = v[r][j] * s[r] * gs + sh;
                ((GAS unsigned long long*)(XN + (size_t)(m0 + r) * DM))[64 * j + F.lane] = (unsigned long long)pk2(y.x, y.y) | ((unsigned long long)pk2(y.z, y.w) << 32); } }
    }
    for (int m = MP + F.wave * F.G + F.vcu; m < MROWS; m += NGW) {
        const int ci = row_ci(m);
        f32x4 v[4]; float q = 0.f;
#pragma unroll
        for (int j = 0; j < 4; ++j) { v[j] = ld_row4(xs_adj, XRB, (size_t)m, 64 * j + F.lane);
            if (npart > 0) {
                f32x4 ps = {0.f, 0.f, 0.f, 0.f};
#pragma unroll
                for (int k = 0; k < 12; ++k) if (k < npart) ps += *(const f32x4*)(PART + ((size_t)k * (MROWS - MP) + (m - MP)) * DM + 256 * j + 4 * F.lane);
                v[j] += *(const f32x4*)(pgate + (size_t)ci * MODW + 256 * j + 4 * F.lane) * ps;
                ((GAS unsigned long long*)(XRB + (size_t)m * DM))[64 * j + F.lane] = (unsigned long long)pk2(v[j].x, v[j].y) | ((unsigned long long)pk2(v[j].z, v[j].w) << 32);
            }
            q += (v[j].x * v[j].x + v[j].y * v[j].y) + (v[j].z * v[j].z + v[j].w * v[j].w); }
        const float rstd = 1.f / sqrtf(wave_sum(q) * (1.f / DM) + EPSN);
#pragma unroll
        for (int j = 0; j < 4; ++j) { const int c = 256 * j + 4 * F.lane;
            const f32x4 gg = *(const f32x4*)(g + c), sh = *(const f32x4*)(mod_sh + (size_t)ci * MODW + c), sc = *(const f32x4*)(mod_sc + (size_t)ci * MODW + c);
            const f32x4 y = v[j] * rstd * gg * (sc + 1.f) + sh;
            ((GAS unsigned long long*)(XN + (size_t)m * DM))[64 * j + F.lane] = (unsigned long long)pk2(y.x, y.y) | ((unsigned long long)pk2(y.z, y.w) << 32); }
    }
}
__device__ __forceinline__ void final_norm(const Frame& F0, const bf16* XRB, float* y, const float* g, int npart, const float* pgate, const float* PART) {
    const Frame F = refresh(F0);
    const int gw = F.vcu * NWAVES + F.wave, NGW = F.G * NWAVES;
    for (int m0 = 8 * gw; m0 < MP; m0 += 8 * NGW) {
        v4u w[8][2]; float sr[8];
#pragma unroll
        for (int r = 0; r < 8; ++r)
#pragma unroll
            for (int j = 0; j < 2; ++j) w[r][j] = ((const GAS v4u*)(XRB + (size_t)(m0 + r) * DM))[64 * j + F.lane];
#pragma unroll
        for (int r = 0; r < 8; ++r) { float q = 0.f;
#pragma unroll
            for (int j = 0; j < 2; ++j) { float v[8]; cvt8(w[r][j], v);
#pragma unroll
                for (int e = 0; e < 8; ++e) q += v[e] * v[e]; }
            sr[r] = __builtin_amdgcn_rsqf(wave_sum(q) * (1.f / DM) + EPSN); }
#pragma unroll
        for (int j = 0; j < 2; ++j) { const int c = 512 * j + 8 * F.lane; const f32x4 g0 = *(const f32x4*)(g + c), g1 = *(const f32x4*)(g + c + 4);
#pragma unroll
            for (int r = 0; r < 8; ++r) { float v[8]; cvt8(w[r][j], v); float* yp = y + (size_t)(m0 + r) * DM + c;
                *(f32x4*)yp = (f32x4){v[0], v[1], v[2], v[3]} * sr[r] * g0; *(f32x4*)(yp + 4) = (f32x4){v[4], v[5], v[6], v[7]} * sr[r] * g1; } }
    }
    for (int m = MP + F.wave * F.G + F.vcu; m < MROWS; m += NGW) {
        const int ci = row_ci(m);
        f32x4 v[4]; float q = 0.f;
#pragma unroll
        for (int j = 0; j < 4; ++j) { v[j] = ld_row4(nullptr, XRB, (size_t)m, 64 * j + F.lane);
            f32x4 ps = {0.f, 0.f, 0.f, 0.f};
#pragma unroll
            for (int k = 0; k < 12; ++k) if (k < npart) ps += *(const f32x4*)(PART + ((size_t)k * (MROWS - MP) + (m - MP)) * DM + 256 * j + 4 * F.lane);
            v[j] += *(const f32x4*)(pgate + (size_t)ci * MODW + 256 * j + 4 * F.lane) * ps;
            q += (v[j].x * v[j].x + v[j].y * v[j].y) + (v[j].z * v[j].z + v[j].w * v[j].w); }
        const float rstd = 1.f / sqrtf(wave_sum(q) * (1.f / DM) + EPSN);
#pragma unroll
        for (int j = 0; j < 4; ++j) { const f32x4 gg = *(const f32x4*)(g + 256 * j + 4 * F.lane); ((GAS f32x4*)(y + (size_t)m * DM))[64 * j + F.lane] = v[j] * rstd * gg; }
    }
}


template <int MODE> __device__ __forceinline__ void rg_unit(const Frame& F, const Args& A, int l, bool sample, int s, int c, int h) {
    unsigned char* ws = A.ws;
    LAS float* TAB = (LAS float*)(F.lds + F.wave * 15360);
    LAS float* XC = TAB + 512;
    LAS float* AA = XC + 16 * 68;
    LAS float* BB = AA + 16 * 68;
    const int lane = F.lane, fr = lane & 15, fq = lane >> 4, ch0 = 64 * h;
    const bf16* RX = (const bf16*)(ws + WS_RX); bf16* RY = (bf16*)(ws + WS_RY);
    {
        const int chg = l * DM + ch0 + lane;
#pragma unroll
        for (int j = 0; j < 4; ++j) TAB[j * 64 + lane] = A.in[15][(size_t)(l * 4 + j) * DM + ch0 + lane];
        TAB[4 * 64 + lane] = A.in[16][chg]; TAB[5 * 64 + lane] = A.in[18][chg]; TAB[6 * 64 + lane] = A.in[20][chg];
        const float lam = A.in[21][chg]; TAB[7 * 64 + lane] = -8.f * 1.44269504f * log1pf(expf(-lam));
    }
    bf16x8 Wf[2][4][2];
    { const bf16* WG = (const bf16*)(ws + WS_SMALL + SM_WG);
#pragma unroll
      for (int g = 0; g < 2; ++g)
#pragma unroll
        for (int n = 0; n < 4; ++n)
#pragma unroll
            for (int k = 0; k < 2; ++k) Wf[g][n][k] = *(const bf16x8*)(WG + ((h * 2 + g) * 64 + 16 * n + fr) * 64 + 32 * k + 8 * fq); }
    LDS_WAIT(); asm volatile("" ::: "memory");
    const int rbase = sample ? MP + s * 32 : s * TP + c * TC;
    float hst = 0.f, aprod = 1.f;
    if (MODE == 1 && !sample) {
        const float* AG = (const float*)(ws + WS_AGGRG) + ((size_t)(s * NCH) * DM + ch0 + lane) * 2;
        for (int cc = 0; cc < c; ++cc) { const float a = AG[(size_t)cc * DM * 2], b = AG[(size_t)cc * DM * 2 + 1]; hst = a * hst + b; }
    }
    const int ntile = sample ? 2 : 8;
#pragma unroll 1
    for (int tile = 0; tile < ntile; ++tile) {
        const int row = rbase + 16 * tile + fr;
        const int t = sample ? (fr & 7) : c * TC + 16 * tile + fr;
        const int sq = sample ? s * 4 + tile * 2 + (fr >> 3) : s;
        bf16x8 X[2];
#pragma unroll
        for (int k = 0; k < 2; ++k) {
            const int cl = 32 * k + 8 * fq; float xc[8];
            { const f32x4 b0 = *(const LAS f32x4*)(TAB + 4 * 64 + cl), b1 = *(const LAS f32x4*)(TAB + 4 * 64 + cl + 4); xc[0] = b0.x; xc[1] = b0.y; xc[2] = b0.z; xc[3] = b0.w; xc[4] = b1.x; xc[5] = b1.y; xc[6] = b1.z; xc[7] = b1.w; }
#pragma unroll
            for (int d = 0; d < 4; ++d) {
                float v[8];
                if (t - d >= 0) { cvt8(*(const v4u*)(RX + (size_t)(row - d) * DM + ch0 + cl), v); }
                else if (sample) { const float* st = A.in[3] + ((size_t)(sq * 2 + l) * 3 + (3 + t - d)) * DM + ch0 + cl; const f32x4 a0 = *(const f32x4*)st, a1 = *(const f32x4*)(st + 4);
                    v[0] = a0.x; v[1] = a0.y; v[2] = a0.z; v[3] = a0.w; v[4] = a1.x; v[5] = a1.y; v[6] = a1.z; v[7] = a1.w; }
                else {
#pragma unroll
                    for (int q = 0; q < 8; ++q) v[q] = 0.f; }
                const f32x4 w0 = *(const LAS f32x4*)(TAB + (3 - d) * 64 + cl), w1 = *(const LAS f32x4*)(TAB + (3 - d) * 64 + cl + 4);
                xc[0] += w0.x * v[0]; xc[1] += w0.y * v[1]; xc[2] += w0.z * v[2]; xc[3] += w0.w * v[3]; xc[4] += w1.x * v[4]; xc[5] += w1.y * v[5]; xc[6] += w1.z * v[6]; xc[7] += w1.w * v[7];
            }
            *(LAS f32x4*)(XC + fr * 68 + cl) = (f32x4){xc[0], xc[1], xc[2], xc[3]}; *(LAS f32x4*)(XC + fr * 68 + cl + 4) = (f32x4){xc[4], xc[5], xc[6], xc[7]};
            v4u pk; pk.x = pk2(xc[0], xc[1]); pk.y = pk2(xc[2], xc[3]); pk.z = pk2(xc[4], xc[5]); pk.w = pk2(xc[6], xc[7]);
            X[k] = __builtin_bit_cast(bf16x8, pk);
        }
        f32x4 acc[2][4];
#pragma unroll
        for (int g = 0; g < 2; ++g)
#pragma unroll
            for (int n = 0; n < 4; ++n) { acc[g][n] = (f32x4){0.f, 0.f, 0.f, 0.f};
#pragma unroll
                for (int k = 0; k < 2; ++k) acc[g][n] = __builtin_amdgcn_mfma_f32_16x16x32_bf16(Wf[g][n][k], X[k], acc[g][n], 0, 0, 0); }
        LDS_WAIT(); asm volatile("" ::: "memory");
#pragma unroll
        for (int n = 0; n < 4; ++n) { const int cl = 16 * n + 4 * fq;
            const f32x4 xv = *(const LAS f32x4*)(XC + fr * 68 + cl), ba = *(const LAS f32x4*)(TAB + 5 * 64 + cl), bx = *(const LAS f32x4*)(TAB + 6 * 64 + cl), c8 = *(const LAS f32x4*)(TAB + 7 * 64 + cl);
            f32x4 av, bv;
#pragma unroll
            for (int j = 0; j < 4; ++j) { const float r = fsig(acc[0][n][j] + ba[j]), ig = fsig(acc[1][n][j] + bx[j]); const float a = __builtin_amdgcn_exp2f(r * c8[j]);
                av[j] = a; bv[j] = __builtin_amdgcn_sqrtf(fmaxf(1.f - a * a, 0.f)) * ig * xv[j]; }
            *(LAS f32x4*)(AA + fr * 68 + cl) = av; *(LAS f32x4*)(BB + fr * 68 + cl) = bv; }
        LDS_WAIT(); asm volatile("" ::: "memory");
#pragma unroll
        for (int tt = 0; tt < 16; ++tt) {
            if (sample && (tt & 7) == 0) hst = A.in[2][(size_t)((s * 4 + tile * 2 + (tt >> 3)) * 2 + l) * DM + ch0 + lane];
            const float a = AA[tt * 68 + lane], b = BB[tt * 68 + lane];
            hst = a * hst + b; if (MODE == 0) aprod *= a;
            if (MODE == 1) BB[tt * 68 + lane] = hst;
            if (MODE == 1 && sample && (tt & 7) == 7) A.out[O_SRGH + (size_t)((s * 4 + tile * 2 + (tt >> 3)) * 2 + l) * DM + ch0 + lane] = hst;
        }
        if (MODE == 1) {
            LDS_WAIT(); asm volatile("" ::: "memory");
#pragma unroll
            for (int n = 0; n < 4; ++n) { const int cl = 16 * n + 4 * fq; const f32x4 hv = *(const LAS f32x4*)(BB + fr * 68 + cl);
                bf16* p = RY + (size_t)row * DM + ch0 + cl; const u32x2 ry = *(const u32x2*)p;
                u32x2 o; o.x = pk2(hv.x * fgelu(bflo(ry.x)), hv.y * fgelu(bfhi(ry.x))); o.y = pk2(hv.z * fgelu(bflo(ry.y)), hv.w * fgelu(bfhi(ry.y)));
                *(u32x2*)p = o; }
            LDS_WAIT(); asm volatile("" ::: "memory");
        }
    }
    if (MODE == 0) { float* AG = (float*)(ws + WS_AGGRG) + ((size_t)(s * NCH + c) * DM + ch0 + lane) * 2; AG[0] = aprod; AG[1] = hst; }
    if (MODE == 1) {
        if (!sample && c == NCH - 1) {
            A.out[O_PRGH + (size_t)(s * 2 + l) * DM + ch0 + lane] = hst;
#pragma unroll
            for (int k = 0; k < 3; ++k) A.out[O_PRGC + (size_t)((s * 2 + l) * 3 + k) * DM + ch0 + lane] = bf2f(RX[(size_t)(s * TP + TP - 3 + k) * DM + ch0 + lane]);
        }
        if (sample) {
#pragma unroll 1
            for (int q = 0; q < 4; ++q) { const int n = s * 4 + q;
#pragma unroll
                for (int k = 0; k < 3; ++k) A.out[O_SRGC + (size_t)((n * 2 + l) * 3 + k) * DM + ch0 + lane] = bf2f(RX[(size_t)(MP + n * TS + 5 + k) * DM + ch0 + lane]); }
        }
    }
}

__device__ __forceinline__ void rg_unit_sp(const Frame& F, const Args& A, int l, int s, int c, int h) {
    constexpr int MODE = 0; constexpr bool sample = false;
    unsigned char* ws = A.ws;
    LAS float* TAB = (LAS float*)(F.lds + F.wave * 15360);
    LAS float* XC = TAB + 512;
    LAS float* AA = XC + 16 * 68;
    LAS float* BB = AA + 16 * 68;
    const int lane = F.lane, fr = lane & 15, fq = lane >> 4, ch0 = 64 * h;
    const bf16* RX = (const bf16*)(ws + WS_RX); bf16* RY = (bf16*)(ws + WS_RY);
    {
        const int chg = l * DM + ch0 + lane;
#pragma unroll
        for (int j = 0; j < 4; ++j) TAB[j * 64 + lane] = A.in[15][(size_t)(l * 4 + j) * DM + ch0 + lane];
        TAB[4 * 64 + lane] = A.in[16][chg]; TAB[5 * 64 + lane] = A.in[18][chg]; TAB[6 * 64 + lane] = A.in[20][chg];
        const float lam = A.in[21][chg]; TAB[7 * 64 + lane] = -8.f * 1.44269504f * log1pf(expf(-lam));
    }
    bf16x8 Wf[2][4][2];
    { const bf16* WG = (const bf16*)(ws + WS_SMALL + SM_WG);
#pragma unroll
      for (int g = 0; g < 2; ++g)
#pragma unroll
        for (int n = 0; n < 4; ++n)
#pragma unroll
            for (int k = 0; k < 2; ++k) Wf[g][n][k] = *(const bf16x8*)(WG + ((h * 2 + g) * 64 + 16 * n + fr) * 64 + 32 * k + 8 * fq); }
    LDS_WAIT(); asm volatile("" ::: "memory");
    const int rbase = s * TP + c * TC;
    bf16* XQ = (bf16*)(ws + WS_XN);
    float hst = 0.f, aprod = 1.f;
    if (MODE == 1 && !sample) {
        const float* AG = (const float*)(ws + WS_AGGRG) + ((size_t)(s * NCH) * DM + ch0 + lane) * 2;
        for (int cc = 0; cc < c; ++cc) { const float a = AG[(size_t)cc * DM * 2], b = AG[(size_t)cc * DM * 2 + 1]; hst = a * hst + b; }
    }
    v4u nx[2][4]; unsigned short nry[16];
#define RG_LOAD_RX(tl) do { const int row_ = rbase + 16 * (tl) + fr, t_ = c * TC + 16 * (tl) + fr; \
        _Pragma("unroll") for (int k = 0; k < 2; ++k) _Pragma("unroll") for (int d = 0; d < 4; ++d) nx[k][d] = *(const v4u*)(RX + (size_t)(t_ - d >= 0 ? row_ - d : row_) * DM + ch0 + 32 * k + 8 * fq); } while (0)
#define RG_LOAD_RY(tl) do { _Pragma("unroll") for (int tt = 0; tt < 16; ++tt) nry[tt] = RY[(size_t)(rbase + 16 * (tl) + tt) * DM + ch0 + lane]; } while (0)
    RG_LOAD_RX(0); RG_LOAD_RY(0);
#pragma unroll 1
    for (int tile = 0; tile < 8; ++tile) {
        const int row = rbase + 16 * tile + fr;
        const int t = c * TC + 16 * tile + fr;
        const int sq = sample ? s * 16 + tile * 2 + (fr >> 3) : s;
        bf16x8 X[2];
#pragma unroll
        for (int k = 0; k < 2; ++k) {
            const int cl = 32 * k + 8 * fq; float xc[8];
            { const f32x4 b0 = *(const LAS f32x4*)(TAB + 4 * 64 + cl), b1 = *(const LAS f32x4*)(TAB + 4 * 64 + cl + 4); xc[0] = b0.x; xc[1] = b0.y; xc[2] = b0.z; xc[3] = b0.w; xc[4] = b1.x; xc[5] = b1.y; xc[6] = b1.z; xc[7] = b1.w; }
#pragma unroll
            for (int d = 0; d < 4; ++d) {
                float v[8];
                { v4u w_ = nx[k][d]; if (t - d < 0) w_ = (v4u){0u, 0u, 0u, 0u}; cvt8(w_, v); }
                const f32x4 w0 = *(const LAS f32x4*)(TAB + (3 - d) * 64 + cl), w1 = *(const LAS f32x4*)(TAB + (3 - d) * 64 + cl + 4);
                xc[0] += w0.x * v[0]; xc[1] += w0.y * v[1]; xc[2] += w0.z * v[2]; xc[3] += w0.w * v[3]; xc[4] += w1.x * v[4]; xc[5] += w1.y * v[5]; xc[6] += w1.z * v[6]; xc[7] += w1.w * v[7];
            }
            *(LAS f32x4*)(XC + fr * 68 + cl) = (f32x4){xc[0], xc[1], xc[2], xc[3]}; *(LAS f32x4*)(XC + fr * 68 + cl + 4) = (f32x4){xc[4], xc[5], xc[6], xc[7]};
            v4u pk; pk.x = pk2(xc[0], xc[1]); pk.y = pk2(xc[2], xc[3]); pk.z = pk2(xc[4], xc[5]); pk.w = pk2(xc[6], xc[7]);
            X[k] = __builtin_bit_cast(bf16x8, pk);
        }
        if (tile < 7) RG_LOAD_RX(tile + 1);
        f32x4 acc[2][4];
#pragma unroll
        for (int g = 0; g < 2; ++g)
#pragma unroll
            for (int n = 0; n < 4; ++n) { acc[g][n] = (f32x4){0.f, 0.f, 0.f, 0.f};
#pragma unroll
                for (int k = 0; k < 2; ++k) acc[g][n] = __builtin_amdgcn_mfma_f32_16x16x32_bf16(Wf[g][n][k], X[k], acc[g][n], 0, 0, 0); }
        LDS_WAIT(); asm volatile("" ::: "memory");
#pragma unroll
        for (int n = 0; n < 4; ++n) { const int cl = 16 * n + 4 * fq;
            const f32x4 xv = *(const LAS f32x4*)(XC + fr * 68 + cl), ba = *(const LAS f32x4*)(TAB + 5 * 64 + cl), bx = *(const LAS f32x4*)(TAB + 6 * 64 + cl), c8 = *(const LAS f32x4*)(TAB + 7 * 64 + cl);
            f32x4 av, bv;
#pragma unroll
            for (int j = 0; j < 4; ++j) { const float r = fsig(acc[0][n][j] + ba[j]), ig = fsig(acc[1][n][j] + bx[j]); const float a = __builtin_amdgcn_exp2f(r * c8[j]);
                av[j] = a; bv[j] = __builtin_amdgcn_sqrtf(fmaxf(1.f - a * a, 0.f)) * ig * xv[j]; }
            *(LAS f32x4*)(AA + fr * 68 + cl) = av; *(LAS f32x4*)(BB + fr * 68 + cl) = bv; }
        LDS_WAIT(); asm volatile("" ::: "memory");
#pragma unroll
        for (int tt = 0; tt < 16; ++tt) {
            const float a = AA[tt * 68 + lane], b = BB[tt * 68 + lane];
            hst = a * hst + b; aprod *= a;
            const float g = fgelu(bf2f(nry[tt]));
            const size_t o = (size_t)(rbase + 16 * tile + tt) * DM + ch0 + lane; const unsigned pq = pk2(hst * g, aprod * g); RY[o] = (bf16)(pq & 0xffffu); XQ[o] = (bf16)(pq >> 16);
        }
        if (tile < 7) RG_LOAD_RY(tile + 1);
        LDS_WAIT(); asm volatile("" ::: "memory");
    }
    unsigned long long* AGT = (unsigned long long*)(ws + WS_AGT) + ((size_t)(l * 128 + s * 16 + h) * 16) * 64 + lane;
    __hip_atomic_store(AGT + (size_t)c * 64, ((unsigned long long)__float_as_uint(hst) << 32) | __float_as_uint(fmaxf(aprod, 1e-30f)), __ATOMIC_RELAXED, __HIP_MEMORY_SCOPE_AGENT);
}
__device__ __forceinline__ void rg_unit_sp2(const Frame& F, const Args& A, int l, int s, int c, int h) {
    unsigned char* ws = A.ws;
    const int lane = F.lane, ch0 = 64 * h;
    const bf16* RX = (const bf16*)(ws + WS_RX); bf16* RY = (bf16*)(ws + WS_RY); bf16* XQ = (bf16*)(ws + WS_XN);
    const int rbase = s * TP + c * TC;
    unsigned long long* AGT = (unsigned long long*)(ws + WS_AGT) + ((size_t)(l * 128 + s * 16 + h) * 16) * 64 + lane;
    float hst, aprod; { const unsigned long long v = __hip_atomic_load(AGT + (size_t)c * 64, __ATOMIC_RELAXED, __HIP_MEMORY_SCOPE_AGENT); aprod = __uint_as_float((unsigned)v); hst = __uint_as_float((unsigned)(v >> 32)); }
    float hin = 0.f;
    {   unsigned long long av[NCH - 1];
#pragma unroll
        for (int cc = 0; cc < NCH - 1; ++cc) av[cc] = (cc < c) ? __hip_atomic_load(AGT + (size_t)cc * 64, __ATOMIC_RELAXED, __HIP_MEMORY_SCOPE_AGENT) : 0ull;
#pragma unroll
        for (int cc = 0; cc < NCH - 1; ++cc) if (cc < c) {
            unsigned long long v = av[cc]; unsigned sp_ = 0;
            while (!(__uint_as_float((unsigned)v) > 0.f) && sp_ < (1u << 22)) { __builtin_amdgcn_s_sleep(2); v = __hip_atomic_load(AGT + (size_t)cc * 64, __ATOMIC_RELAXED, __HIP_MEMORY_SCOPE_AGENT); ++sp_; }
            hin = __uint_as_float((unsigned)v) * hin + __uint_as_float((unsigned)(v >> 32));
        } }
    if (c > 0) {
        asm volatile("s_waitcnt vmcnt(0)" ::: "memory");
#pragma unroll 1
        for (int tile = 0; tile < 8; ++tile) {
            unsigned short pv[16], qv[16];
#pragma unroll
            for (int tt = 0; tt < 16; ++tt) { const size_t o = (size_t)(rbase + 16 * tile + tt) * DM + ch0 + lane; pv[tt] = RY[o]; qv[tt] = XQ[o]; }
#pragma unroll
            for (int tt = 0; tt < 16; ++tt) RY[(size_t)(rbase + 16 * tile + tt) * DM + ch0 + lane] = (bf16)f2bf(bf2f(pv[tt]) + bf2f(qv[tt]) * hin);
        }
    }
    if (c == NCH - 1) {
        A.out[O_PRGH + (size_t)(s * 2 + l) * DM + ch0 + lane] = hst + aprod * hin;
#pragma unroll
        for (int k = 0; k < 3; ++k) A.out[O_PRGC + (size_t)((s * 2 + l) * 3 + k) * DM + ch0 + lane] = bf2f(RX[(size_t)(s * TP + TP - 3 + k) * DM + ch0 + lane]);
    }
}

template <int MODE> __device__ __forceinline__ void s5_unit(const Frame& F, const Args& A, int l, bool sample, int s, int c, int g) {
    unsigned char* ws = A.ws;
    LAS float* BU = (LAS float*)(F.lds + F.wave * 15360);
    LAS bf16* XS = (LAS bf16*)(F.lds + F.wave * 15360 + 16 * 132 * 4);
    const int lane = F.lane, fr = lane & 15, fq = lane >> 4;
    bf16* SX = (bf16*)(ws + WS_SX);
    bf16x8 Bf[8], Cf[4];
    { const bf16* BBm = (const bf16*)(ws + WS_SMALL + SM_BBAR) + (size_t)g * 128 * 16;
#pragma unroll
      for (int n = 0; n < 8; ++n) { v4u z = {0u, 0u, 0u, 0u}; if (fq < 2) z = *(const v4u*)(BBm + (16 * n + fr) * 16 + 8 * fq); Bf[n] = __builtin_bit_cast(bf16x8, z); }
      const bf16* CM = (const bf16*)(ws + WS_SMALL + SM_CMAT) + (size_t)g * 16 * 128;
#pragma unroll
      for (int kk = 0; kk < 4; ++kk) Cf[kk] = *(const bf16x8*)(CM + fr * 128 + 32 * kk + 8 * fq); }
    const float ar = ((const float*)(ws + WS_SMALL + SM_ABAR))[(g * 64 + lane) * 2], ai = ((const float*)(ws + WS_SMALL + SM_ABAR))[(g * 64 + lane) * 2 + 1];
    const f32x4 dv = *(const f32x4*)(A.in[28] + l * 512 + 16 * g + 4 * fq);
    const int rbase = sample ? MP + s * 32 : s * TP + c * TC;
    float xr = 0.f, xi = 0.f;
    if (MODE == 1 && !sample) {
        const float tr = ((const float*)(ws + WS_SMALL + SM_ABARTC))[(g * 64 + lane) * 2], ti = ((const float*)(ws + WS_SMALL + SM_ABARTC))[(g * 64 + lane) * 2 + 1];
        const float* AG = (const float*)(ws + WS_AGGS5) + ((size_t)(s * NCH) * 2048 + g * 64 + lane) * 2;
        f32x2 ag[NCH - 1];
#pragma unroll
        for (int cc = 0; cc < NCH - 1; ++cc) ag[cc] = (cc < c) ? *(const f32x2*)(AG + (size_t)cc * 4096) : (f32x2){0.f, 0.f};
#pragma unroll
        for (int cc = 0; cc < NCH - 1; ++cc) if (cc < c) { const float nr = tr * xr - ti * xi + ag[cc].x, ni = tr * xi + ti * xr + ag[cc].y; xr = nr; xi = ni; }
    }
    const int ntile = sample ? 2 : 8;
#define S5_BU(uz_) do { const bf16x8 U_ = __builtin_bit_cast(bf16x8, uz_); _Pragma("unroll") for (int n = 0; n < 8; ++n) { \
        f32x4 a_ = __builtin_amdgcn_mfma_f32_16x16x32_bf16(Bf[n], U_, (f32x4){0.f, 0.f, 0.f, 0.f}, 0, 0, 0); *(LAS f32x4*)(BU + fr * 132 + 16 * n + 4 * fq) = a_; } } while (0)
    v4u un = {0u, 0u, 0u, 0u}; u32x2 sxc = {0u, 0u};
    { v4u u0 = {0u, 0u, 0u, 0u}; if (fq < 2) u0 = *(const v4u*)(SX + (size_t)(rbase + fr) * 512 + 16 * g + 8 * fq);
      if (fq < 2) un = *(const v4u*)(SX + (size_t)(rbase + 16 + fr) * 512 + 16 * g + 8 * fq);
      if (MODE == 1) sxc = *(const u32x2*)(SX + (size_t)(rbase + fr) * 512 + 16 * g + 4 * fq);
      S5_BU(u0); }
#pragma unroll 1
    for (int tile = 0; tile < ntile; ++tile) {
        const int row = rbase + 16 * tile + fr;
        LDS_WAIT(); asm volatile("" ::: "memory");
        float br[16], bi[16];
#pragma unroll
        for (int tt = 0; tt < 16; ++tt) { br[tt] = BU[tt * 132 + lane]; bi[tt] = BU[tt * 132 + 64 + lane]; }
        u32x2 sxn = {0u, 0u};
        if (tile + 1 < ntile) {
            S5_BU(un);
            if (tile + 2 < ntile && fq < 2) un = *(const v4u*)(SX + (size_t)(row + 32) * 512 + 16 * g + 8 * fq);
            if (MODE == 1) sxn = *(const u32x2*)(SX + (size_t)(row + 16) * 512 + 16 * g + 4 * fq);
        }
#pragma unroll
        for (int tt = 0; tt < 16; ++tt) {
            if (sample && (tt & 7) == 0) { const size_t si = ((size_t)((s * 4 + tile * 2 + (tt >> 3)) * 2 + l) * 32 + g) * 64 + lane; xr = A.in[4][si]; xi = A.in[5][si]; }
            const float nr = ar * xr - ai * xi + br[tt], ni = ar * xi + ai * xr + bi[tt]; xr = nr; xi = ni;
            if (MODE == 1) { const unsigned xx = pk2(xr, xi); XS[tt * 136 + lane] = (bf16)(xx & 0xffffu); XS[tt * 136 + 64 + lane] = (bf16)(xx >> 16); }
            if (MODE == 1 && sample && (tt & 7) == 7) { const size_t si = ((size_t)((s * 4 + tile * 2 + (tt >> 3)) * 2 + l) * 32 + g) * 64 + lane; A.out[O_SS5R + si] = xr; A.out[O_SS5I + si] = xi; }
        }
        if (MODE == 1) {
            LDS_WAIT(); asm volatile("" ::: "memory");
            f32x4 y = {0.f, 0.f, 0.f, 0.f};
#pragma unroll
            for (int kk = 0; kk < 4; ++kk) { const bf16x8 xb = *(const LAS bf16x8*)(XS + fr * 136 + 32 * kk + 8 * fq); y = __builtin_amdgcn_mfma_f32_16x16x32_bf16(Cf[kk], xb, y, 0, 0, 0); }
            bf16* p = SX + (size_t)row * 512 + 16 * g + 4 * fq; const u32x2 sx = sxc;
            u32x2 o; o.x = pk2(fgelu(y.x + dv.x * bflo(sx.x)), fgelu(y.y + dv.y * bfhi(sx.x))); o.y = pk2(fgelu(y.z + dv.z * bflo(sx.y)), fgelu(y.w + dv.w * bfhi(sx.y)));
            *(u32x2*)p = o;
        }
        sxc = sxn;
    }
    LDS_WAIT(); asm volatile("" ::: "memory");
#undef S5_BU
    if (MODE == 0) { float* AG = (float*)(ws + WS_AGGS5) + ((size_t)(s * NCH + c) * 2048 + g * 64 + lane) * 2; AG[0] = xr; AG[1] = xi; }
    if (MODE == 1 && !sample && c == NCH - 1) { const size_t si = ((size_t)(s * 2 + l) * 32 + g) * 64 + lane; A.out[O_PS5R + si] = xr; A.out[O_PS5I + si] = xi; }
}

template <int MODE> __device__ __forceinline__ void mixer_phase(const Frame& F0, const Args& A, int l, int qi, int b0) {
    const Frame F = refresh(F0);
    int bx_ = blockIdx.x; asm volatile("" : "+s"(bx_)); if (bx_ < b0) return;
    gu32* q = F.ctl + CW_Q + 64 * qi;
    constexpr int N_A = MODE == 0 ? 2048 : NSP * NCH * 32, N_B = MODE == 0 ? 32 * 16 : 32 * 32, N_C = MODE == 0 ? NSP * (NCH - 1) * 32 : 0;
    constexpr int NTOT = N_A + N_B + N_C;
    (void)q;
    const int nb_ = F.G - b0, bl_ = bx_ - b0, vb_ = (nb_ % 8 == 0) ? (bl_ % 8) * (nb_ / 8) + bl_ / 8 : bl_, gw = F.wave * nb_ + vb_, NGW = nb_ * NWAVES;
    for (int u0 = gw; u0 < NTOT; u0 += NGW) {
        int u = u0;
        if (MODE == 0) {
            if (u < N_A) { const int c = u >> 7, sh = u & 127; rg_unit_sp(F, A, l, sh >> 4, c, sh & 15); continue; } u -= N_A;
            if (u < N_B) { rg_unit<1>(F, A, l, true, u >> 4, 0, u & 15); continue; } u -= N_B;
            { const int g = u & 31, r = u >> 5, c = r % (NCH - 1), s2 = r / (NCH - 1); s5_unit<0>(F, A, l, false, s2, c, g); }
        } else {
            if (u < N_A) { const int g = u & 31, r = u >> 5, c = r % NCH, s2 = r / NCH; s5_unit<1>(F, A, l, false, s2, c, g); continue; } u -= N_A;
            s5_unit<1>(F, A, l, true, u >> 5, 0, u & 31);
        }
    }
    if (MODE == 0 && gw < N_A) { const int c = gw >> 7, sh = gw & 127; rg_unit_sp2(F, A, l, sh >> 4, c, sh & 15); }
}

__device__ __forceinline__ void ffn_fixup_local(const Frame& F0, const Args& A, int l, int pm) {
    const Frame F = refresh(F0);
    if (pm < 64 && (pm & 7) != 0) {
        const float* HALO = (const float*)(A.ws + WS_HALO); bf16* HF = (bf16*)(A.ws + WS_HFF);
        const float* cw = A.in[34] + (size_t)l * 3 * FF2; const float* cb = A.in[35] + (size_t)l * FF2;
        for (int c = F.tid; c < FF; c += NWAVES * 64) {
            float uc0[2], uc1[2];
#pragma unroll
            for (int bj = 0; bj < 2; ++bj) {
                const float a254 = HALO[((size_t)((pm - 1) * 4 + 0) * 2 + bj) * FF + c], a255 = HALO[((size_t)((pm - 1) * 4 + 1) * 2 + bj) * FF + c];
                const float r0 = HALO[((size_t)(pm * 4 + 2) * 2 + bj) * FF + c], r1 = HALO[((size_t)(pm * 4 + 3) * 2 + bj) * FF + c];
                const float w0 = cw[bj * FF + c], w1 = cw[FF2 + bj * FF + c], w2 = cw[2 * FF2 + bj * FF + c], b = cb[bj * FF + c];
                uc0[bj] = b + w0 * a254 + w1 * a255 + w2 * r0; uc1[bj] = b + w0 * a255 + w1 * r0 + w2 * r1;
            }
            HF[(size_t)(pm * 256) * FF + c] = (bf16)f2bf(fgelu(uc0[0]) * uc0[1]); HF[(size_t)(pm * 256 + 1) * FF + c] = (bf16)f2bf(fgelu(uc1[0]) * uc1[1]);
        }
    }
    asm volatile("s_waitcnt vmcnt(0)" ::: "memory"); __syncthreads();
}

__global__ void __launch_bounds__(NWAVES * 64, 2) hawk_fwd(Args args) {
    extern __shared__ __attribute__((aligned(16))) unsigned char lds[];
    Frame F;
    F.lds = (LAS unsigned char*)lds;
    F.MISC = (volatile LAS unsigned*)(F.lds + MISC_OFF);
    F.tid = threadIdx.x; F.lane = F.tid & 63; F.wave = __builtin_amdgcn_readfirstlane(F.tid >> 6);
    F.G = gridDim.x; { const int bx = blockIdx.x; F.vcu = (F.G % 8 == 0) ? (bx % 8) * (F.G / 8) + bx / 8 : bx; }
    unsigned char* ws = args.ws;
    F.ctl = (gu32*)(ws + WS_CTL);
    for (int u = F.tid; u < (LDS_BYTES - LDSCTL_OFF) / 4; u += NWAVES * 64) ((LAS unsigned*)(F.lds + LDSCTL_OFF))[u] = 0u;
    __syncthreads();
    XcdBarrier bar = xcd_barrier_post((unsigned*)(F.ctl + CW_BAR), F.MISC + 8);
#define GRID_BAR() xcd_barrier(bar)

#pragma unroll 1
    for (int st = 0; st < NST_MAX; ++st) {
        unsigned char* ws = args.ws; float* outp = args.out; asm volatile("" : "+s"(ws), "+s"(outp));
        bf16* XRB = (bf16*)(ws + WS_XRB); float* MOD = (float*)(ws + WS_MOD); bf16* XN = (bf16*)(ws + WS_XN); int bid = (int)blockIdx.x; asm volatile("" : "+s"(bid));
        const int l = st < 2 ? 0 : (st - 2) / 10, sub = st < 2 ? st - 2 : (st == 22 ? 99 : (st - 2) % 10);
        const int ll = st == 22 ? 1 : l;
        const float* xin_p = ll == 0 ? args.in[0] : nullptr; const float* xin_s = ll == 0 ? args.in[1] - (size_t)MP * DM : nullptr;
        const float* modl = MOD + ll * 6144;
        bool is_gemm = false; pg8::Gemm g{nullptr, nullptr, 0, 0, 0, 0, 0}; pg8::EpiAny E{0, false, ws, nullptr, nullptr, nullptr, nullptr, 0, ll, (PG8_LAS float*)(F.lds + XCH_OFF)};
        switch (sub) {
            case -1: is_gemm = true; g = pg8::Gemm{(const pg8::bf16_t*)(ws + WS_SILUC), (const pg8::bf16_t*)(ws + WS_WADA), 256, MODW, DM, DM, DM}; E.mode = pg8::EM_ADA; E.perm = false; E.p0 = args.in[10]; E.out = MOD; break;
            case 1: is_gemm = true; g = pg8::Gemm{(const pg8::bf16_t*)XN, (const pg8::bf16_t*)(ws + WS_WIN), MROWS, INW, DM, DM, DM}; E.mode = pg8::EM_IN; E.perm = true; E.p0 = args.in[14] + l * INW; break;
            case 3: case 4: is_gemm = true; g = pg8::Gemm{(const pg8::bf16_t*)(ws + WS_RY), (const pg8::bf16_t*)(ws + WS_WRG), MROWS, DM, DM, DM, DM}; E.mode = pg8::EM_RGP; E.perm = true; break;
            case 5: is_gemm = true; g = pg8::Gemm{(const pg8::bf16_t*)(ws + WS_SX), (const pg8::bf16_t*)(ws + WS_WGLU), MROWS, 2048, 512, 512, 512}; E.mode = pg8::EM_GLU; E.perm = true; break;
            case 6: is_gemm = true; g = pg8::Gemm{(const pg8::bf16_t*)(ws + WS_GA), (const pg8::bf16_t*)(ws + WS_WOUT), MROWS, DM, DM, DM, DM}; E.mode = pg8::EM_RES; E.perm = true; E.p0 = xin_p; E.p2 = modl + 2048; E.row_off = 0; break;
            case 8: is_gemm = true; g = pg8::Gemm{(const pg8::bf16_t*)XN, (const pg8::bf16_t*)(ws + WS_WUP), MROWS, FF2, DM, DM, DM}; E.mode = pg8::EM_UPF; E.perm = true; E.p0 = args.in[34] + (size_t)l * 3 * FF2; E.p1 = args.in[35] + (size_t)l * FF2; E.p2 = args.in[6]; E.out = outp; break;
            case 9: is_gemm = true; g = pg8::Gemm{(const pg8::bf16_t*)(ws + WS_HFF), (const pg8::bf16_t*)(ws + WS_WDOWN), MROWS, DM, FF, FF, FF}; E.mode = pg8::EM_RES; E.perm = true; E.p0 = nullptr; E.p2 = modl + 5120; E.row_off = 1; break;
            default: break;
        }
#ifndef DUP
#define DUP 0
#endif
        const int nrep = (DUP == 1 && sub == 2) || (DUP == 2 && (st == 0 || (sub == 0 && l == 1))) || (DUP == 3 && sub == 8) || (DUP == 4 && (sub == 0 || sub == 7)) || (DUP == 5 && sub == 1) || (DUP == 6 && sub == 6 && l == 0) || (DUP == 7 && ((sub == 0 && l == 0 && st >= 2) || sub == 9)) ? 2 : 1;
#pragma unroll 1
        for (int rep = 0; rep < nrep; ++rep) {
        if (rep == 1) GRID_BAR();
        if (st < 2 || (sub == 0 && l == 1)) p0_weights(F, args, l, st == 0 ? 0 : 1, st == 1 ? 48 : 0, st == 1 ? F.G - 48 : F.G);
        if (sub == 0 || sub == 7) norm_rows(F, sub == 0 ? xin_p : nullptr, sub == 0 ? xin_s : nullptr, XRB, (sub == 0 ? args.in[11] : args.in[12]) + l * DM, modl + (sub == 0 ? 0 : 3072), modl + (sub == 0 ? 1024 : 4096), XN,
                                            sub == 7 ? 4 : (l == 1 ? 12 : 0), sub == 7 ? modl + 2048 : MOD + 5120, (const float*)(ws + (sub == 7 ? WS_PART_OUT : WS_PART_DOWN)));
        if (sub == 2) mixer_phase<0>(F, args, l, l * 2 + rep * 4, 0);
        if (sub == 3) mixer_phase<1>(F, args, l, l * 2 + 1, 16);
        if (is_gemm) { pg8::SplitOrder S; S.init(g.M, g.N, g.K, F.G, bid, (sub == 6 || sub == 9) ? 1 : (sub == 4 ? 2 : (sub == 3 ? 3 : 0)), 256);
            if (sub == 9) { pg8::Unit u0; ffn_fixup_local(F, args, l, S.next(0, u0) ? u0.pm : 64); } pg8::gemm_phase<pg8::EpiAny, pg8::SplitOrder, true, true>(F.lds, g, S, E); }
        }
        if (sub == 99) final_norm(F, XRB, outp + O_Y, args.in[37], 12, MOD + 6144 + 5120, (const float*)(ws + WS_PART_DOWN)); else GRID_BAR();
    }
}

extern "C" void kernel_launch(void* const* d_in, const int* in_sizes, int n_in, void* d_out, int out_size, void* d_ws, size_t ws_size, hipStream_t stream) {
    static int grid = 0;
    if (grid == 0) {
        if (n_in != 38 || out_size != 23396352 || ws_size < WS_END) { fprintf(stderr, "kernel_launch: unexpected shapes (n_in %d out %d ws %zu)\n", n_in, out_size, ws_size); grid = -1; return; }
        int dev = 0, cus = 0, per_cu = 0;
        if (hipGetDevice(&dev) != hipSuccess || hipDeviceGetAttribute(&cus, hipDeviceAttributeMultiprocessorCount, dev) != hipSuccess) { grid = -1; return; }
        if (hipFuncSetAttribute((const void*)hawk_fwd, hipFuncAttributeMaxDynamicSharedMemorySize, LDS_BYTES) != hipSuccess) { fprintf(stderr, "kernel_launch: hipFuncSetAttribute failed\n"); grid = -1; return; }
        if (hipOccupancyMaxActiveBlocksPerMultiprocessor(&per_cu, (const void*)hawk_fwd, NWAVES * 64, LDS_BYTES) != hipSuccess || per_cu < 1) { fprintf(stderr, "kernel_launch: occupancy query says %d\n", per_cu); per_cu = 1; }
        (void)hipGetLastError();
        grid = cus;
    }
    if (grid < 0) return;
    if (hipMemsetAsync((char*)d_ws + WS_CTL, 0, CTL_ZERO_BYTES, stream) != hipSuccess) { fprintf(stderr, "kernel_launch: memset failed\n"); return; }
    if (hipMemsetAsync((char*)d_ws + WS_AGT, 0, 2 * MiB, stream) != hipSuccess) { fprintf(stderr, "kernel_launch: memset 2 failed\n"); return; }
    Args a{};
    for (int i = 0; i < 38; ++i) a.in[i] = (const float*)d_in[i];
    a.out = (float*)d_out; a.ws = (unsigned char*)d_ws;
    hipLaunchKernelGGL(hawk_fwd, dim3(grid), dim3(NWAVES * 64), LDS_BYTES, stream, a);
}
```

```cpp
#include <hip/hip_runtime.h>
#include <cstdio>
#include <cstdint>
namespace pg8 {
#define PG8_LAS __attribute__((address_space(3)))
typedef unsigned short bf16_t;
typedef short bf16x8 __attribute__((ext_vector_type(8)));
typedef float f32x4 __attribute__((ext_vector_type(4)));
typedef unsigned u32x4 __attribute__((ext_vector_type(4)));
constexpr int BM = 256, BK = 64, HALF = 128, HTB = HALF * BK * 2  , STAGE_BYTES = 8 * HTB, NXCD = 8, WGM = 8;

__host__ __device__ __forceinline__ int lds_byte(int r, int c) { const int st = (r >> 4) * 2 + (c >> 5), rr = r & 15, cc = c & 31, ob = rr * 64 + cc * 2; return st * 1024 + (ob ^ (((ob >> 9) & 1) << 5)); }
__host__ __device__ __forceinline__ void stage_rc(int b, int& R, int& C) { const int st = b / 1024, sb = b % 1024, swz = sb ^ (((sb >> 9) & 1) << 5); R = (st >> 1) * 16 + swz / 64; C = (st & 1) * 32 + (swz % 64) / 2; }
__host__ __device__ __forceinline__ int perm32(int rho) { const int n = rho >> 4, i = rho & 15; return 8 * (i >> 2) + 4 * n + (i & 3); }

struct Unit { int pm, pn, koff, nt, mini, ksl; };
struct Gemm { const bf16_t* A; const bf16_t* Bt; int M, N, K, lda, ldb; };

struct StaticOrder {
    int nM, nN, nwg, G, c, ntK;
    __host__ __device__ void init(int M, int N, int G_, int c_, int K_ = 128) { nM = M / BM; nN = N / BM; nwg = nM * nN; G = G_; c = c_; ntK = K_ / BK; }
    __host__ __device__ bool next(int i, Unit& u) const {
        const long L = (long)i * G + c; if (L >= nwg) return false;
        int wgid = (int)L; { const int q = nwg / NXCD, r = nwg % NXCD, xcd = wgid % NXCD, off = wgid / NXCD; wgid = (xcd < r ? xcd * (q + 1) : r * (q + 1) + (xcd - r) * q) + off; }
        const int nig = WGM * nN, gid = wgid / nig, fm = gid * WGM, gsz = (nM - fm) < WGM ? (nM - fm) : WGM;
        u.pm = fm + ((wgid % nig) % gsz); u.pn = (wgid % nig) / gsz; u.koff = 0; u.nt = ntK; u.mini = 0; u.ksl = 256; return true;
    }
    __device__ __forceinline__ void a_ready(const Unit&) const {}
    __device__ __forceinline__ void done(const Unit&) const {}
};
struct SplitOrder {
    StaticOrder so; int nslice, nmini, rounds, smode, ksl;
    __device__ void init(int M, int N, int K, int G_, int c_, int smode_, int ksl_) { smode = smode_; ksl = ksl_; so.init(smode_ == 0 ? M : 16384, N, G_, c_, K); nslice = K / ksl_; nmini = smode_ == 1 ? 4 * (N / BM) * nslice : 0; rounds = (so.nwg + G_ - 1) / G_; }
    __device__ bool next(int i, Unit& u) const {
        const long L = (long)i * so.G + so.c;
        if (smode == 3) { if (L >= 4 * so.nN) return false; u.pm = 64 + (int)L / so.nN; u.pn = (int)L % so.nN; u.koff = 0; u.nt = so.ntK; u.mini = 0; u.ksl = 256; return true; }
        if (L < so.nwg) return so.next(i, u);
        const int mm = (int)(L - so.nwg);
        if (mm >= nmini) return false;
        const int kc = mm % nslice, t16 = mm / nslice; u.pm = 64 + t16 / so.nN; u.pn = t16 % so.nN; u.koff = kc * ksl; u.nt = ksl / BK; u.mini = 1; u.ksl = ksl; return true;
    }
    __device__ __forceinline__ void a_ready(const Unit&) const {}
    __device__ __forceinline__ void done(const Unit&) const {}
};


__device__ __forceinline__ unsigned cvt_pk_bf16(float lo, float hi) { unsigned r; asm volatile("v_cvt_pk_bf16_f32 %0, %1, %2" : "=v"(r) : "v"(lo), "v"(hi)); return r; }
typedef float f32x2 __attribute__((ext_vector_type(2)));
__device__ __forceinline__ f32x2 gelu_pk(f32x2 v) {
    const f32x2 av = __builtin_elementwise_abs(v), d = av * 0.2316418882f + 1.0f;
    f32x2 t; t.x = __builtin_amdgcn_rcpf(d.x); t.y = __builtin_amdgcn_rcpf(d.y);
    f32x2 q = t * 0.5307027145f + (-0.7265760135f); q = q * t + 0.7107068705f; q = q * t + (-0.142248368f); q = q * t + 0.127414796f; q = q * t;
    const f32x2 s = (v * v) * (-0.72134752044f);
    f32x2 e; e.x = __builtin_amdgcn_exp2f(s.x); e.y = __builtin_amdgcn_exp2f(s.y);
    const f32x2 m = v * (q * e), r = v - m;
    f32x2 o; o.x = v.x < 0.f ? m.x : r.x; o.y = v.y < 0.f ? m.y : r.y; return o;
}

template <int ACT  > struct EpiBf16 {
    static constexpr bool PERM = true, AFTER_DRAIN = false; static_assert(ACT == 0 || ACT == 1, "EpiBf16: ACT is 0 (none) or 1 (gelu_pk)");
    bf16_t* O; int ldc; const float* bias; int split_cols; size_t split_stride; float scale0;
    __device__ __forceinline__ void operator()(const f32x4 (&acc)[2][2][4][2], const Unit& u, int wr, int wc, int fr, int fq) const {
        const int row0 = u.pm * BM + wr * 64 + fr; int colt = u.pn * BM; bf16_t* base = O;
        float sc = 1.f; if (split_cols) { const int t = colt / split_cols; base += (size_t)t * split_stride; colt -= t * split_cols; if (t == 0) sc = scale0; }
        const int col0 = colt + wc * 32 + 8 * fq, bcol0 = u.pn * BM + wc * 32 + 8 * fq;
        f32x4 bv[2][2];
#pragma unroll
        for (int bj = 0; bj < 2; ++bj)
#pragma unroll
            for (int n = 0; n < 2; ++n) bv[bj][n] = bias ? *(const f32x4*)(bias + bcol0 + bj * HALF + 4 * n) : (f32x4){0.f, 0.f, 0.f, 0.f};
#pragma unroll
        for (int ai = 0; ai < 2; ++ai)
#pragma unroll
            for (int m = 0; m < 4; ++m) { bf16_t* rowp = base + (size_t)(row0 + ai * HALF + m * 16) * ldc + col0;
#pragma unroll
                for (int bj = 0; bj < 2; ++bj) { f32x4 v0 = acc[ai][bj][m][0] + bv[bj][0], v1 = acc[ai][bj][m][1] + bv[bj][1];
                    if (ACT == 1) { f32x2 a = gelu_pk((f32x2){v0[0], v0[1]}), b = gelu_pk((f32x2){v0[2], v0[3]}), c = gelu_pk((f32x2){v1[0], v1[1]}), d = gelu_pk((f32x2){v1[2], v1[3]});
                        v0 = (f32x4){a.x, a.y, b.x, b.y}; v1 = (f32x4){c.x, c.y, d.x, d.y}; }
                    v0 = v0 * sc; v1 = v1 * sc; u32x4 w; w.x = cvt_pk_bf16(v0[0], v0[1]); w.y = cvt_pk_bf16(v0[2], v0[3]); w.z = cvt_pk_bf16(v1[0], v1[1]); w.w = cvt_pk_bf16(v1[2], v1[3]);
                    *(u32x4*)(rowp + bj * HALF) = w; } }
    }
};

template <class Epi, class Sched, bool ALIGN_EPI, bool SP2>
__device__ __forceinline__ void gemm_phase(PG8_LAS unsigned char* lds, const Gemm g, const Sched& S, const Epi& E) {
    int tid_ = threadIdx.x; asm volatile("" : "+v"(tid_));
    const int tid = tid_, wid = __builtin_amdgcn_readfirstlane(tid >> 6), lane = tid & 63, wr = wid >> 2, wc = wid & 3, fr = lane & 15, fq = lane >> 4;
    const int lda = g.lda, ldb = g.ldb;
    unsigned voffA[2], voffB[2];
#pragma unroll
    for (int i = 0; i < 2; ++i) { int R, C; stage_rc(tid * 16 + i * 8192, R, C); const int Rb = E.perm ? ((R & ~31) + perm32(R & 31)) : R;
        voffA[i] = (unsigned)(R * lda + C) * 2u; voffB[i] = (unsigned)(Rb * ldb + C) * 2u; }
    const size_t kstep = (size_t)(BK * 2);
    const size_t hstepA = (size_t)HALF * lda * 2, hstepB = (size_t)HALF * ldb * 2;
    const size_t tstepA = 2 * hstepA, tstepB = 2 * hstepB;
    const unsigned ldsw = (unsigned)wid * 1024u;
    const int aoff = lds_byte(wr * 64 + fr, fq * 8), boff = lds_byte(wc * 32 + fr, fq * 8);
#define PG8_SA(b, h) (((b) * 2 + (h)) * HTB)
#define PG8_SB(b, h) ((4 + (b) * 2 + (h)) * HTB)
#define PG8_STAGE(bufoff, gbase, voff) do { _Pragma("unroll") for (int _i = 0; _i < 2; ++_i) \
        __builtin_amdgcn_global_load_lds((const unsigned*)((const char*)(gbase) + (voff)[_i]), (PG8_LAS unsigned*)(lds + (bufoff) + ldsw + _i * 8192), 16, 0, 0); } while (0)
#define PG8_LDA(dst, b, h) do { _Pragma("unroll") for (int m = 0; m < 4; ++m) _Pragma("unroll") for (int k = 0; k < 2; ++k) dst[m][k] = *(const PG8_LAS bf16x8*)(lds + PG8_SA(b, h) + aoff + m * 2048 + k * 1024); } while (0)
#define PG8_LDB(dst, b, h) do { _Pragma("unroll") for (int n = 0; n < 2; ++n) _Pragma("unroll") for (int k = 0; k < 2; ++k) dst[n][k] = *(const PG8_LAS bf16x8*)(lds + PG8_SB(b, h) + boff + n * 2048 + k * 1024); } while (0)
#define PG8_MMA(ai, bj, At, Bt) do { __builtin_amdgcn_s_setprio(1); _Pragma("unroll") for (int m = 0; m < 4; ++m) _Pragma("unroll") for (int n = 0; n < 2; ++n) _Pragma("unroll") for (int k = 0; k < 2; ++k) \
        acc[ai][bj][m][n] = __builtin_amdgcn_mfma_f32_16x16x32_bf16(Bt[n][k], At[m][k], acc[ai][bj][m][n], 0, 0, 0); __builtin_amdgcn_s_setprio(0); } while (0)
#define PG8_WAIT_V(n) asm volatile("s_waitcnt vmcnt(" #n ")" ::: "memory")
#define PG8_WAIT_L(n) asm volatile("s_waitcnt lgkmcnt(" #n ")" ::: "memory")
#define PG8_BAR __builtin_amdgcn_s_barrier()
#define PG8_SCHED __builtin_amdgcn_sched_barrier(0)
    Unit cur, nxt; int ui = 0;
    if (!S.next(0, cur)) return;
    f32x4 acc[2][2][4][2];
#pragma unroll
    for (int a = 0; a < 2; ++a)
#pragma unroll
        for (int b = 0; b < 2; ++b)
#pragma unroll
            for (int m = 0; m < 4; ++m)
#pragma unroll
                for (int n = 0; n < 2; ++n) acc[a][b][m][n] = (f32x4){0.f, 0.f, 0.f, 0.f};
    bf16x8 At[4][2], B0[2][2], B1[2][2];
    const char* cA = (const char*)g.A + (size_t)cur.pm * tstepA + (size_t)cur.koff * 2; const char* cB = (const char*)g.Bt + (size_t)cur.pn * tstepB + (size_t)cur.koff * 2;
    S.a_ready(cur);
    if constexpr (SP2) {
        PG8_STAGE(PG8_SB(0, 0), cB, voffB); PG8_STAGE(PG8_SB(0, 1), cB + hstepB, voffB); PG8_STAGE(PG8_SA(0, 0), cA, voffA); PG8_STAGE(PG8_SA(0, 1), cA + hstepA, voffA);
        if (wr == 1) PG8_BAR;
        PG8_WAIT_V(2); PG8_BAR;
        PG8_STAGE(PG8_SB(1, 0), cB + kstep, voffB); PG8_STAGE(PG8_SA(1, 0), cA + kstep, voffA); PG8_STAGE(PG8_SB(1, 1), cB + hstepB + kstep, voffB);
        PG8_WAIT_V(6); PG8_BAR;
    } else {
        PG8_STAGE(PG8_SB(0, 0), cB, voffB); PG8_STAGE(PG8_SA(0, 0), cA, voffA); PG8_STAGE(PG8_SB(0, 1), cB + hstepB, voffB); PG8_STAGE(PG8_SA(0, 1), cA + hstepA, voffA);
        if (wr == 1) PG8_BAR;
        PG8_WAIT_V(4); PG8_BAR;
        PG8_STAGE(PG8_SB(1, 0), cB + kstep, voffB); PG8_STAGE(PG8_SA(1, 0), cA + kstep, voffA); PG8_STAGE(PG8_SB(1, 1), cB + hstepB + kstep, voffB);
        PG8_WAIT_V(6); PG8_BAR;
    }
    for (;;) {
        const bool has_next = S.next(ui + 1, nxt);
        const char* nA = has_next ? (const char*)g.A + (size_t)nxt.pm * tstepA + (size_t)nxt.koff * 2 : cA; const char* nB = has_next ? (const char*)g.Bt + (size_t)nxt.pn * tstepB + (size_t)nxt.koff * 2 : cB;
        const int nt = cur.nt;
        for (int t = 0; t < nt; t += 2) {
            const bool last = (t == nt - 2);
            const char* a1 = cA + (size_t)(t + 1) * kstep;
            const char* a2 = last ? nA : cA + (size_t)(t + 2) * kstep; const char* b2 = last ? nB : cB + (size_t)(t + 2) * kstep;
            const char* a3 = a2 + kstep; const char* b3 = b2 + kstep;
            if (last && has_next) S.a_ready(nxt);
            if constexpr (SP2) {
            PG8_LDB(B0, 0, 0); PG8_LDB(B1, 0, 1); PG8_SCHED; PG8_LDA(At, 0, 0); PG8_STAGE(PG8_SA(1, 1), a1 + hstepA, voffA);
            PG8_WAIT_V(8); PG8_WAIT_L(0); PG8_BAR; PG8_MMA(0, 0, At, B0); PG8_MMA(0, 1, At, B1); PG8_BAR; PG8_SCHED;
            PG8_LDA(At, 0, 1); PG8_STAGE(PG8_SB(0, 0), b2, voffB); PG8_STAGE(PG8_SB(0, 1), b2 + hstepB, voffB); PG8_STAGE(PG8_SA(0, 0), a2, voffA);
            PG8_WAIT_V(8); PG8_WAIT_L(0); PG8_BAR; PG8_MMA(1, 0, At, B0); PG8_MMA(1, 1, At, B1); PG8_BAR; PG8_SCHED;
            PG8_LDB(B0, 1, 0); PG8_LDB(B1, 1, 1); PG8_SCHED; PG8_LDA(At, 1, 0); PG8_STAGE(PG8_SA(0, 1), a2 + hstepA, voffA);
            PG8_WAIT_V(8); PG8_WAIT_L(0); PG8_BAR; PG8_MMA(0, 0, At, B0); PG8_MMA(0, 1, At, B1); PG8_BAR; PG8_SCHED;
            PG8_LDA(At, 1, 1); PG8_STAGE(PG8_SB(1, 0), b3, voffB); PG8_STAGE(PG8_SB(1, 1), b3 + hstepB, voffB); PG8_STAGE(PG8_SA(1, 0), a3, voffA);
            PG8_WAIT_V(8); PG8_WAIT_L(0); PG8_BAR; PG8_MMA(1, 0, At, B0); PG8_MMA(1, 1, At, B1); PG8_BAR; PG8_SCHED;
            } else {
            PG8_LDB(B0, 0, 0); PG8_SCHED; PG8_LDA(At, 0, 0); PG8_STAGE(PG8_SA(1, 1), a1 + hstepA, voffA);
            PG8_WAIT_L(8); PG8_BAR; PG8_WAIT_L(0); PG8_MMA(0, 0, At, B0); PG8_BAR; PG8_SCHED;
            PG8_LDB(B1, 0, 1); PG8_STAGE(PG8_SB(0, 0), b2, voffB);
            PG8_BAR; PG8_WAIT_L(0); PG8_MMA(0, 1, At, B1); PG8_BAR;
            PG8_LDA(At, 0, 1); PG8_STAGE(PG8_SA(0, 0), a2, voffA);
            PG8_BAR; PG8_WAIT_L(0); PG8_MMA(1, 0, At, B0); PG8_BAR; PG8_SCHED;
            PG8_STAGE(PG8_SB(0, 1), b2 + hstepB, voffB);
            PG8_WAIT_V(6); PG8_BAR; PG8_MMA(1, 1, At, B1); PG8_BAR;
            PG8_LDB(B0, 1, 0); PG8_SCHED; PG8_LDA(At, 1, 0); PG8_STAGE(PG8_SA(0, 1), a2 + hstepA, voffA);
            PG8_WAIT_L(8); PG8_BAR; PG8_WAIT_L(0); PG8_MMA(0, 0, At, B0); PG8_BAR; PG8_SCHED;
            PG8_LDB(B1, 1, 1); PG8_STAGE(PG8_SB(1, 0), b3, voffB);
            PG8_BAR; PG8_WAIT_L(0); PG8_MMA(0, 1, At, B1); PG8_BAR;
            PG8_LDA(At, 1, 1); PG8_STAGE(PG8_SA(1, 0), a3, voffA);
            PG8_BAR; PG8_WAIT_L(0); PG8_MMA(1, 0, At, B0); PG8_BAR; PG8_SCHED;
            PG8_STAGE(PG8_SB(1, 1), b3 + hstepB, voffB);
            PG8_WAIT_V(6); PG8_BAR; PG8_MMA(1, 1, At, B1); PG8_BAR;
            }
        }
        if constexpr (ALIGN_EPI) { if (wr == 0) PG8_BAR; }
        if constexpr (!Epi::AFTER_DRAIN) { E(acc, cur, wr, wc, fr, fq); S.done(cur); }
        if (!has_next) break;
#pragma unroll
        for (int a = 0; a < 2; ++a)
#pragma unroll
            for (int b = 0; b < 2; ++b)
#pragma unroll
                for (int m = 0; m < 4; ++m)
#pragma unroll
                    for (int n = 0; n < 2; ++n) acc[a][b][m][n] = (f32x4){0.f, 0.f, 0.f, 0.f};
        cur = nxt; cA = nA; cB = nB; ++ui;
        if constexpr (ALIGN_EPI) { if (wr == 1) PG8_BAR; }
    }
    PG8_WAIT_V(0);
    if constexpr (!ALIGN_EPI) { if (wr == 0) PG8_BAR; }
    PG8_BAR;
    if constexpr (Epi::AFTER_DRAIN) { E.fused(acc, cur, wr, wc, fr, fq, lds, wid, lane); S.done(cur); }
#undef PG8_SA
#undef PG8_SB
#undef PG8_STAGE
#undef PG8_LDA
#undef PG8_LDB
#undef PG8_MMA
#undef PG8_WAIT_V
#undef PG8_WAIT_L
#undef PG8_BAR
#undef PG8_SCHED
}
}
#define GAS __attribute__((address_space(1)))
#define LAS __attribute__((address_space(3)))
typedef unsigned short bf16;
typedef unsigned v4u __attribute__((ext_vector_type(4)));
typedef float f32x4 __attribute__((ext_vector_type(4)));
typedef short bf16x8 __attribute__((ext_vector_type(8)));
typedef GAS unsigned gu32;
typedef GAS unsigned long long gu64;
#define RLX_AGENT __ATOMIC_RELAXED, __HIP_MEMORY_SCOPE_AGENT
#define LDS_WAIT() asm volatile("s_waitcnt lgkmcnt(0)" ::: "memory")
#define VM_WAIT() asm volatile("s_waitcnt vmcnt(0)" ::: "memory")
__device__ __forceinline__ unsigned long long rt() { return __builtin_amdgcn_s_memrealtime(); }
__device__ __forceinline__ unsigned pk2(float lo, float hi) { unsigned r; asm("v_cvt_pk_bf16_f32 %0, %1, %2" : "=v"(r) : "v"(lo), "v"(hi)); return r; }
__device__ __forceinline__ unsigned f2bf(float f) { return pk2(f, 0.f) & 0xffffu; }
#define XB_TMO      128
#define XB_XCNT(j)  (256  + 64 * (j))
#define XB_XSUB(j)  (1280 + 64 * (j))
#define XB_XGEN(j)  (2304 + 64 * (j))
#define XB_TOP      3328
#define XB_TOPGEN   3392
#define XCD_BAR_WORDS 3456
#define XB_SPIN_CAP (1u << 18)

__device__ __forceinline__ unsigned xb_ld(unsigned* p)              { return __hip_atomic_load(p, __ATOMIC_RELAXED, __HIP_MEMORY_SCOPE_AGENT); }
__device__ __forceinline__ unsigned xb_add(unsigned* p, unsigned v) { return __hip_atomic_fetch_add(p, v, __ATOMIC_RELAXED, __HIP_MEMORY_SCOPE_AGENT); }
__device__ __forceinline__ unsigned xb_xcc_id() { return (unsigned)__builtin_amdgcn_s_getreg((3 << 11) | 20) & 0xFu; }
#define XB_SPIN(cond, bar) do { unsigned _sp = 0; while (cond) { __builtin_amdgcn_s_sleep(1); \
    if ((++_sp & 255u) == 0u) { if (xb_ld(&(bar)[XB_TMO])) break; if (_sp > XB_SPIN_CAP) { atomicAdd(&(bar)[XB_TMO], 1u); break; } } } } while (0)

struct XcdBarrier {
    unsigned* bar; unsigned x;
    volatile LAS unsigned* st;
};

__device__ __forceinline__ XcdBarrier xcd_barrier_post(unsigned* bar, volatile LAS unsigned* st) {
    XcdBarrier b; b.bar = bar; b.x = xb_xcc_id(); b.st = st;
    if (threadIdx.x == 0) (void)xb_add(&bar[XB_XCNT(b.x)], 1u);
    return b;
}
__device__ __forceinline__ void xcd_barrier_complete(unsigned* bar, unsigned x, unsigned& nloc, unsigned& nx) {
    const unsigned G = gridDim.x * gridDim.y * gridDim.z;
    unsigned sum, cnt, mine, sp = 0u;
    for (;;) {
        sum = 0u; cnt = 0u; mine = 0u;
#pragma unroll
        for (unsigned j = 0; j < 16; ++j) { const unsigned c = xb_ld(&bar[XB_XCNT(j)]); sum += c; cnt += (c > 0u) ? 1u : 0u; mine = (j == x) ? c : mine; }
        if (sum == G) break;
        __builtin_amdgcn_s_sleep(1);
        if ((++sp & 255u) == 0u) { if (xb_ld(&bar[XB_TMO])) break; if (sp > XB_SPIN_CAP) { atomicAdd(&bar[XB_TMO], 1u); break; } }
    }
    nloc = mine > 0u ? mine : 1u; nx = cnt > 0u ? cnt : 1u;
}

__device__ __forceinline__ void xcd_barrier(const XcdBarrier& b) {
    asm volatile("s_waitcnt vmcnt(0)" ::: "memory");
    __syncthreads();
    if (threadIdx.x == 0) {
        unsigned* bar = b.bar;
        __builtin_amdgcn_s_waitcnt(0);
        unsigned nloc = b.st[0], nx = b.st[1];
        if (nloc == 0u) { xcd_barrier_complete(bar, b.x, nloc, nx); b.st[0] = nloc; b.st[1] = nx; }
        const unsigned old = xb_add(&bar[XB_XSUB(b.x)], 1u);
        const unsigned gen = old / nloc;
        if (old + 1u == (gen + 1u) * nloc) {
            __builtin_amdgcn_fence(__ATOMIC_RELEASE, "agent");
            asm volatile("s_waitcnt vmcnt(0)" ::: "memory");
            const unsigned og = xb_add(&bar[XB_TOP], 1u);
            const unsigned tg = og / nx;
            if (og + 1u == (tg + 1u) * nx) xb_add(&bar[XB_TOPGEN], 1u);
            else XB_SPIN(xb_ld(&bar[XB_TOPGEN]) == tg, bar);
            __builtin_amdgcn_fence(__ATOMIC_ACQUIRE, "agent");
            xb_add(&bar[XB_XGEN(b.x)], 1u);
            asm volatile("s_waitcnt vmcnt(0)" ::: "memory");
        } else {
            XB_SPIN(xb_ld(&bar[XB_XGEN(b.x)]) == gen, bar);
            __builtin_amdgcn_fence(__ATOMIC_ACQUIRE, "agent");
            asm volatile("s_waitcnt vmcnt(0)" ::: "memory");
        }
    }
    __syncthreads();
}

constexpr int NWAVES = 8;
#ifndef NST_MAX
#define NST_MAX 23
#endif
constexpr int DM = 1024, MROWS = 17408, MP = 16384, TP = 2048, NSP = 8, NSS = 128, TS = 8;
constexpr int INW = 4608, FF = 3072, FF2 = 6144, NCI = 136, MODW = 12288;
constexpr float EPSN = 1e-6f;
constexpr int TC = 128, NCH = TP / TC;

constexpr size_t MiB = 1u << 20;
constexpr size_t WS_CTL = 269 * MiB, CTL_ZERO_BYTES = 64 * 1024;
constexpr size_t WS_MOD = 1 * MiB;
constexpr size_t WS_WIN = 8 * MiB, WS_WRG = 17 * MiB, WS_WGLU = 19 * MiB, WS_WOUT = 21 * MiB, WS_WUP = 23 * MiB, WS_WDOWN = 35 * MiB;
constexpr size_t WS_SMALL = 41 * MiB;
constexpr size_t SM_WG = 0, SM_BBAR = 256 * 1024, SM_CMAT = 384 * 1024, SM_ABAR = 512 * 1024, SM_ABARTC = 528 * 1024;
constexpr size_t WS_XN = 42 * MiB;
constexpr size_t WS_XRB = 76 * MiB;
constexpr size_t WS_RX = 110 * MiB, WS_RY = 144 * MiB, WS_SX = 178 * MiB, WS_GA = 195 * MiB, WS_GB = 229 * MiB;
constexpr size_t WS_UPH = 110 * MiB, WS_HFFH = 212 * MiB;
constexpr size_t WS_HFF = 110 * MiB, WS_HALO = 212 * MiB;
constexpr size_t WS_WADA = 110 * MiB, WS_SILUC = 135 * MiB;
constexpr size_t WS_AGGRG = 263 * MiB, WS_AGGS5 = 263 * MiB;
constexpr size_t WS_PART_OUT = 229 * MiB, WS_PART_DOWN = 219 * MiB;
constexpr size_t WS_AGT = 267 * MiB;
constexpr size_t WS_END = 269 * MiB + 64 * 1024;
constexpr int CW_BAR = 4096, CW_Q = 8192;

constexpr size_t O_Y = 0, O_PRGH = 17825792, O_PRGC = 17842176, O_PS5R = 17891328, O_PS5I = 17924096, O_PFFN = 17956864,
                 O_SRGH = 18153472, O_SRGC = 18415616, O_SS5R = 19202048, O_SS5I = 19726336, O_SFFN = 20250624;

constexpr int RING_BYTES = 131072, LDSCTL_OFF = RING_BYTES, MISC_OFF = LDSCTL_OFF + 320, LDS_BYTES = 147456;
constexpr int XCH_OFF = RING_BYTES + 1024;

typedef float f32x2 __attribute__((ext_vector_type(2)));
typedef unsigned u32x2 __attribute__((ext_vector_type(2)));

struct Args { const float* in[38]; float* out; unsigned char* ws; };

struct Frame { LAS unsigned char* lds; volatile LAS unsigned* MISC; gu32* ctl; int tid, lane, wave, vcu, G; };
__device__ __forceinline__ Frame refresh(const Frame& F0) {
    Frame F = F0; int t = threadIdx.x; asm volatile("" : "+v"(t)); int bx = blockIdx.x; asm volatile("" : "+s"(bx));
    F.tid = t; F.lane = t & 63; F.wave = __builtin_amdgcn_readfirstlane(t >> 6); F.G = gridDim.x; F.vcu = (F.G % 8 == 0) ? (bx % 8) * (F.G / 8) + bx / 8 : bx; return F;
}

__device__ __forceinline__ float bf2f(unsigned short b) { return __builtin_bit_cast(float, (unsigned)b << 16); }
__device__ __forceinline__ float bflo(unsigned w) { return __builtin_bit_cast(float, w << 16); }
__device__ __forceinline__ float bfhi(unsigned w) { return __builtin_bit_cast(float, w & 0xffff0000u); }
__device__ __forceinline__ float fsig(float x) { return __builtin_amdgcn_rcpf(1.f + __builtin_amdgcn_exp2f(-1.44269504f * x)); }
__device__ __forceinline__ float fgelu(float x) { const float u = x * (1.f + 0.044715f * x * x); return x * __builtin_amdgcn_rcpf(1.f + __builtin_amdgcn_exp2f(-2.302208198f * u)); }
__device__ __forceinline__ float wave_sum(float v) {
#pragma unroll
    for (int o = 1; o < 64; o <<= 1) v += __shfl_xor(v, o);
    return v;
}
__device__ __forceinline__ int row_ci(int row) { return row < MP ? (row >> 11) : 8 + ((row - MP) >> 3); }

namespace pg8 {
enum { EM_ADA = 0, EM_IN = 1, EM_GLU = 2, EM_RGP = 3, EM_RES = 4, EM_PLAIN = 5, EM_UPF = 6 };
struct EpiAny {
    static constexpr bool AFTER_DRAIN = false;
    int mode; bool perm; unsigned char* ws; const float* p0; const float* p1; const float* p2; float* out; int row_off; int lay; PG8_LAS float* xch;
    __device__ __forceinline__ void operator()(const f32x4 (&acc)[2][2][4][2], const Unit& u, int wr, int wc, int fr, int fq) const {
        asm volatile("" : "+v"(fr), "+v"(fq), "+s"(wr), "+s"(wc));
        if (mode == EM_IN || mode == EM_PLAIN) {
            const int pn = u.pn; int ldc = 1024, ct = pn; size_t wo = WS_UPH;
            if (mode == EM_IN) { if (pn < 4) { wo = WS_RX; ct = pn; } else if (pn < 8) { wo = WS_RY; ct = pn - 4; } else if (pn < 10) { wo = WS_SX; ct = pn - 8; ldc = 512; } else if (pn < 14) { wo = WS_GA; ct = pn - 10; } else { wo = WS_GB; ct = pn - 14; } }
            else ldc = FF2;
            bf16_t* base = (bf16_t*)(ws + wo);
            const int row0 = u.pm * BM + wr * 64 + fr, col0 = ct * BM + wc * 32 + 8 * fq, bcol0 = pn * BM + wc * 32 + 8 * fq;
#pragma unroll
            for (int bj = 0; bj < 2; ++bj) {
                f32x4 b0 = {0.f, 0.f, 0.f, 0.f}, b1 = {0.f, 0.f, 0.f, 0.f};
                if (mode == EM_IN) { b0 = *(const f32x4*)(p0 + bcol0 + bj * HALF); b1 = *(const f32x4*)(p0 + bcol0 + bj * HALF + 4); }
#pragma unroll
                for (int ai = 0; ai < 2; ++ai)
#pragma unroll
                    for (int m = 0; m < 4; ++m) { bf16_t* rowp = base + (size_t)(row0 + ai * HALF + m * 16) * ldc + col0;
                        const f32x4 v0 = acc[ai][bj][m][0] + b0, v1 = acc[ai][bj][m][1] + b1;
                        u32x4 w; w.x = cvt_pk_bf16(v0[0], v0[1]); w.y = cvt_pk_bf16(v0[2], v0[3]); w.z = cvt_pk_bf16(v1[0], v1[1]); w.w = cvt_pk_bf16(v1[2], v1[3]);
                        *(u32x4*)(rowp + bj * HALF) = w; } }
        } else if (mode == EM_UPF) {
            const int pm = u.pm, pn = u.pn; const bool smp = pm >= 64; const int lane = fq * 16 + fr;
            bf16_t* HF = (bf16_t*)(ws + WS_HFF); float* HALO = (float*)(ws + WS_HALO);
            const int cb = pn * HALF + wc * 32 + 8 * fq;
            if (fr >= 14) {
#pragma unroll
                for (int ai = 0; ai < 2; ++ai)
#pragma unroll
                    for (int bj = 0; bj < 2; ++bj)
#pragma unroll
                        for (int n = 0; n < 2; ++n) *(PG8_LAS f32x4*)(xch + ((((ai * 2 + wr) * 2 + (fr - 14)) * 4 + wc) * 4 + fq) * 16 + bj * 8 + n * 4) = acc[ai][bj][3][n];
            }
            if (!smp) {
                if (wr == 1 && fr >= 14) {
#pragma unroll
                    for (int bj = 0; bj < 2; ++bj)
#pragma unroll
                        for (int n = 0; n < 2; ++n) { *(f32x4*)(HALO + ((size_t)(pm * 4 + (fr - 14)) * 2 + bj) * FF + cb + 4 * n) = acc[1][bj][3][n];
                            if ((pm & 7) == 7) *(f32x4*)(out + O_PFFN + ((size_t)((pm >> 3) * 2 + lay) * 2 + (fr - 14)) * FF2 + bj * FF + cb + 4 * n) = acc[1][bj][3][n]; }
                }
                if (wr == 0 && fr < 2) {
#pragma unroll
                    for (int bj = 0; bj < 2; ++bj)
#pragma unroll
                        for (int n = 0; n < 2; ++n) *(f32x4*)(HALO + ((size_t)(pm * 4 + 2 + fr) * 2 + bj) * FF + cb + 4 * n) = acc[0][bj][0][n];
                }
            } else if ((fr & 7) >= 6) {
#pragma unroll
                for (int ai = 0; ai < 2; ++ai)
#pragma unroll
                    for (int m = 0; m < 4; ++m) { const int sq = ((pm - 64) * BM + ai * HALF + wr * 64 + m * 16 + fr) >> 3;
#pragma unroll
                        for (int bj = 0; bj < 2; ++bj)
#pragma unroll
                            for (int n = 0; n < 2; ++n) *(f32x4*)(out + O_SFFN + ((size_t)(sq * 2 + lay) * 2 + ((fr & 7) - 6)) * FF2 + bj * FF + cb + 4 * n) = acc[ai][bj][m][n]; }
            }
            asm volatile("s_waitcnt lgkmcnt(0)" ::: "memory"); __builtin_amdgcn_s_barrier(); asm volatile("" ::: "memory");
#pragma unroll
            for (int n = 0; n < 2; ++n) {
                const int c4 = cb + 4 * n;
                f32x4 w[2][3], bb[2];
#pragma unroll
                for (int bj = 0; bj < 2; ++bj) { bb[bj] = *(const f32x4*)(p1 + bj * FF + c4);
#pragma unroll
                    for (int k = 0; k < 3; ++k) w[bj][k] = *(const f32x4*)(p0 + k * FF2 + bj * FF + c4); }
#pragma unroll
                for (int ai = 0; ai < 2; ++ai) {
                    f32x4 pg[2] = {{0.f, 0.f, 0.f, 0.f}, {0.f, 0.f, 0.f, 0.f}};
                    const int blk = ai * 2 + wr;
                    if (!smp && blk > 0 && fr >= 14) {
#pragma unroll
                        for (int bj = 0; bj < 2; ++bj) pg[bj] = *(const PG8_LAS f32x4*)(xch + (((((blk - 1) * 2 + (fr - 14)) * 4 + wc) * 4 + fq) * 16 + bj * 8 + n * 4));
                    }
#pragma unroll
                    for (int m = 0; m < 4; ++m) {
                        const int trow = ai * HALF + wr * 64 + m * 16 + fr;
                        f32x4 uc[2];
#pragma unroll
                        for (int bj = 0; bj < 2; ++bj) {
                            const f32x4 cur = acc[ai][bj][m][n]; f32x4 p1v, p2v;
#pragma unroll
                            for (int j = 0; j < 4; ++j) { const float x1 = (fr == 15) ? pg[bj][j] : cur[j], x2 = (fr >= 14) ? pg[bj][j] : cur[j];
                                p1v[j] = __builtin_bit_cast(float, __builtin_amdgcn_update_dpp(0, __builtin_bit_cast(int, x1), 0x121, 0xF, 0xF, false));
                                p2v[j] = __builtin_bit_cast(float, __builtin_amdgcn_update_dpp(0, __builtin_bit_cast(int, x2), 0x122, 0xF, 0xF, false)); }
                            if (smp) { const int t = fr & 7;
                                if (t < 2) { const int sq = ((pm - 64) * BM + trow) >> 3; const float* st = p2 + ((size_t)(sq * 2 + lay) * 2) * FF2 + bj * FF + c4;
                                    const f32x4 s1 = *(const f32x4*)(st + FF2); p2v = s1; if (t == 0) { p1v = s1; p2v = *(const f32x4*)st; } } }
                            uc[bj] = bb[bj] + w[bj][0] * p2v + w[bj][1] * p1v + w[bj][2] * cur;
                            pg[bj] = cur;
                        }
                        u32x2 o; o.x = cvt_pk_bf16(fgelu(uc[0][0]) * uc[1][0], fgelu(uc[0][1]) * uc[1][1]); o.y = cvt_pk_bf16(fgelu(uc[0][2]) * uc[1][2], fgelu(uc[0][3]) * uc[1][3]);
                        *(u32x2*)(HF + (size_t)(pm * BM + trow) * FF + c4) = o;
                    }
                }
            }
        } else if (mode == EM_GLU) {
            bf16_t* GA = (bf16_t*)(ws + WS_GA); const bf16_t* GB = (const bf16_t*)(ws + WS_GB);
            const int row0 = u.pm * BM + wr * 64 + fr, col0 = u.pn * HALF + wc * 32 + 8 * fq;
#pragma unroll
            for (int ai = 0; ai < 2; ++ai) {
                u32x4 gq[4], aq[4];
#pragma unroll
                for (int m = 0; m < 4; ++m) { const size_t off = (size_t)(row0 + ai * HALF + m * 16) * 1024 + col0; gq[m] = *(const u32x4*)(GB + off); aq[m] = *(const u32x4*)(GA + off); }
#pragma unroll
                for (int m = 0; m < 4; ++m) { const size_t off = (size_t)(row0 + ai * HALF + m * 16) * 1024 + col0;
                    const u32x4 g = gq[m], a = aq[m];
                    float gv[8] = {bflo(g.x), bfhi(g.x), bflo(g.y), bfhi(g.y), bflo(g.z), bfhi(g.z), bflo(g.w), bfhi(g.w)};
                    float av[8] = {bflo(a.x), bfhi(a.x), bflo(a.y), bfhi(a.y), bflo(a.z), bfhi(a.z), bflo(a.w), bfhi(a.w)}; float o[8];
#pragma unroll
                    for (int n = 0; n < 2; ++n)
#pragma unroll
                        for (int j = 0; j < 4; ++j) o[4 * n + j] = av[4 * n + j] + fsig(gv[4 * n + j]) * acc[ai][0][m][n][j] * fsig(acc[ai][1][m][n][j]);
                    u32x4 w; w.x = cvt_pk_bf16(o[0], o[1]); w.y = cvt_pk_bf16(o[2], o[3]); w.z = cvt_pk_bf16(o[4], o[5]); w.w = cvt_pk_bf16(o[6], o[7]);
                    *(u32x4*)(GA + off) = w; } }
        } else if (mode == EM_RGP) {
            bf16_t* GA = (bf16_t*)(ws + WS_GA);
            const int row0 = u.pm * BM + wr * 64 + fr, col0 = u.pn * BM + wc * 32 + 8 * fq;
#pragma unroll
            for (int ai = 0; ai < 2; ++ai) {
                u32x4 gq[4][2];
#pragma unroll
                for (int m = 0; m < 4; ++m)
#pragma unroll
                    for (int bj = 0; bj < 2; ++bj) gq[m][bj] = *(const u32x4*)(GA + (size_t)(row0 + ai * HALF + m * 16) * 1024 + col0 + bj * HALF);
#pragma unroll
                for (int m = 0; m < 4; ++m)
#pragma unroll
                    for (int bj = 0; bj < 2; ++bj) { const size_t off = (size_t)(row0 + ai * HALF + m * 16) * 1024 + col0 + bj * HALF;
                        const u32x4 g = gq[m][bj];
                        float gv[8] = {bflo(g.x), bfhi(g.x), bflo(g.y), bfhi(g.y), bflo(g.z), bfhi(g.z), bflo(g.w), bfhi(g.w)}; float o[8];
#pragma unroll
                        for (int n = 0; n < 2; ++n)
#pragma unroll
                            for (int j = 0; j < 4; ++j) o[4 * n + j] = fsig(gv[4 * n + j]) * acc[ai][bj][m][n][j];
                        u32x4 w; w.x = cvt_pk_bf16(o[0], o[1]); w.y = cvt_pk_bf16(o[2], o[3]); w.z = cvt_pk_bf16(o[4], o[5]); w.w = cvt_pk_bf16(o[6], o[7]);
                        *(u32x4*)(GA + off) = w; } }
        } else if (mode == EM_RES) {
            bf16_t* XB = (bf16_t*)(ws + WS_XRB);
            const int col0 = u.pn * BM + wc * 32 + 8 * fq;
            if (u.mini) {
#pragma unroll
                for (int ai = 0; ai < 2; ++ai)
#pragma unroll
                    for (int m = 0; m < 4; ++m) { const int r = u.pm * BM + ai * HALF + wr * 64 + m * 16 + fr;
#pragma unroll
                        for (int bj = 0; bj < 2; ++bj) { float* P = (float*)(ws + (row_off ? WS_PART_DOWN : WS_PART_OUT)) + ((size_t)(u.koff / u.ksl) * (MROWS - MP) + (r - MP)) * DM + col0 + bj * HALF;
                            *(f32x4*)P = acc[ai][bj][m][0]; *(f32x4*)(P + 4) = acc[ai][bj][m][1]; } }
            } else {
                const float* gt = p2 + (size_t)(u.pm >> 3) * MODW;
                f32x4 gq[2][2];
#pragma unroll
                for (int bj = 0; bj < 2; ++bj) { gq[bj][0] = *(const f32x4*)(gt + col0 + bj * HALF); gq[bj][1] = *(const f32x4*)(gt + col0 + bj * HALF + 4); }
#pragma unroll
                for (int ai = 0; ai < 2; ++ai) {
                    f32x4 sq[4][2][2];
#pragma unroll
                    for (int m = 0; m < 4; ++m)
#pragma unroll
                        for (int bj = 0; bj < 2; ++bj) { const size_t off = (size_t)(u.pm * BM + ai * HALF + wr * 64 + m * 16 + fr) * DM + col0 + bj * HALF;
                            if (p0) { sq[m][bj][0] = *(const f32x4*)(p0 + off); sq[m][bj][1] = *(const f32x4*)(p0 + off + 4); }
                            else { const u32x4 b = *(const u32x4*)(XB + off); sq[m][bj][0] = (f32x4){bflo(b.x), bfhi(b.x), bflo(b.y), bfhi(b.y)}; sq[m][bj][1] = (f32x4){bflo(b.z), bfhi(b.z), bflo(b.w), bfhi(b.w)}; } }
#pragma unroll
                    for (int m = 0; m < 4; ++m)
#pragma unroll
                        for (int bj = 0; bj < 2; ++bj) { const size_t off = (size_t)(u.pm * BM + ai * HALF + wr * 64 + m * 16 + fr) * DM + col0 + bj * HALF;
                            const f32x4 o0 = sq[m][bj][0] + gq[bj][0] * acc[ai][bj][m][0], o1 = sq[m][bj][1] + gq[bj][1] * acc[ai][bj][m][1];
                            u32x4 w; w.x = cvt_pk_bf16(o0[0], o0[1]); w.y = cvt_pk_bf16(o0[2], o0[3]); w.z = cvt_pk_bf16(o1[0], o1[1]); w.w = cvt_pk_bf16(o1[2], o1[3]);
                            *(u32x4*)(XB + off) = w; } }
            }
        } else {
            const int col0 = u.pn * BM + wc * 32 + 4 * fq;
#pragma unroll
            for (int ai = 0; ai < 2; ++ai)
#pragma unroll
                for (int m = 0; m < 4; ++m) { const int r = ai * HALF + wr * 64 + m * 16 + fr;
                    if (r < NCI) {
#pragma unroll
                        for (int bj = 0; bj < 2; ++bj)
#pragma unroll
                            for (int n = 0; n < 2; ++n) { const int c = col0 + bj * HALF + n * 16; *(f32x4*)(out + (size_t)r * MODW + c) = acc[ai][bj][m][n] + *(const f32x4*)(p0 + c); } } }
        }
    }
};
}

template <int MAP> __device__ __forceinline__ int wt_row(int n) {
    if (MAP == 1) { return n < 1024 ? ((n >> 7) << 8) + (n & 127) : (((n - 1024) >> 7) << 8) + 128 + (n & 127); }
    if (MAP == 2) { return n < 3072 ? ((n >> 7) << 8) + (n & 127) : (((n - 3072) >> 7) << 8) + 128 + (n & 127); }
    return n;
}
template <int MAP> __device__ __forceinline__ void p0_transpose_item(const float* W, int K, int N, bf16* WT, int row_off, LAS float* scr, int item, int lane, int npair) {
    const int nblk = N / 32;
    f32x4 v[2][8];
#pragma unroll
    for (int p = 0; p < 2; ++p) if (p < npair) { const int kb = (item + p) / nblk, nb = (item + p) % nblk, k0 = 64 * kb, n0 = 32 * nb;
#pragma unroll
        for (int i = 0; i < 8; ++i) v[p][i] = __builtin_nontemporal_load((const f32x4*)(W + (size_t)(k0 + 8 * i + (lane >> 3)) * N + n0 + 4 * (lane & 7))); }
#pragma unroll
    for (int p = 0; p < 2; ++p) if (p < npair) { const int kb = (item + p) / nblk, nb = (item + p) % nblk, k0 = 64 * kb, n0 = 32 * nb;
#pragma unroll
        for (int i = 0; i < 8; ++i) { LAS float* d = scr + (8 * i + (lane >> 3)) * 33 + 4 * (lane & 7); d[0] = v[p][i].x; d[1] = v[p][i].y; d[2] = v[p][i].z; d[3] = v[p][i].w; }
        LDS_WAIT(); asm volatile("" ::: "memory");
        const int c = lane & 7;
#pragma unroll
        for (int j = 0; j < 4; ++j) { const int n = (lane >> 3) + 8 * j; const LAS float* s = scr + (8 * c) * 33 + n;
            v4u o; o.x = pk2(s[0 * 33], s[1 * 33]); o.y = pk2(s[2 * 33], s[3 * 33]); o.z = pk2(s[4 * 33], s[5 * 33]); o.w = pk2(s[6 * 33], s[7 * 33]);
            *(GAS v4u*)(WT + (size_t)(row_off + wt_row<MAP>(n0 + n)) * K + k0 + 8 * c) = o; }
        LDS_WAIT(); asm volatile("" ::: "memory"); }
}

__device__ __forceinline__ void p0_weights(const Frame& F0, const Args& A, int l, int part, int b0, int nb) {
    const Frame F = refresh(F0);
    unsigned char* ws = A.ws;
    LAS float* scr = (LAS float*)(F.lds + F.wave * 16384);
    int bx = blockIdx.x; asm volatile("" : "+s"(bx));
    if (bx < b0) return;
    const bool first = part == 0;
    const int gw = (bx - b0) * NWAVES + F.wave, NGW = nb * NWAVES;
    constexpr int I_IN = (DM / 64) * (INW / 32), I_SQ = (DM / 64) * (DM / 32), I_GLU = (512 / 64) * (2048 / 32), I_UP = (DM / 64) * (FF2 / 32), I_DN = (FF / 64) * (DM / 32), I_ADA = (DM / 64) * (FF2 / 32);
    constexpr int NLAYER = I_IN + 2 * I_SQ + I_GLU + I_UP + I_DN;
    const int nitems = first ? 2 * I_ADA : NLAYER;
    const int per_ = (nitems + NGW - 1) / NGW, it_hi = (gw + 1) * per_ < nitems ? (gw + 1) * per_ : nitems;
    for (int it = gw * per_; it < it_hi; it += 2) {
        int r = first ? it + NLAYER : it; const bool more = it + 1 < it_hi;
        if (r < I_IN) { p0_transpose_item<0>(A.in[13] + (size_t)l * DM * INW, DM, INW, (bf16*)(ws + WS_WIN), 0, scr, r, F.lane, (more && r + 1 < I_IN) ? 2 : 1); if (more && !(r + 1 < I_IN)) --it; continue; } r -= I_IN;
        if (r < I_SQ) { p0_transpose_item<0>(A.in[30] + (size_t)l * DM * DM, DM, DM, (bf16*)(ws + WS_WRG), 0, scr, r, F.lane, (more && r + 1 < I_SQ) ? 2 : 1); if (more && !(r + 1 < I_SQ)) --it; continue; } r -= I_SQ;
        if (r < I_SQ) { p0_transpose_item<0>(A.in[32] + (size_t)l * DM * DM, DM, DM, (bf16*)(ws + WS_WOUT), 0, scr, r, F.lane, (more && r + 1 < I_SQ) ? 2 : 1); if (more && !(r + 1 < I_SQ)) --it; continue; } r -= I_SQ;
        if (r < I_GLU) { p0_transpose_item<1>(A.in[31] + (size_t)l * 512 * 2048, 512, 2048, (bf16*)(ws + WS_WGLU), 0, scr, r, F.lane, (more && r + 1 < I_GLU) ? 2 : 1); if (more && !(r + 1 < I_GLU)) --it; continue; } r -= I_GLU;
        if (r < I_UP) { p0_transpose_item<2>(A.in[33] + (size_t)l * DM * FF2, DM, FF2, (bf16*)(ws + WS_WUP), 0, scr, r, F.lane, (more && r + 1 < I_UP) ? 2 : 1); if (more && !(r + 1 < I_UP)) --it; continue; } r -= I_UP;
        if (r < I_DN) { p0_transpose_item<0>(A.in[36] + (size_t)l * FF * DM, FF, DM, (bf16*)(ws + WS_WDOWN), 0, scr, r, F.lane, (more && r + 1 < I_DN) ? 2 : 1); if (more && !(r + 1 < I_DN)) --it; continue; } r -= I_DN;
        if (r < I_ADA) { p0_transpose_item<0>(A.in[9], DM, FF2, (bf16*)(ws + WS_WADA), 0, scr, r, F.lane, (more && r + 1 < I_ADA) ? 2 : 1); if (more && !(r + 1 < I_ADA)) --it; continue; } r -= I_ADA;
        p0_transpose_item<0>(A.in[9] + (size_t)DM * FF2, DM, FF2, (bf16*)(ws + WS_WADA), FF2, scr, r, F.lane, (more && r + 1 < I_ADA) ? 2 : 1); if (more && !(r + 1 < I_ADA)) --it;
    }
    const int gt = (bx - b0) * (NWAVES * 64) + F.tid, NGT = nb * NWAVES * 64;
    if (!first) {
    bf16* WG = (bf16*)(ws + WS_SMALL + SM_WG);
    for (int e = gt; e < 2 * 16 * 4096; e += NGT) { const int gate = e >> 16, rem = e & 65535, h = rem >> 12, j = (rem >> 6) & 63, i = rem & 63;
        const float* src = (gate ? A.in[19] : A.in[17]) + (size_t)l * 65536 + h * 4096 + i * 64 + j;
        WG[((h * 2 + gate) * 64 + j) * 64 + i] = (bf16)f2bf(*src); }
    for (int e = gt; e < 2048; e += NGT) { const int g = e >> 6, p = e & 63;
        const float dt = expf(A.in[29][l * 32 + g]);
        const float lr = A.in[22][l * 2048 + e], li = A.in[23][l * 2048 + e];
        const float mag = expf(lr * dt); float sn, cs; sincosf(li * dt, &sn, &cs);
        const float ar = mag * cs, ai = mag * sn, den = lr * lr + li * li;
        const float zr = ((ar - 1.f) * lr + ai * li) / den, zi = (ai * lr - (ar - 1.f) * li) / den;
        float* AB = (float*)(ws + WS_SMALL + SM_ABAR); AB[e * 2] = ar; AB[e * 2 + 1] = ai;
        float pr = ar, pi = ai;
#pragma unroll 1
        for (int s = 0; s < 7; ++s) { const float nr = pr * pr - pi * pi, ni = 2.f * pr * pi; pr = nr; pi = ni; }
        float* ABT = (float*)(ws + WS_SMALL + SM_ABARTC); ABT[e * 2] = pr; ABT[e * 2 + 1] = pi;
        bf16* BB = (bf16*)(ws + WS_SMALL + SM_BBAR) + (size_t)g * 128 * 16;
        const float* bre = A.in[24] + ((size_t)l * 2048 + e) * 16; const float* bim = A.in[25] + ((size_t)l * 2048 + e) * 16;
#pragma unroll 4
        for (int c = 0; c < 16; ++c) { const float br = bre[c], bi = bim[c]; BB[p * 16 + c] = (bf16)f2bf(zr * br - zi * bi); BB[(64 + p) * 16 + c] = (bf16)f2bf(zr * bi + zi * br); }
        bf16* CM = (bf16*)(ws + WS_SMALL + SM_CMAT) + (size_t)g * 16 * 128;
        const float* cre = A.in[26] + ((size_t)l * 32 + g) * 1024; const float* cim = A.in[27] + ((size_t)l * 32 + g) * 1024;
#pragma unroll 4
        for (int c = 0; c < 16; ++c) { CM[c * 128 + p] = (bf16)f2bf(cre[c * 64 + p]); CM[c * 128 + 64 + p] = (bf16)f2bf(-cim[c * 64 + p]); }
    }
    }
    if (first) {
        bf16* XRs = (bf16*)(ws + WS_XRB) + (size_t)MP * DM;
        for (int e = gt; e < (MROWS - MP) * DM / 4; e += NGT) { const f32x4 v = ((const f32x4*)A.in[1])[e]; ((unsigned long long*)XRs)[e] = (unsigned long long)pk2(v.x, v.y) | ((unsigned long long)pk2(v.z, v.w) << 32); }
    }
    if (first) {
        bf16* SC = (bf16*)(ws + WS_SILUC);
        for (int e = gt; e < 256 * DM; e += NGT) { const int r = e >> 10, c = e & 1023; float v = 0.f;
            if (r < NSP) v = A.in[7][r * DM + c]; else if (r < NCI) v = A.in[8][(r - NSP) * DM + c];
            SC[e] = (bf16)f2bf(v * fsig(v)); }
    }
}

__device__ __forceinline__ void cvt8(const v4u w, float (&o)[8]) { o[0] = bflo(w.x); o[1] = bfhi(w.x); o[2] = bflo(w.y); o[3] = bfhi(w.y); o[4] = bflo(w.z); o[5] = bfhi(w.z); o[6] = bflo(w.w); o[7] = bfhi(w.w); }
__device__ __forceinline__ f32x4 ld_row4(const float* xf, const bf16* xb, size_t row, int idx) {
    if (xf) return __builtin_nontemporal_load((const GAS f32x4*)(xf + row * DM) + idx);
    const u32x2 b = ((const GAS u32x2*)(xb + row * DM))[idx]; return (f32x4){bflo(b.x), bfhi(b.x), bflo(b.y), bfhi(b.y)};
}
__device__ __forceinline__ void norm_rows(const Frame& F0, const float* xp, const float* xs_adj, bf16* XRB, const float* g, const float* mod_sh, const float* mod_sc, bf16* XN, int npart, const float* pgate, const float* PART) {
    const Frame F = refresh(F0);
    const int gw = F.vcu * NWAVES + F.wave, NGW = F.G * NWAVES;
    if (!xp) {
        for (int m0 = 8 * gw; m0 < MP; m0 += 8 * NGW) {
            const int ci = m0 >> 11;
            v4u w[8][2]; float sr[8];
#pragma unroll
            for (int r = 0; r < 8; ++r)
#pragma unroll
                for (int j = 0; j < 2; ++j) w[r][j] = ((const GAS v4u*)(XRB + (size_t)(m0 + r) * DM))[64 * j + F.lane];
#pragma unroll
            for (int r = 0; r < 8; ++r) { float q = 0.f;
#pragma unroll
                for (int j = 0; j < 2; ++j) { float v[8]; cvt8(w[r][j], v);
#pragma unroll
                    for (int e = 0; e < 8; ++e) q += v[e] * v[e]; }
                sr[r] = __builtin_amdgcn_rsqf(wave_sum(q) * (1.f / DM) + EPSN); }
#pragma unroll
            for (int j = 0; j < 2; ++j) { const int c = 512 * j + 8 * F.lane; float gs[8], sh[8];
#pragma unroll
                for (int h2 = 0; h2 < 2; ++h2) { const f32x4 gg = *(const f32x4*)(g + c + 4 * h2), s4 = *(const f32x4*)(mod_sh + (size_t)ci * MODW + c + 4 * h2), c4 = *(const f32x4*)(mod_sc + (size_t)ci * MODW + c + 4 * h2);
#pragma unroll
                    for (int e = 0; e < 4; ++e) { gs[4 * h2 + e] = gg[e] * (c4[e] + 1.f); sh[4 * h2 + e] = s4[e]; } }
#pragma unroll
                for (int r = 0; r < 8; ++r) { float v[8]; cvt8(w[r][j], v); v4u o;
                    o.x = pk2(v[0] * sr[r] * gs[0] + sh[0], v[1] * sr[r] * gs[1] + sh[1]); o.y = pk2(v[2] * sr[r] * gs[2] + sh[2], v[3] * sr[r] * gs[3] + sh[3]);
                    o.z = pk2(v[4] * sr[r] * gs[4] + sh[4], v[5] * sr[r] * gs[5] + sh[5]); o.w = pk2(v[6] * sr[r] * gs[6] + sh[6], v[7] * sr[r] * gs[7] + sh[7]);
                    ((GAS v4u*)(XN + (size_t)(m0 + r) * DM))[64 * j + F.lane] = o; } }
        }
    } else
    for (int m0 = 4 * gw; m0 < MP; m0 += 4 * NGW) {
        const int ci = m0 >> 11;
        f32x4 v[4][4]; float s[4];
#pragma unroll
        for (int r = 0; r < 4; ++r)
#pragma unroll
            for (int j = 0; j < 4; ++j) v[r][j] = ld_row4(xp, XRB, (size_t)(m0 + r), 64 * j + F.lane);
#pragma unroll
        for (int r = 0; r < 4; ++r) { float q = 0.f;
#pragma unroll
            for (int j = 0; j < 4; ++j) q += (v[r][j].x * v[r][j].x + v[r][j].y * v[r][j].y) + (v[r][j].z * v[r][j].z + v[r][j].w * v[r][j].w);
            s[r] = 1.f / sqrtf(wave_sum(q) * (1.f / DM) + EPSN); }
#pragma unroll
        for (int j = 0; j < 4; ++j) { const int c = 256 * j + 4 * F.lane;
            const f32x4 gg = *(const f32x4*)(g + c), sh = *(const f32x4*)(mod_sh + (size_t)ci * MODW + c), sc = *(const f32x4*)(mod_sc + (size_t)ci * MODW + c);
            const f32x4 gs = gg * (sc + 1.f);
#pragma unroll
            for (int r = 0; r < 4; ++r) { const f32x4 y = v[r][j] * s[r] * gs + sh;
                ((GAS unsigned long long*)(XN + (size_t)(m0 + r) * DM))[64 * j + F.lane] = (unsigned long long)pk2(y.x, y.y) | ((unsigned long long)pk2(y.z, y.w) << 32); } }
    }
    for (int m = MP + F.wave * F.G + F.vcu; m < MROWS; m += NGW) {
        const int ci = row_ci(m);
        f32x4 v[4]; float q = 0.f;
#pragma unroll
        for (int j = 0; j < 4; ++j) { v[j] = ld_row4(xs_adj, XRB, (size_t)m, 64 * j + F.lane);
            if (npart > 0) {
                f32x4 ps = {0.f, 0.f, 0.f, 0.f};
#pragma unroll
                for (int k = 0; k < 12; ++k) if (k < npart) ps += *(const f32x4*)(PART + ((size_t)k * (MROWS - MP) + (m - MP)) * DM + 256 * j + 4 * F.lane);
                v[j] += *(const f32x4*)(pgate + (size_t)ci * MODW + 256 * j + 4 * F.lane) * ps;
                ((GAS unsigned long long*)(XRB + (size_t)m * DM))[64 * j + F.lane] = (unsigned long long)pk2(v[j].x, v[j].y) | ((unsigned long long)pk2(v[j].z, v[j].w) << 32);
            }
            q += (v[j].x * v[j].x + v[j].y * v[j].y) + (v[j].z * v[j].z + v[j].w * v[j].w); }
        const float rstd = 1.f / sqrtf(wave_sum(q) * (1.f / DM) + EPSN);
#pragma unroll
        for (int j = 0; j < 4; ++j) { const int c = 256 * j + 4 * F.lane;
            const f32x4 gg = *(const f32x4*)(g + c), sh = *(const f32x4*)(mod_sh + (size_t)ci * MODW + c), sc = *(const f32x4*)(mod_sc + (size_t)ci * MODW + c);
            const f32x4 y = v[j] * rstd * gg * (sc + 1.f) + sh;
            ((GAS unsigned long long*)(XN + (size_t)m * DM))[64 * j + F.lane] = (unsigned long long)pk2(y.x, y.y) | ((unsigned long long)pk2(y.z, y.w) << 32); }
    }
}
__device__ __forceinline__ void final_norm(const Frame& F0, const bf16* XRB, float* y, const float* g, int npart, const float* pgate, const float* PART) {
    const Frame F = refresh(F0);
    const int gw = F.vcu * NWAVES + F.wave, NGW = F.G * NWAVES;
    for (int m0 = 8 * gw; m0 < MP; m0 += 8 * NGW) {
        v4u w[8][2]; float sr[8];
#pragma unroll
        for (int r = 0; r < 8; ++r)
#pragma unroll
            for (int j = 0; j < 2; ++j) w[r][j] = ((const GAS v4u*)(XRB + (size_t)(m0 + r) * DM))[64 * j + F.lane];
#pragma unroll
        for (int r = 0; r < 8; ++r) { float q = 0.f;
#pragma unroll
            for (int j = 0; j < 2; ++j) { float v[8]; cvt8(w[r][j], v);
#pragma unroll
                for (int e = 0; e < 8; ++e) q += v[e] * v[e]; }
            sr[r] = __builtin_amdgcn_rsqf(wave_sum(q) * (1.f / DM) + EPSN); }
#pragma unroll
        for (int j = 0; j < 2; ++j) { const int c = 512 * j + 8 * F.lane; const f32x4 g0 = *(const f32x4*)(g + c), g1 = *(const f32x4*)(g + c + 4);
#pragma unroll
            for (int r = 0; r < 8; ++r) { float v[8]; cvt8(w[r][j], v); float* yp = y + (size_t)(m0 + r) * DM + c;
                *(f32x4*)yp = (f32x4){v[0], v[1], v[2], v[3]} * sr[r] * g0; *(f32x4*)(yp + 4) = (f32x4){v[4], v[5], v[6], v[7]} * sr[r] * g1; } }
    }
    for (int m = MP + F.wave * F.G + F.vcu; m < MROWS; m += NGW) {
        const int ci = row_ci(m);
        f32x4 v[4]; float q = 0.f;
#pragma unroll
        for (int j = 0; j < 4; ++j) { v[j] = ld_row4(nullptr, XRB, (size_t)m, 64 * j + F.lane);
            f32x4 ps = {0.f, 0.f, 0.f, 0.f};
#pragma unroll
            for (int k = 0; k < 12; ++k) if (k < npart) ps += *(const f32x4*)(PART + ((size_t)k * (MROWS - MP) + (m - MP)) * DM + 256 * j + 4 * F.lane);
            v[j] += *(const f32x4*)(pgate + (size_t)ci * MODW + 256 * j + 4 * F.lane) * ps;
            q += (v[j].x * v[j].x + v[j].y * v[j].y) + (v[j].z * v[j].z + v[j].w * v[j].w); }
        const float rstd = 1.f / sqrtf(wave_sum(q) * (1.f / DM) + EPSN);
#pragma unroll
        for (int j = 0; j < 4; ++j) { const f32x4 gg = *(const f32x4*)(g + 256 * j + 4 * F.lane); ((GAS f32x4*)(y + (size_t)m * DM))[64 * j + F.lane] = v[j] * rstd * gg; }
    }
}


template <int MODE> __device__ __forceinline__ void rg_unit(const Frame& F, const Args& A, int l, bool sample, int s, int c, int h) {
    unsigned char* ws = A.ws;
    LAS float* TAB = (LAS float*)(F.lds + F.wave * 15360);
    LAS float* XC = TAB + 512;
    LAS float* AA = XC + 16 * 68;
    LAS float* BB = AA + 16 * 68;
    const int lane = F.lane, fr = lane & 15, fq = lane >> 4, ch0 = 64 * h;
    const bf16* RX = (const bf16*)(ws + WS_RX); bf16* RY = (bf16*)(ws + WS_RY);
    {
        const int chg = l * DM + ch0 + lane;
#pragma unroll
        for (int j = 0; j < 4; ++j) TAB[j * 64 + lane] = A.in[15][(size_t)(l * 4 + j) * DM + ch0 + lane];
        TAB[4 * 64 + lane] = A.in[16][chg]; TAB[5 * 64 + lane] = A.in[18][chg]; TAB[6 * 64 + lane] = A.in[20][chg];
        const float lam = A.in[21][chg]; TAB[7 * 64 + lane] = -8.f * 1.44269504f * log1pf(expf(-lam));
    }
    bf16x8 Wf[2][4][2];
    { const bf16* WG = (const bf16*)(ws + WS_SMALL + SM_WG);
#pragma unroll
      for (int g = 0; g < 2; ++g)
#pragma unroll
        for (int n = 0; n < 4; ++n)
#pragma unroll
            for (int k = 0; k < 2; ++k) Wf[g][n][k] = *(const bf16x8*)(WG + ((h * 2 + g) * 64 + 16 * n + fr) * 64 + 32 * k + 8 * fq); }
    LDS_WAIT(); asm volatile("" ::: "memory");
    const int rbase = sample ? MP + s * 32 : s * TP + c * TC;
    float hst = 0.f, aprod = 1.f;
    if (MODE == 1 && !sample) {
        const float* AG = (const float*)(ws + WS_AGGRG) + ((size_t)(s * NCH) * DM + ch0 + lane) * 2;
        for (int cc = 0; cc < c; ++cc) { const float a = AG[(size_t)cc * DM * 2], b = AG[(size_t)cc * DM * 2 + 1]; hst = a * hst + b; }
    }
    const int ntile = sample ? 2 : 8;
#pragma unroll 1
    for (int tile = 0; tile < ntile; ++tile) {
        const int row = rbase + 16 * tile + fr;
        const int t = sample ? (fr & 7) : c * TC + 16 * tile + fr;
        const int sq = sample ? s * 4 + tile * 2 + (fr >> 3) : s;
        bf16x8 X[2];
#pragma unroll
        for (int k = 0; k < 2; ++k) {
            const int cl = 32 * k + 8 * fq; float xc[8];
            { const f32x4 b0 = *(const LAS f32x4*)(TAB + 4 * 64 + cl), b1 = *(const LAS f32x4*)(TAB + 4 * 64 + cl + 4); xc[0] = b0.x; xc[1] = b0.y; xc[2] = b0.z; xc[3] = b0.w; xc[4] = b1.x; xc[5] = b1.y; xc[6] = b1.z; xc[7] = b1.w; }
#pragma unroll
            for (int d = 0; d < 4; ++d) {
                float v[8];
                if (t - d >= 0) { cvt8(*(const v4u*)(RX + (size_t)(row - d) * DM + ch0 + cl), v); }
                else if (sample) { const float* st = A.in[3] + ((size_t)(sq * 2 + l) * 3 + (3 + t - d)) * DM + ch0 + cl; const f32x4 a0 = *(const f32x4*)st, a1 = *(const f32x4*)(st + 4);
                    v[0] = a0.x; v[1] = a0.y; v[2] = a0.z; v[3] = a0.w; v[4] = a1.x; v[5] = a1.y; v[6] = a1.z; v[7] = a1.w; }
                else {
#pragma unroll
                    for (int q = 0; q < 8; ++q) v[q] = 0.f; }
                const f32x4 w0 = *(const LAS f32x4*)(TAB + (3 - d) * 64 + cl), w1 = *(const LAS f32x4*)(TAB + (3 - d) * 64 + cl + 4);
                xc[0] += w0.x * v[0]; xc[1] += w0.y * v[1]; xc[2] += w0.z * v[2]; xc[3] += w0.w * v[3]; xc[4] += w1.x * v[4]; xc[5] += w1.y * v[5]; xc[6] += w1.z * v[6]; xc[7] += w1.w * v[7];
            }
            *(LAS f32x4*)(XC + fr * 68 + cl) = (f32x4){xc[0], xc[1], xc[2], xc[3]}; *(LAS f32x4*)(XC + fr * 68 + cl + 4) = (f32x4){xc[4], xc[5], xc[6], xc[7]};
            v4u pk; pk.x = pk2(xc[0], xc[1]); pk.y = pk2(xc[2], xc[3]); pk.z = pk2(xc[4], xc[5]); pk.w = pk2(xc[6], xc[7]);
            X[k] = __builtin_bit_cast(bf16x8, pk);
        }
        f32x4 acc[2][4];
#pragma unroll
        for (int g = 0; g < 2; ++g)
#pragma unroll
            for (int n = 0; n < 4; ++n) { acc[g][n] = (f32x4){0.f, 0.f, 0.f, 0.f};
#pragma unroll
                for (int k = 0; k < 2; ++k) acc[g][n] = __builtin_amdgcn_mfma_f32_16x16x32_bf16(Wf[g][n][k], X[k], acc[g][n], 0, 0, 0); }
        LDS_WAIT(); asm volatile("" ::: "memory");
#pragma unroll
        for (int n = 0; n < 4; ++n) { const int cl = 16 * n + 4 * fq;
            const f32x4 xv = *(const LAS f32x4*)(XC + fr * 68 + cl), ba = *(const LAS f32x4*)(TAB + 5 * 64 + cl), bx = *(const LAS f32x4*)(TAB + 6 * 64 + cl), c8 = *(const LAS f32x4*)(TAB + 7 * 64 + cl);
            f32x4 av, bv;
#pragma unroll
            for (int j = 0; j < 4; ++j) { const float r = fsig(acc[0][n][j] + ba[j]), ig = fsig(acc[1][n][j] + bx[j]); const float a = __builtin_amdgcn_exp2f(r * c8[j]);
                av[j] = a; bv[j] = __builtin_amdgcn_sqrtf(fmaxf(1.f - a * a, 0.f)) * ig * xv[j]; }
            *(LAS f32x4*)(AA + fr * 68 + cl) = av; *(LAS f32x4*)(BB + fr * 68 + cl) = bv; }
        LDS_WAIT(); asm volatile("" ::: "memory");
#pragma unroll
        for (int tt = 0; tt < 16; ++tt) {
            if (sample && (tt & 7) == 0) hst = A.in[2][(size_t)((s * 4 + tile * 2 + (tt >> 3)) * 2 + l) * DM + ch0 + lane];
            const float a = AA[tt * 68 + lane], b = BB[tt * 68 + lane];
            hst = a * hst + b; if (MODE == 0) aprod *= a;
            if (MODE == 1) BB[tt * 68 + lane] = hst;
            if (MODE == 1 && sample && (tt & 7) == 7) A.out[O_SRGH + (size_t)((s * 4 + tile * 2 + (tt >> 3)) * 2 + l) * DM + ch0 + lane] = hst;
        }
        if (MODE == 1) {
            LDS_WAIT(); asm volatile("" ::: "memory");
#pragma unroll
            for (int n = 0; n < 4; ++n) { const int cl = 16 * n + 4 * fq; const f32x4 hv = *(const LAS f32x4*)(BB + fr * 68 + cl);
                bf16* p = RY + (size_t)row * DM + ch0 + cl; const u32x2 ry = *(const u32x2*)p;
                u32x2 o; o.x = pk2(hv.x * fgelu(bflo(ry.x)), hv.y * fgelu(bfhi(ry.x))); o.y = pk2(hv.z * fgelu(bflo(ry.y)), hv.w * fgelu(bfhi(ry.y)));
                *(u32x2*)p = o; }
            LDS_WAIT(); asm volatile("" ::: "memory");
        }
    }
    if (MODE == 0) { float* AG = (float*)(ws + WS_AGGRG) + ((size_t)(s * NCH + c) * DM + ch0 + lane) * 2; AG[0] = aprod; AG[1] = hst; }
    if (MODE == 1) {
        if (!sample && c == NCH - 1) {
            A.out[O_PRGH + (size_t)(s * 2 + l) * DM + ch0 + lane] = hst;
#pragma unroll
            for (int k = 0; k < 3; ++k) A.out[O_PRGC + (size_t)((s * 2 + l) * 3 + k) * DM + ch0 + lane] = bf2f(RX[(size_t)(s * TP + TP - 3 + k) * DM + ch0 + lane]);
        }
        if (sample) {
#pragma unroll 1
            for (int q = 0; q < 4; ++q) { const int n = s * 4 + q;
#pragma unroll
                for (int k = 0; k < 3; ++k) A.out[O_SRGC + (size_t)((n * 2 + l) * 3 + k) * DM + ch0 + lane] = bf2f(RX[(size_t)(MP + n * TS + 5 + k) * DM + ch0 + lane]); }
        }
    }
}

__device__ __forceinline__ void rg_unit_sp(const Frame& F, const Args& A, int l, int s, int c, int h) {
    constexpr int MODE = 0; constexpr bool sample = false;
    unsigned char* ws = A.ws;
    LAS float* TAB = (LAS float*)(F.lds + F.wave * 15360);
    LAS float* XC = TAB + 512;
    LAS float* AA = XC + 16 * 68;
    LAS float* BB = AA + 16 * 68;
    const int lane = F.lane, fr = lane & 15, fq = lane >> 4, ch0 = 64 * h;
    const bf16* RX = (const bf16*)(ws + WS_RX); bf16* RY = (bf16*)(ws + WS_RY);
    {
        const int chg = l * DM + ch0 + lane;
#pragma unroll
        for (int j = 0; j < 4; ++j) TAB[j * 64 + lane] = A.in[15][(size_t)(l * 4 + j) * DM + ch0 + lane];
        TAB[4 * 64 + lane] = A.in[16][chg]; TAB[5 * 64 + lane] = A.in[18][chg]; TAB[6 * 64 + lane] = A.in[20][chg];
        const float lam = A.in[21][chg]; TAB[7 * 64 + lane] = -8.f * 1.44269504f * log1pf(expf(-lam));
    }
    bf16x8 Wf[2][4][2];
    { const bf16* WG = (const bf16*)(ws + WS_SMALL + SM_WG);
#pragma unroll
      for (int g = 0; g < 2; ++g)
#pragma unroll
        for (int n = 0; n < 4; ++n)
#pragma unroll
            for (int k = 0; k < 2; ++k) Wf[g][n][k] = *(const bf16x8*)(WG + ((h * 2 + g) * 64 + 16 * n + fr) * 64 + 32 * k + 8 * fq); }
    LDS_WAIT(); asm volatile("" ::: "memory");
    const int rbase = s * TP + c * TC;
    bf16* XQ = (bf16*)(ws + WS_XN);
    float hst = 0.f, aprod = 1.f;
    if (MODE == 1 && !sample) {
        const float* AG = (const float*)(ws + WS_AGGRG) + ((size_t)(s * NCH) * DM + ch0 + lane) * 2;
        for (int cc = 0; cc < c; ++cc) { const float a = AG[(size_t)cc * DM * 2], b = AG[(size_t)cc * DM * 2 + 1]; hst = a * hst + b; }
    }
    v4u nx[2][4]; unsigned short nry[16];
#define RG_LOAD_RX(tl) do { const int row_ = rbase + 16 * (tl) + fr, t_ = c * TC + 16 * (tl) + fr; \
        _Pragma("unroll") for (int k = 0; k < 2; ++k) _Pragma("unroll") for (int d = 0; d < 4; ++d) nx[k][d] = *(const v4u*)(RX + (size_t)(t_ - d >= 0 ? row_ - d : row_) * DM + ch0 + 32 * k + 8 * fq); } while (0)
#define RG_LOAD_RY(tl) do { _Pragma("unroll") for (int tt = 0; tt < 16; ++tt) nry[tt] = RY[(size_t)(rbase + 16 * (tl) + tt) * DM + ch0 + lane]; } while (0)
    RG_LOAD_RX(0); RG_LOAD_RY(0);
#pragma unroll 1
    for (int tile = 0; tile < 8; ++tile) {
        const int row = rbase + 16 * tile + fr;
        const int t = c * TC + 16 * tile + fr;
        const int sq = sample ? s * 16 + tile * 2 + (fr >> 3) : s;
        bf16x8 X[2];
#pragma unroll
        for (int k = 0; k < 2; ++k) {
            const int cl = 32 * k + 8 * fq; float xc[8];
            { const f32x4 b0 = *(const LAS f32x4*)(TAB + 4 * 64 + cl), b1 = *(const LAS f32x4*)(TAB + 4 * 64 + cl + 4); xc[0] = b0.x; xc[1] = b0.y; xc[2] = b0.z; xc[3] = b0.w; xc[4] = b1.x; xc[5] = b1.y; xc[6] = b1.z; xc[7] = b1.w; }
#pragma unroll
            for (int d = 0; d < 4; ++d) {
                float v[8];
                { v4u w_ = nx[k][d]; if (t - d < 0) w_ = (v4u){0u, 0u, 0u, 0u}; cvt8(w_, v); }
                const f32x4 w0 = *(const LAS f32x4*)(TAB + (3 - d) * 64 + cl), w1 = *(const LAS f32x4*)(TAB + (3 - d) * 64 + cl + 4);
                xc[0] += w0.x * v[0]; xc[1] += w0.y * v[1]; xc[2] += w0.z * v[2]; xc[3] += w0.w * v[3]; xc[4] += w1.x * v[4]; xc[5] += w1.y * v[5]; xc[6] += w1.z * v[6]; xc[7] += w1.w * v[7];
            }
            *(LAS f32x4*)(XC + fr * 68 + cl) = (f32x4){xc[0], xc[1], xc[2], xc[3]}; *(LAS f32x4*)(XC + fr * 68 + cl + 4) = (f32x4){xc[4], xc[5], xc[6], xc[7]};
            v4u pk; pk.x = pk2(xc[0], xc[1]); pk.y = pk2(xc[2], xc[3]); pk.z = pk2(xc[4], xc[5]); pk.w = pk2(xc[6], xc[7]);
            X[k] = __builtin_bit_cast(bf16x8, pk);
        }
        if (tile < 7) RG_LOAD_RX(tile + 1);
        f32x4 acc[2][4];
#pragma unroll
        for (int g = 0; g < 2; ++g)
#pragma unroll
            for (int n = 0; n < 4; ++n) { acc[g][n] = (f32x4){0.f, 0.f, 0.f, 0.f};
#pragma unroll
                for (int k = 0; k < 2; ++k) acc[g][n] = __builtin_amdgcn_mfma_f32_16x16x32_bf16(Wf[g][n][k], X[k], acc[g][n], 0, 0, 0); }
        LDS_WAIT(); asm volatile("" ::: "memory");
#pragma unroll
        for (int n = 0; n < 4; ++n) { const int cl = 16 * n + 4 * fq;
            const f32x4 xv = *(const LAS f32x4*)(XC + fr * 68 + cl), ba = *(const LAS f32x4*)(TAB + 5 * 64 + cl), bx = *(const LAS f32x4*)(TAB + 6 * 64 + cl), c8 = *(const LAS f32x4*)(TAB + 7 * 64 + cl);
            f32x4 av, bv;
#pragma unroll
            for (int j = 0; j < 4; ++j) { const float r = fsig(acc[0][n][j] + ba[j]), ig = fsig(acc[1][n][j] + bx[j]); const float a = __builtin_amdgcn_exp2f(r * c8[j]);
                av[j] = a; bv[j] = __builtin_amdgcn_sqrtf(fmaxf(1.f - a * a, 0.f)) * ig * xv[j]; }
            *(LAS f32x4*)(AA + fr * 68 + cl) = av; *(LAS f32x4*)(BB + fr * 68 + cl) = bv; }
        LDS_WAIT(); asm volatile("" ::: "memory");
#pragma unroll
        for (int tt = 0; tt < 16; ++tt) {
            const float a = AA[tt * 68 + lane], b = BB[tt * 68 + lane];
            hst = a * hst + b; aprod *= a;
            const float g = fgelu(bf2f(nry[tt]));
            const size_t o = (size_t)(rbase + 16 * tile + tt) * DM + ch0 + lane; const unsigned pq = pk2(hst * g, aprod * g); RY[o] = (bf16)(pq & 0xffffu); XQ[o] = (bf16)(pq >> 16);
        }
        if (tile < 7) RG_LOAD_RY(tile + 1);
        LDS_WAIT(); asm volatile("" ::: "memory");
    }
    unsigned long long* AGT = (unsigned long long*)(ws + WS_AGT) + ((size_t)(l * 128 + s * 16 + h) * 16) * 64 + lane;
    __hip_atomic_store(AGT + (size_t)c * 64, ((unsigned long long)__float_as_uint(hst) << 32) | __float_as_uint(fmaxf(aprod, 1e-30f)), __ATOMIC_RELAXED, __HIP_MEMORY_SCOPE_AGENT);
}
__device__ __forceinline__ void rg_unit_sp2(const Frame& F, const Args& A, int l, int s, int c, int h) {
    unsigned char* ws = A.ws;
    const int lane = F.lane, ch0 = 64 * h;
    const bf16* RX = (const bf16*)(ws + WS_RX); bf16* RY = (bf16*)(ws + WS_RY); bf16* XQ = (bf16*)(ws + WS_XN);
    const int rbase = s * TP + c * TC;
    unsigned long long* AGT = (unsigned long long*)(ws + WS_AGT) + ((size_t)(l * 128 + s * 16 + h) * 16) * 64 + lane;
    float hst, aprod; { const unsigned long long v = __hip_atomic_load(AGT + (size_t)c * 64, __ATOMIC_RELAXED, __HIP_MEMORY_SCOPE_AGENT); aprod = __uint_as_float((unsigned)v); hst = __uint_as_float((unsigned)(v >> 32)); }
    float hin = 0.f;
    {   unsigned long long av[NCH - 1];
#pragma unroll
        for (int cc = 0; cc < NCH - 1; ++cc) av[cc] = (cc < c) ? __hip_atomic_load(AGT + (size_t)cc * 64, __ATOMIC_RELAXED, __HIP_MEMORY_SCOPE_AGENT) : 0ull;
#pragma unroll
        for (int cc = 0; cc < NCH - 1; ++cc) if (cc < c) {
            unsigned long long v = av[cc]; unsigned sp_ = 0;
            while (!(__uint_as_float((unsigned)v) > 0.f) && sp_ < (1u << 22)) { __builtin_amdgcn_s_sleep(2); v = __hip_atomic_load(AGT + (size_t)cc * 64, __ATOMIC_RELAXED, __HIP_MEMORY_SCOPE_AGENT); ++sp_; }
            hin = __uint_as_float((unsigned)v) * hin + __uint_as_float((unsigned)(v >> 32));
        } }
    if (c > 0) {
        asm volatile("s_waitcnt vmcnt(0)" ::: "memory");
#pragma unroll 1
        for (int tile = 0; tile < 8; ++tile) {
            unsigned short pv[16], qv[16];
#pragma unroll
            for (int tt = 0; tt < 16; ++tt) { const size_t o = (size_t)(rbase + 16 * tile + tt) * DM + ch0 + lane; pv[tt] = RY[o]; qv[tt] = XQ[o]; }
#pragma unroll
            for (int tt = 0; tt < 16; ++tt) RY[(size_t)(rbase + 16 * tile + tt) * DM + ch0 + lane] = (bf16)f2bf(bf2f(pv[tt]) + bf2f(qv[tt]) * hin);
        }
    }
    if (c == NCH - 1) {
        A.out[O_PRGH + (size_t)(s * 2 + l) * DM + ch0 + lane] = hst + aprod * hin;
#pragma unroll
        for (int k = 0; k < 3; ++k) A.out[O_PRGC + (size_t)((s * 2 + l) * 3 + k) * DM + ch0 + lane] = bf2f(RX[(size_t)(s * TP + TP - 3 + k) * DM + ch0 + lane]);
    }
}

template <int MODE> __device__ __forceinline__ void s5_unit(const Frame& F, const Args& A, int l, bool sample, int s, int c, int g) {
    unsigned char* ws = A.ws;
    LAS float* BU = (LAS float*)(F.lds + F.wave * 15360);
    LAS bf16* XS = (LAS bf16*)(F.lds + F.wave * 15360 + 16 * 132 * 4);
    const int lane = F.lane, fr = lane & 15, fq = lane >> 4;
    bf16* SX = (bf16*)(ws + WS_SX);
    bf16x8 Bf[8], Cf[4];
    { const bf16* BBm = (const bf16*)(ws + WS_SMALL + SM_BBAR) + (size_t)g * 128 * 16;
#pragma unroll
      for (int n = 0; n < 8; ++n) { v4u z = {0u, 0u, 0u, 0u}; if (fq < 2) z = *(const v4u*)(BBm + (16 * n + fr) * 16 + 8 * fq); Bf[n] = __builtin_bit_cast(bf16x8, z); }
      const bf16* CM = (const bf16*)(ws + WS_SMALL + SM_CMAT) + (size_t)g * 16 * 128;
#pragma unroll
      for (int kk = 0; kk < 4; ++kk) Cf[kk] = *(const bf16x8*)(CM + fr * 128 + 32 * kk + 8 * fq); }
    const float ar = ((const float*)(ws + WS_SMALL + SM_ABAR))[(g * 64 + lane) * 2], ai = ((const float*)(ws + WS_SMALL + SM_ABAR))[(g * 64 + lane) * 2 + 1];
    const f32x4 dv = *(const f32x4*)(A.in[28] + l * 512 + 16 * g + 4 * fq);
    const int rbase = sample ? MP + s * 32 : s * TP + c * TC;
    float xr = 0.f, xi = 0.f;
    if (MODE == 1 && !sample) {
        const float tr = ((const float*)(ws + WS_SMALL + SM_ABARTC))[(g * 64 + lane) * 2], ti = ((const float*)(ws + WS_SMALL + SM_ABARTC))[(g * 64 + lane) * 2 + 1];
        const float* AG = (const float*)(ws + WS_AGGS5) + ((size_t)(s * NCH) * 2048 + g * 64 + lane) * 2;
        f32x2 ag[NCH - 1];
#pragma unroll
        for (int cc = 0; cc < NCH - 1; ++cc) ag[cc] = (cc < c) ? *(const f32x2*)(AG + (size_t)cc * 4096) : (f32x2){0.f, 0.f};
#pragma unroll
        for (int cc = 0; cc < NCH - 1; ++cc) if (cc < c) { const float nr = tr * xr - ti * xi + ag[cc].x, ni = tr * xi + ti * xr + ag[cc].y; xr = nr; xi = ni; }
    }
    const int ntile = sample ? 2 : 8;
#define S5_BU(uz_) do { const bf16x8 U_ = __builtin_bit_cast(bf16x8, uz_); _Pragma("unroll") for (int n = 0; n < 8; ++n) { \
        f32x4 a_ = __builtin_amdgcn_mfma_f32_16x16x32_bf16(Bf[n], U_, (f32x4){0.f, 0.f, 0.f, 0.f}, 0, 0, 0); *(LAS f32x4*)(BU + fr * 132 + 16 * n + 4 * fq) = a_; } } while (0)
    v4u un = {0u, 0u, 0u, 0u}; u32x2 sxc = {0u, 0u};
    { v4u u0 = {0u, 0u, 0u, 0u}; if (fq < 2) u0 = *(const v4u*)(SX + (size_t)(rbase + fr) * 512 + 16 * g + 8 * fq);
      if (fq < 2) un = *(const v4u*)(SX + (size_t)(rbase + 16 + fr) * 512 + 16 * g + 8 * fq);
      if (MODE == 1) sxc = *(const u32x2*)(SX + (size_t)(rbase + fr) * 512 + 16 * g + 4 * fq);
      S5_BU(u0); }
#pragma unroll 1
    for (int tile = 0; tile < ntile; ++tile) {
        const int row = rbase + 16 * tile + fr;
        LDS_WAIT(); asm volatile("" ::: "memory");
        float br[16], bi[16];
#pragma unroll
        for (int tt = 0; tt < 16; ++tt) { br[tt] = BU[tt * 132 + lane]; bi[tt] = BU[tt * 132 + 64 + lane]; }
        u32x2 sxn = {0u, 0u};
        if (tile + 1 < ntile) {
            S5_BU(un);
            if (tile + 2 < ntile && fq < 2) un = *(const v4u*)(SX + (size_t)(row + 32) * 512 + 16 * g + 8 * fq);
            if (MODE == 1) sxn = *(const u32x2*)(SX + (size_t)(row + 16) * 512 + 16 * g + 4 * fq);
        }
#pragma unroll
        for (int tt = 0; tt < 16; ++tt) {
            if (sample && (tt & 7) == 0) { const size_t si = ((size_t)((s * 4 + tile * 2 + (tt >> 3)) * 2 + l) * 32 + g) * 64 + lane; xr = A.in[4][si]; xi = A.in[5][si]; }
            const float nr = ar * xr - ai * xi + br[tt], ni = ar * xi + ai * xr + bi[tt]; xr = nr; xi = ni;
            if (MODE == 1) { const unsigned xx = pk2(xr, xi); XS[tt * 136 + lane] = (bf16)(xx & 0xffffu); XS[tt * 136 + 64 + lane] = (bf16)(xx >> 16); }
            if (MODE == 1 && sample && (tt & 7) == 7) { const size_t si = ((size_t)((s * 4 + tile * 2 + (tt >> 3)) * 2 + l) * 32 + g) * 64 + lane; A.out[O_SS5R + si] = xr; A.out[O_SS5I + si] = xi; }
        }
        if (MODE == 1) {
            LDS_WAIT(); asm volatile("" ::: "memory");
            f32x4 y = {0.f, 0.f, 0.f, 0.f};
#pragma unroll
            for (int kk = 0; kk < 4; ++kk) { const bf16x8 xb = *(const LAS bf16x8*)(XS + fr * 136 + 32 * kk + 8 * fq); y = __builtin_amdgcn_mfma_f32_16x16x32_bf16(Cf[kk], xb, y, 0, 0, 0); }
            bf16* p = SX + (size_t)row * 512 + 16 * g + 4 * fq; const u32x2 sx = sxc;
            u32x2 o; o.x = pk2(fgelu(y.x + dv.x * bflo(sx.x)), fgelu(y.y + dv.y * bfhi(sx.x))); o.y = pk2(fgelu(y.z + dv.z * bflo(sx.y)), fgelu(y.w + dv.w * bfhi(sx.y)));
            *(u32x2*)p = o;
        }
        sxc = sxn;
    }
    LDS_WAIT(); asm volatile("" ::: "memory");
#undef S5_BU
    if (MODE == 0) { float* AG = (float*)(ws + WS_AGGS5) + ((size_t)(s * NCH + c) * 2048 + g * 64 + lane) * 2; AG[0] = xr; AG[1] = xi; }
    if (MODE == 1 && !sample && c == NCH - 1) { const size_t si = ((size_t)(s * 2 + l) * 32 + g) * 64 + lane; A.out[O_PS5R + si] = xr; A.out[O_PS5I + si] = xi; }
}

template <int MODE> __device__ __forceinline__ void mixer_phase(const Frame& F0, const Args& A, int l, int qi, int b0) {
    const Frame F = refresh(F0);
    int bx_ = blockIdx.x; asm volatile("" : "+s"(bx_)); if (bx_ < b0) return;
    gu32* q = F.ctl + CW_Q + 64 * qi;
    constexpr int N_A = MODE == 0 ? 2048 : NSP * NCH * 32, N_B = MODE == 0 ? 32 * 16 : 32 * 32, N_C = MODE == 0 ? NSP * (NCH - 1) * 32 : 0;
    constexpr int NTOT = N_A + N_B + N_C;
    (void)q;
    const int nb_ = F.G - b0, bl_ = bx_ - b0, vb_ = (nb_ % 8 == 0) ? (bl_ % 8) * (nb_ / 8) + bl_ / 8 : bl_, gw = F.wave * nb_ + vb_, NGW = nb_ * NWAVES;
    for (int u0 = gw; u0 < NTOT; u0 += NGW) {
        int u = u0;
        if (MODE == 0) {
            if (u < N_A) { const int c = u >> 7, sh = u & 127; rg_unit_sp(F, A, l, sh >> 4, c, sh & 15); continue; } u -= N_A;
            if (u < N_B) { rg_unit<1>(F, A, l, true, u >> 4, 0, u & 15); continue; } u -= N_B;
            { const int g = u & 31, r = u >> 5, c = r % (NCH - 1), s2 = r / (NCH - 1); s5_unit<0>(F, A, l, false, s2, c, g); }
        } else {
            if (u < N_A) { const int g = u & 31, r = u >> 5, c = r % NCH, s2 = r / NCH; s5_unit<1>(F, A, l, false, s2, c, g); continue; } u -= N_A;
            s5_unit<1>(F, A, l, true, u >> 5, 0, u & 31);
        }
    }
    if (MODE == 0 && gw < N_A) { const int c = gw >> 7, sh = gw & 127; rg_unit_sp2(F, A, l, sh >> 4, c, sh & 15); }
}

__device__ __forceinline__ void ffn_fixup_local(const Frame& F0, const Args& A, int l, int pm) {
    const Frame F = refresh(F0);
    if (pm < 64 && (pm & 7) != 0) {
        const float* HALO = (const float*)(A.ws + WS_HALO); bf16* HF = (bf16*)(A.ws + WS_HFF);
        const float* cw = A.in[34] + (size_t)l * 3 * FF2; const float* cb = A.in[35] + (size_t)l * FF2;
        for (int c = F.tid; c < FF; c += NWAVES * 64) {
            float uc0[2], uc1[2];
#pragma unroll
            for (int bj = 0; bj < 2; ++bj) {
                const float a254 = HALO[((size_t)((pm - 1) * 4 + 0) * 2 + bj) * FF + c], a255 = HALO[((size_t)((pm - 1) * 4 + 1) * 2 + bj) * FF + c];
                const float r0 = HALO[((size_t)(pm * 4 + 2) * 2 + bj) * FF + c], r1 = HALO[((size_t)(pm * 4 + 3) * 2 + bj) * FF + c];
                const float w0 = cw[bj * FF + c], w1 = cw[FF2 + bj * FF + c], w2 = cw[2 * FF2 + bj * FF + c], b = cb[bj * FF + c];
                uc0[bj] = b + w0 * a254 + w1 * a255 + w2 * r0; uc1[bj] = b + w0 * a255 + w1 * r0 + w2 * r1;
            }
            HF[(size_t)(pm * 256) * FF + c] = (bf16)f2bf(fgelu(uc0[0]) * uc0[1]); HF[(size_t)(pm * 256 + 1) * FF + c] = (bf16)f2bf(fgelu(uc1[0]) * uc1[1]);
        }
    }
    asm volatile("s_waitcnt vmcnt(0)" ::: "memory"); __syncthreads();
}

__global__ void __launch_bounds__(NWAVES * 64, 2) hawk_fwd(Args args) {
    extern __shared__ __attribute__((aligned(16))) unsigned char lds[];
    Frame F;
    F.lds = (LAS unsigned char*)lds;
    F.MISC = (volatile LAS unsigned*)(F.lds + MISC_OFF);
    F.tid = threadIdx.x; F.lane = F.tid & 63; F.wave = __builtin_amdgcn_readfirstlane(F.tid >> 6);
    F.G = gridDim.x; { const int bx = blockIdx.x; F.vcu = (F.G % 8 == 0) ? (bx % 8) * (F.G / 8) + bx / 8 : bx; }
    unsigned char* ws = args.ws;
    F.ctl = (gu32*)(ws + WS_CTL);
    for (int u = F.tid; u < (LDS_BYTES - LDSCTL_OFF) / 4; u += NWAVES * 64) ((LAS unsigned*)(F.lds + LDSCTL_OFF))[u] = 0u;
    __syncthreads();
    XcdBarrier bar = xcd_barrier_post((unsigned*)(F.ctl + CW_BAR), F.MISC + 8);
#define GRID_BAR() xcd_barrier(bar)

#pragma unroll 1
    for (int st = 0; st < NST_MAX; ++st) {
        unsigned char* ws = args.ws; float* outp = args.out; asm volatile("" : "+s"(ws), "+s"(outp));
        bf16* XRB = (bf16*)(ws + WS_XRB); float* MOD = (float*)(ws + WS_MOD); bf16* XN = (bf16*)(ws + WS_XN); int bid = (int)blockIdx.x; asm volatile("" : "+s"(bid));
        const int l = st < 2 ? 0 : (st - 2) / 10, sub = st < 2 ? st - 2 : (st == 22 ? 99 : (st - 2) % 10);
        const int ll = st == 22 ? 1 : l;
        const float* xin_p = ll == 0 ? args.in[0] : nullptr; const float* xin_s = ll == 0 ? args.in[1] - (size_t)MP * DM : nullptr;
        const float* modl = MOD + ll * 6144;
        bool is_gemm = false; pg8::Gemm g{nullptr, nullptr, 0, 0, 0, 0, 0}; pg8::EpiAny E{0, false, ws, nullptr, nullptr, nullptr, nullptr, 0, ll, (PG8_LAS float*)(F.lds + XCH_OFF)};
        switch (sub) {
            case -1: is_gemm = true; g = pg8::Gemm{(const pg8::bf16_t*)(ws + WS_SILUC), (const pg8::bf16_t*)(ws + WS_WADA), 256, MODW, DM, DM, DM}; E.mode = pg8::EM_ADA; E.perm = false; E.p0 = args.in[10]; E.out = MOD; break;
            case 1: is_gemm = true; g = pg8::Gemm{(const pg8::bf16_t*)XN, (const pg8::bf16_t*)(ws + WS_WIN), MROWS, INW, DM, DM, DM}; E.mode = pg8::EM_IN; E.perm = true; E.p0 = args.in[14] + l * INW; break;
            case 3: case 4: is_gemm = true; g = pg8::Gemm{(const pg8::bf16_t*)(ws + WS_RY), (const pg8::bf16_t*)(ws + WS_WRG), MROWS, DM, DM, DM, DM}; E.mode = pg8::EM_RGP; E.perm = true; break;
            case 5: is_gemm = true; g = pg8::Gemm{(const pg8::bf16_t*)(ws + WS_SX), (const pg8::bf16_t*)(ws + WS_WGLU), MROWS, 2048, 512, 512, 512}; E.mode = pg8::EM_GLU; E.perm = true; break;
            case 6: is_gemm = true; g = pg8::Gemm{(const pg8::bf16_t*)(ws + WS_GA), (const pg8::bf16_t*)(ws + WS_WOUT), MROWS, DM, DM, DM, DM}; E.mode = pg8::EM_RES; E.perm = true; E.p0 = xin_p; E.p2 = modl + 2048; E.row_off = 0; break;
            case 8: is_gemm = true; g = pg8::Gemm{(const pg8::bf16_t*)XN, (const pg8::bf16_t*)(ws + WS_WUP), MROWS, FF2, DM, DM, DM}; E.mode = pg8::EM_UPF; E.perm = true; E.p0 = args.in[34] + (size_t)l * 3 * FF2; E.p1 = args.in[35] + (size_t)l * FF2; E.p2 = args.in[6]; E.out = outp; break;
            case 9: is_gemm = true; g = pg8::Gemm{(const pg8::bf16_t*)(ws + WS_HFF), (const pg8::bf16_t*)(ws + WS_WDOWN), MROWS, DM, FF, FF, FF}; E.mode = pg8::EM_RES; E.perm = true; E.p0 = nullptr; E.p2 = modl + 5120; E.row_off = 1; break;
            default: break;
        }
#ifndef DUP
#define DUP 0
#endif
        const int nrep = (DUP == 1 && sub == 2) || (DUP == 2 && (st == 0 || (sub == 0 && l == 1))) || (DUP == 3 && sub == 8) || (DUP == 4 && (sub == 0 || sub == 7)) || (DUP == 5 && sub == 1) || (DUP == 6 && sub == 6 && l == 0) || (DUP == 7 && ((sub == 0 && l == 0 && st >= 2) || sub == 9)) ? 2 : 1;
#pragma unroll 1
        for (int rep = 0; rep < nrep; ++rep) {
        if (rep == 1) GRID_BAR();
        if (st < 2 || (sub == 0 && l == 1)) p0_weights(F, args, l, st == 0 ? 0 : 1, st == 1 ? 48 : 0, st == 1 ? F.G - 48 : F.G);
        if (sub == 0 || sub == 7) norm_rows(F, sub == 0 ? xin_p : nullptr, sub == 0 ? xin_s : nullptr, XRB, (sub == 0 ? args.in[11] : args.in[12]) + l * DM, modl + (sub == 0 ? 0 : 3072), modl + (sub == 0 ? 1024 : 4096), XN,
                                            sub == 7 ? 4 : (l == 1 ? 12 : 0), sub == 7 ? modl + 2048 : MOD + 5120, (const float*)(ws + (sub == 7 ? WS_PART_OUT : WS_PART_DOWN)));
        if (sub == 2) mixer_phase<0>(F, args, l, l * 2 + rep * 4, 0);
        if (sub == 3) mixer_phase<1>(F, args, l, l * 2 + 1, 16);
        if (is_gemm) { pg8::SplitOrder S; S.init(g.M, g.N, g.K, F.G, bid, (sub == 6 || sub == 9) ? 1 : (sub == 4 ? 2 : (sub == 3 ? 3 : 0)), 256);
            if (sub == 9) { pg8::Unit u0; ffn_fixup_local(F, args, l, S.next(0, u0) ? u0.pm : 64); } pg8::gemm_phase<pg8::EpiAny, pg8::SplitOrder, true, true>(F.lds, g, S, E); }
        }
        if (sub == 99) final_norm(F, XRB, outp + O_Y, args.in[37], 12, MOD + 6144 + 5120, (const float*)(ws + WS_PART_DOWN)); else GRID_BAR();
    }
}

extern "C" void kernel_launch(void* const* d_in, const int* in_sizes, int n_in, void* d_out, int out_size, void* d_ws, size_t ws_size, hipStream_t stream) {
    static int grid = 0;
    if (grid == 0) {
        if (n_in != 38 || out_size != 23396352 || ws_size < WS_END) { fprintf(stderr, "kernel_launch: unexpected shapes (n_in %d out %d ws %zu)\n", n_in, out_size, ws_size); grid = -1; return; }
        int dev = 0, cus = 0, per_cu = 0;
        if (hipGetDevice(&dev) != hipSuccess || hipDeviceGetAttribute(&cus, hipDeviceAttributeMultiprocessorCount, dev) != hipSuccess) { grid = -1; return; }
        if (hipFuncSetAttribute((const void*)hawk_fwd, hipFuncAttributeMaxDynamicSharedMemorySize, LDS_BYTES) != hipSuccess) { fprintf(stderr, "kernel_launch: hipFuncSetAttribute failed\n"); grid = -1; return; }
        if (hipOccupancyMaxActiveBlocksPerMultiprocessor(&per_cu, (const void*)hawk_fwd, NWAVES * 64, LDS_BYTES) != hipSuccess || per_cu < 1) { fprintf(stderr, "kernel_launch: occupancy query says %d\n", per_cu); per_cu = 1; }
        (void)hipGetLastError();
        grid = cus;
    }
    if (grid < 0) return;
    static_assert(WS_AGT + 2 * MiB == WS_CTL, "the tagged aggregates and the control words form one zeroed span");
    if (hipMemsetAsync((char*)d_ws + WS_AGT, 0, 2 * MiB + CTL_ZERO_BYTES, stream) != hipSuccess) { fprintf(stderr, "kernel_launch: memset failed\n"); return; }
    Args a{};
    for (int i = 0; i < 38; ++i) a.in[i] = (const float*)d_in[i];
    a.out = (float*)d_out; a.ws = (unsigned char*)d_ws;
    hipLaunchKernelGGL(hawk_fwd, dim3(grid), dim3(NWAVES * 64), LDS_BYTES, stream, a);
}
```
